# Optimizing an MI355X kernel written in HIP

```python
import math
import jax, jax.numpy as jnp
from jax import lax
import numpy as np

D_MODEL = 1024
BATCH = 32
SEQ = 256
DEPTH = 2
DEC_BATCH = 2
DEC_SEQ = 4096
PAST_LEN = 256

GRID_W = 64
ROPE_BASE = 10000.0
EPS = 1e-6
BLK = 128
WINDOW = 128
NEG_INF = -1e30

N_AB = (DEPTH + 1) // 2
N_C = DEPTH // 2

A_HEADS = 8
A_KV_HEADS = 2
A_GROUP = A_HEADS // A_KV_HEADS
A_HEAD_DIM = 64
A_WIDTH = A_HEADS * A_HEAD_DIM
A_KV_WIDTH = A_KV_HEADS * A_HEAD_DIM
A_SCALE = A_HEAD_DIM ** -0.5

SSD_HEADS = 16
SSD_HEAD_DIM = 64
SSD_INNER = SSD_HEADS * SSD_HEAD_DIM
SSD_GROUPS = 2
SSD_STATE = 64
CONV_K = 5
CONV_CH = SSD_INNER + 2 * SSD_GROUPS * SSD_STATE
CHUNK = 128

AB_IN = 2 * A_WIDTH + 2 * A_KV_WIDTH + SSD_INNER + CONV_CH + 2 * SSD_HEADS
AB_OUT_IN = A_WIDTH + SSD_INNER

MLA_HEADS = 16
MLA_NOPE = 64
MLA_ROPE = 32
MLA_V = 64
Q_LORA = 256
KV_LORA = 128
MLA_WIDTH = MLA_HEADS * MLA_V
MLA_IN = Q_LORA + KV_LORA + MLA_ROPE + MLA_WIDTH
MLA_SCALE = (MLA_NOPE + MLA_ROPE) ** -0.5

kernel_name = "hybrid_swa_ssd_mla_prefix_dit_step"


def rms_norm(x, w):
    xf = x.astype(jnp.float32)
    y = xf * lax.rsqrt(jnp.mean(xf * xf, axis=-1, keepdims=True) + EPS)
    return (y * w.astype(jnp.float32)).astype(x.dtype)


def split_cols(t, sizes):
    idx = [int(s) for s in np.cumsum(sizes)[:-1]]
    return jnp.split(t, idx, axis=-1)


def modulation(cond, w_ada, b_ada):
    m = jax.nn.silu(cond) @ w_ada + b_ada
    shift, scale, gate = jnp.split(m[:, None, :], 3, axis=-1)
    return shift, scale, gate


def axial_rope_tables(length, dim, dtype):
    rows = length // GRID_W
    row = jnp.repeat(jnp.arange(rows), GRID_W).astype(jnp.float32)
    col = jnp.tile(jnp.arange(GRID_W), rows).astype(jnp.float32)
    nf = dim // 4
    inv = 1.0 / (ROPE_BASE ** (jnp.arange(nf, dtype=jnp.float32) / nf))
    ar = row[:, None] * inv[None, :]
    ac = col[:, None] * inv[None, :]
    ang = jnp.concatenate([ar, ar, ac, ac], axis=-1)
    return jnp.cos(ang).astype(dtype), jnp.sin(ang).astype(dtype)


def apply_rope(x, cos, sin):
    shape = (cos.shape[0],) + (1,) * (x.ndim - 3) + (cos.shape[1],)
    half = x.shape[-1] // 2
    nf = half // 2

    def rot(u):
        return jnp.concatenate([-u[..., nf:], u[..., :nf]], axis=-1)

    xr = jnp.concatenate([rot(x[..., :half]), rot(x[..., half:])], axis=-1)
    return x * cos.reshape(shape) + xr * sin.reshape(shape)


def dense_attention(q, k, v, scale, sink=None):
    b, lq, kvh, g, dk = q.shape
    nb = lq // BLK
    qb = jnp.moveaxis(q.reshape(b, nb, BLK, kvh, g, dk), 1, 0)

    def one_block(qblk):
        s = jnp.einsum("bqhgd,bkhd->bhgqk", qblk, k).astype(jnp.float32) * scale
        if sink is not None:
            s_sink = jnp.broadcast_to(sink.astype(jnp.float32)[None, :, :, None, None], s.shape[:-1] + (1,))
            p = jax.nn.softmax(jnp.concatenate([s, s_sink], axis=-1), axis=-1)[..., :-1]
        else:
            p = jax.nn.softmax(s, axis=-1)
        return jnp.einsum("bhgqk,bkhd->bqhgd", p.astype(v.dtype), v)

    out = lax.map(one_block, qb)
    return jnp.moveaxis(out, 0, 1).reshape(b, lq, kvh, g, v.shape[-1])


def banded_attention(q, k, v, k_ctx, v_ctx, sink, scale):
    b, L, kvh, g, d = q.shape
    nb = L // BLK
    qb = q.reshape(b, nb, BLK, kvh, g, d)

    def windows(t):
        tb = t.reshape(b, nb, BLK, kvh, d)
        tp = jnp.pad(tb, ((0, 0), (1, 1), (0, 0), (0, 0), (0, 0)))
        return jnp.concatenate([tp[:, :-2], tp[:, 1:-1], tp[:, 2:]], axis=2)

    kw = windows(k)
    vw = windows(v)
    qi = jnp.arange(BLK)
    kj = jnp.arange(3 * BLK) - BLK
    rel = kj[None, :] - qi[:, None]
    kpos = jnp.arange(nb)[:, None] * BLK + kj[None, :]
    valid = (jnp.abs(rel) <= WINDOW)[None] & ((kpos >= 0) & (kpos < L))[:, None, :]
    s_loc = jnp.einsum("bnqhgd,bnkhd->bnhgqk", qb, kw).astype(jnp.float32) * scale
    s_loc = jnp.where(valid[None, :, None, None], s_loc, NEG_INF)
    s_ctx = jnp.einsum("bnqhgd,bchd->bnhgqc", qb, k_ctx).astype(jnp.float32) * scale
    s_sink = jnp.broadcast_to(sink.astype(jnp.float32)[None, None, :, :, None, None], s_loc.shape[:-1] + (1,))
    p = jax.nn.softmax(jnp.concatenate([s_loc, s_ctx, s_sink], axis=-1), axis=-1).astype(v.dtype)
    nk = 3 * BLK
    nc = k_ctx.shape[1]
    out = (jnp.einsum("bnhgqk,bnkhd->bnqhgd", p[..., :nk], vw)
           + jnp.einsum("bnhgqc,bchd->bnqhgd", p[..., nk:nk + nc], v_ctx))
    return out.reshape(b, L, kvh, g, d)


def centred_conv(u, w, bias):
    ch = u.shape[-1]
    pad = CONV_K // 2
    out = lax.conv_general_dilated(u, w[:, None, :], window_strides=(1,), padding=[(pad, pad)],
                                   dimension_numbers=("NWC", "WIO", "NWC"), feature_group_count=ch)
    return out + bias


def ssd_scan(x, dt, a_head, bm, cm, h0):
    f32 = jnp.float32
    b, L, H, P = x.shape
    G, N = bm.shape[2], bm.shape[3]
    nc = L // CHUNK
    rep = H // G
    bh = jnp.repeat(bm, rep, axis=2).astype(f32).reshape(b, nc, CHUNK, H, N)
    ch = jnp.repeat(cm, rep, axis=2).astype(f32).reshape(b, nc, CHUNK, H, N)
    xd = (x.astype(f32) * dt[..., None]).reshape(b, nc, CHUNK, H, P)
    la = (dt * a_head.astype(f32)).reshape(b, nc, CHUNK, H)
    cum = jnp.cumsum(la, axis=2)
    causal = jnp.tril(jnp.ones((CHUNK, CHUNK), dtype=bool))[:, :, None]
    diff = cum[:, :, :, None, :] - cum[:, :, None, :, :]
    decay = jnp.exp(jnp.where(causal, diff, -jnp.inf))
    scores = jnp.einsum("bclhn,bcshn->bclsh", ch, bh) * decay
    y_diag = jnp.einsum("bclsh,bcshp->bclhp", scores, xd)
    w_state = jnp.exp(cum[:, :, -1:, :] - cum)
    states = jnp.einsum("bcshn,bcsh,bcshp->bchpn", bh, w_state, xd)
    chunk_decay = jnp.exp(cum[:, :, -1, :])

    def step(hc, inp):
        st, dec = inp
        return hc * dec[:, :, None, None] + st, hc

    h_final, h_in = lax.scan(step, h0.astype(f32), (jnp.moveaxis(states, 1, 0), jnp.moveaxis(chunk_decay, 1, 0)))
    h_in = jnp.moveaxis(h_in, 0, 1)
    y_off = jnp.einsum("bclhn,bchpn,bclh->bclhp", ch, h_in, jnp.exp(cum))
    y = (y_diag + y_off).reshape(b, L, H, P)
    return y.astype(x.dtype), h_final.astype(x.dtype)


def ssd_bidir(xs, bm, cm, dt, dt_bias, a_log, d_skip, h0_f, h0_b):
    dtp = jax.nn.softplus((dt + dt_bias).astype(jnp.float32))
    a = -jnp.exp(a_log.astype(jnp.float32))
    y_f, s_f = ssd_scan(xs, dtp[:, :, 0], a[0], bm, cm, h0_f)
    flip = lambda t: jnp.flip(t, axis=1)
    y_b, s_b = ssd_scan(flip(xs), flip(dtp[:, :, 1]), a[1], flip(bm), flip(cm), h0_b)
    y = y_f + flip(y_b) + d_skip[:, None] * xs
    return y, s_f, s_b


def ab_inputs(h, w_in, conv_w, conv_b):
    b, L, _ = h.shape
    q, k, v, g, z, xbc, dt = split_cols(h @ w_in, (A_WIDTH, A_KV_WIDTH, A_KV_WIDTH, A_WIDTH, SSD_INNER, CONV_CH, 2 * SSD_HEADS))
    q = q.reshape(b, L, A_KV_HEADS, A_GROUP, A_HEAD_DIM)
    k = k.reshape(b, L, A_KV_HEADS, A_HEAD_DIM)
    v = v.reshape(b, L, A_KV_HEADS, A_HEAD_DIM)
    xbc = jax.nn.silu(centred_conv(xbc, conv_w, conv_b))
    xs, bm, cm = split_cols(xbc, (SSD_INNER, SSD_GROUPS * SSD_STATE, SSD_GROUPS * SSD_STATE))
    xs = xs.reshape(b, L, SSD_HEADS, SSD_HEAD_DIM)
    bm = bm.reshape(b, L, SSD_GROUPS, SSD_STATE)
    cm = cm.reshape(b, L, SSD_GROUPS, SSD_STATE)
    dt = dt.reshape(b, L, 2, SSD_HEADS)
    return q, k, v, g, z, xs, bm, cm, dt


def ab_output(attn, g, y, z, gnorm_w, w_out):
    b, L = g.shape[0], g.shape[1]
    a_out = attn.reshape(b, L, A_WIDTH) * jax.nn.silu(g)
    s_out = rms_norm(y.reshape(b, L, SSD_INNER) * jax.nn.silu(z), gnorm_w)
    return jnp.concatenate([a_out, s_out], axis=-1) @ w_out


def ab_context(h, w_in, sink, conv_w, conv_b, dt_bias, a_log, d_skip, gnorm_w, w_out):
    q, k, v, g, z, xs, bm, cm, dt = ab_inputs(h, w_in, conv_w, conv_b)
    attn = dense_attention(q, k, v, A_SCALE, sink.reshape(A_KV_HEADS, A_GROUP))
    h0 = jnp.zeros((h.shape[0], SSD_HEADS, SSD_HEAD_DIM, SSD_STATE), h.dtype)
    y, s_f, s_b = ssd_bidir(xs, bm, cm, dt, dt_bias, a_log, d_skip, h0, h0)
    return ab_output(attn, g, y, z, gnorm_w, w_out), k, v, s_f, s_b


def ab_latent(h, k_ctx, v_ctx, s_f0, s_b0, w_in, sink, conv_w, conv_b, dt_bias, a_log, d_skip, gnorm_w, w_out):
    q, k, v, g, z, xs, bm, cm, dt = ab_inputs(h, w_in, conv_w, conv_b)
    cos, sin = axial_rope_tables(h.shape[1], A_HEAD_DIM, h.dtype)
    attn = banded_attention(apply_rope(q, cos, sin), apply_rope(k, cos, sin), v, k_ctx, v_ctx,
                            sink.reshape(A_KV_HEADS, A_GROUP), A_SCALE)
    y, _, _ = ssd_bidir(xs, bm, cm, dt, dt_bias, a_log, d_skip, s_f0, s_b0)
    return ab_output(attn, g, y, z, gnorm_w, w_out)


def mla_inputs(h, w_in, q_norm_w, kv_norm_w, w_uq):
    b, L, _ = h.shape
    cq, ckv, kpe, g = split_cols(h @ w_in, (Q_LORA, KV_LORA, MLA_ROPE, MLA_WIDTH))
    q = (rms_norm(cq, q_norm_w) @ w_uq).reshape(b, L, MLA_HEADS, MLA_NOPE + MLA_ROPE)
    return q, rms_norm(ckv, kv_norm_w), kpe, g


def mla_expand_kv(ckv, kpe, w_ukv):
    b, L, _ = ckv.shape
    kv = (ckv @ w_ukv).reshape(b, L, MLA_HEADS, MLA_NOPE + MLA_V)
    k_nope, v = kv[..., :MLA_NOPE], kv[..., MLA_NOPE:]
    k = jnp.concatenate([k_nope, jnp.broadcast_to(kpe[:, :, None, :], (b, L, MLA_HEADS, MLA_ROPE))], axis=-1)
    return k, v


def mla_attend(q, k, v, g, w_out):
    b, L = q.shape[0], q.shape[1]
    out = dense_attention(q[:, :, :, None, :], k, v, MLA_SCALE)
    return (out.reshape(b, L, MLA_WIDTH) * jax.nn.silu(g)) @ w_out


def mla_context(h, w_in, q_norm_w, kv_norm_w, w_uq, w_ukv, w_out):
    q, ckv, kpe, g = mla_inputs(h, w_in, q_norm_w, kv_norm_w, w_uq)
    k, v = mla_expand_kv(ckv, kpe, w_ukv)
    return mla_attend(q, k, v, g, w_out), ckv, kpe


def mla_latent(h, ckv_ctx, kpe_ctx, w_in, q_norm_w, kv_norm_w, w_uq, w_ukv, w_out):
    q, ckv, kpe, g = mla_inputs(h, w_in, q_norm_w, kv_norm_w, w_uq)
    cos, sin = axial_rope_tables(h.shape[1], MLA_ROPE, h.dtype)
    q = jnp.concatenate([q[..., :MLA_NOPE], apply_rope(q[..., MLA_NOPE:], cos, sin)], axis=-1)
    k_lat, v_lat = mla_expand_kv(ckv, apply_rope(kpe, cos, sin), w_ukv)
    k_ctx, v_ctx = mla_expand_kv(ckv_ctx, kpe_ctx, w_ukv)
    k = jnp.concatenate([k_lat, k_ctx], axis=1)
    v = jnp.concatenate([v_lat, v_ctx], axis=1)
    return mla_attend(q, k, v, g, w_out)


def setup_inputs(seed: int = 0) -> dict:
    key = jax.random.key(seed)
    ks = jax.random.split(key, 29)
    f32 = jnp.float32

    def nrm(k, shape, s=1.0):
        return s * jax.random.normal(k, shape, f32)

    dt0 = jnp.exp(jax.random.uniform(ks[17], (N_AB, 2, SSD_HEADS), f32, math.log(1e-3), math.log(1e-1)))
    return {
        "x_prompt": nrm(ks[0], (BATCH, SEQ, D_MODEL)),
        "x_sample": nrm(ks[1], (DEC_BATCH, DEC_SEQ, D_MODEL)),
        "cache_a_k": nrm(ks[2], (DEC_BATCH, N_AB, PAST_LEN, A_KV_HEADS, A_HEAD_DIM)),
        "cache_a_v": nrm(ks[3], (DEC_BATCH, N_AB, PAST_LEN, A_KV_HEADS, A_HEAD_DIM)),
        "state_ssd_fwd": nrm(ks[4], (DEC_BATCH, N_AB, SSD_HEADS, SSD_HEAD_DIM, SSD_STATE), 0.5),
        "state_ssd_bwd": nrm(ks[5], (DEC_BATCH, N_AB, SSD_HEADS, SSD_HEAD_DIM, SSD_STATE), 0.5),
        "cache_mla_ckv": nrm(ks[6], (DEC_BATCH, N_C, PAST_LEN, KV_LORA)),
        "cache_mla_kpe": nrm(ks[7], (DEC_BATCH, N_C, PAST_LEN, MLA_ROPE)),
        "c": nrm(ks[8], (DEC_BATCH, D_MODEL)),
        "c_ctx": nrm(ks[9], (D_MODEL,)),
        "ada_w": nrm(ks[10], (DEPTH, D_MODEL, 3 * D_MODEL), D_MODEL ** -0.5),
        "ada_b": nrm(ks[11], (DEPTH, 3 * D_MODEL), 0.02),
        "norm_w": 1.0 + nrm(ks[12], (DEPTH, D_MODEL), 0.02),
        "ab_w_in": nrm(ks[13], (N_AB, D_MODEL, AB_IN), D_MODEL ** -0.5),
        "ab_sink": nrm(ks[14], (N_AB, A_HEADS), 0.5),
        "ab_conv_w": nrm(ks[15], (N_AB, CONV_K, CONV_CH), CONV_K ** -0.5),
        "ab_conv_b": nrm(ks[16], (N_AB, CONV_CH), 0.02),
        "ab_dt_bias": dt0 + jnp.log(-jnp.expm1(-dt0)),
        "ab_a_log": jnp.log(jax.random.uniform(ks[18], (N_AB, 2, SSD_HEADS), f32, 1.0, 16.0)),
        "ab_d_skip": 1.0 + nrm(ks[19], (N_AB, SSD_HEADS), 0.1),
        "ab_gnorm_w": 1.0 + nrm(ks[20], (N_AB, SSD_INNER), 0.02),
        "ab_w_out": nrm(ks[21], (N_AB, AB_OUT_IN, D_MODEL), AB_OUT_IN ** -0.5),
        "mla_w_in": nrm(ks[22], (N_C, D_MODEL, MLA_IN), D_MODEL ** -0.5),
        "mla_q_norm_w": 1.0 + nrm(ks[23], (N_C, Q_LORA), 0.02),
        "mla_kv_norm_w": 1.0 + nrm(ks[24], (N_C, KV_LORA), 0.02),
        "mla_w_uq": nrm(ks[25], (N_C, Q_LORA, MLA_HEADS * (MLA_NOPE + MLA_ROPE)), Q_LORA ** -0.5),
        "mla_w_ukv": nrm(ks[26], (N_C, KV_LORA, MLA_HEADS * (MLA_NOPE + MLA_V)), KV_LORA ** -0.5),
        "mla_w_out": nrm(ks[27], (N_C, MLA_WIDTH, D_MODEL), MLA_WIDTH ** -0.5),
        "final_norm_w": 1.0 + nrm(ks[28], (D_MODEL,), 0.02),
    }


def reference(x_prompt, x_sample, cache_a_k, cache_a_v, state_ssd_fwd, state_ssd_bwd, cache_mla_ckv, cache_mla_kpe,
              c, c_ctx, ada_w, ada_b, norm_w, ab_w_in, ab_sink, ab_conv_w, ab_conv_b, ab_dt_bias, ab_a_log,
              ab_d_skip, ab_gnorm_w, ab_w_out, mla_w_in, mla_q_norm_w, mla_kv_norm_w, mla_w_uq, mla_w_ukv,
              mla_w_out, final_norm_w):
    xp = x_prompt
    ks_a, vs_a, sf_list, sb_list, ckv_list, kpe_list = [], [], [], [], [], []
    for layer in range(DEPTH):
        i = layer // 2
        shift, scale, gate = modulation(c_ctx[None, :], ada_w[layer], ada_b[layer])
        h = rms_norm(xp, norm_w[layer]) * (1.0 + scale) + shift
        if layer % 2 == 0:
            out, k, v, s_f, s_b = ab_context(h, ab_w_in[i], ab_sink[i], ab_conv_w[i], ab_conv_b[i], ab_dt_bias[i],
                                             ab_a_log[i], ab_d_skip[i], ab_gnorm_w[i], ab_w_out[i])
            ks_a.append(k)
            vs_a.append(v)
            sf_list.append(s_f)
            sb_list.append(s_b)
        else:
            out, ckv, kpe = mla_context(h, mla_w_in[i], mla_q_norm_w[i], mla_kv_norm_w[i], mla_w_uq[i],
                                        mla_w_ukv[i], mla_w_out[i])
            ckv_list.append(ckv)
            kpe_list.append(kpe)
        xp = xp + gate * out
    y_prompt = rms_norm(xp, final_norm_w)
    new_cache_a_k = jnp.stack(ks_a, axis=1)
    new_cache_a_v = jnp.stack(vs_a, axis=1)
    new_state_ssd_fwd = jnp.stack(sf_list, axis=1)
    new_state_ssd_bwd = jnp.stack(sb_list, axis=1)
    new_cache_mla_ckv = jnp.stack(ckv_list, axis=1)
    new_cache_mla_kpe = jnp.stack(kpe_list, axis=1)

    xl = x_sample
    for layer in range(DEPTH):
        i = layer // 2
        shift, scale, gate = modulation(c, ada_w[layer], ada_b[layer])
        h = rms_norm(xl, norm_w[layer]) * (1.0 + scale) + shift
        if layer % 2 == 0:
            out = ab_latent(h, cache_a_k[:, i], cache_a_v[:, i], state_ssd_fwd[:, i], state_ssd_bwd[:, i],
                            ab_w_in[i], ab_sink[i], ab_conv_w[i], ab_conv_b[i], ab_dt_bias[i], ab_a_log[i],
                            ab_d_skip[i], ab_gnorm_w[i], ab_w_out[i])
        else:
            out = mla_latent(h, cache_mla_ckv[:, i], cache_mla_kpe[:, i], mla_w_in[i], mla_q_norm_w[i],
                             mla_kv_norm_w[i], mla_w_uq[i], mla_w_ukv[i], mla_w_out[i])
        xl = xl + gate * out
    y_sample = rms_norm(xl, final_norm_w)

    return (y_prompt, y_sample, new_cache_a_k, new_cache_a_v, new_state_ssd_fwd, new_state_ssd_bwd,
            new_cache_mla_ckv, new_cache_mla_kpe)
```

```cpp
#include <hip/hip_runtime.h>
#include <hip/hip_cooperative_groups.h>
#include <cstdio>
namespace cg = cooperative_groups;

#ifndef MULTI_LAUNCH
#define MULTI_LAUNCH 0
#endif

typedef unsigned short bf16_t;
using bf16x8 = __attribute__((ext_vector_type(8))) short;
using f32x4  = __attribute__((ext_vector_type(4))) float;
typedef __bf16 bf2v __attribute__((ext_vector_type(2)));
typedef float  fl2v __attribute__((ext_vector_type(2)));
#define DI __device__ __forceinline__
#define MFMA16(a, b, c) __builtin_amdgcn_mfma_f32_16x16x32_bf16((a), (b), (c), 0, 0, 0)

constexpr int NTOK = 16384;
constexpr int NCTX = 8192;
constexpr int NROWK = 16896;
constexpr int ABIN_N = 3712;
constexpr int MIN_N = 1536;
constexpr float EPS = 1e-6f;
constexpr float LOG2E = 1.4426950408889634f;

constexpr size_t O_Y = 0;
constexpr size_t O_CAK = 16777216;
constexpr size_t O_CAV = 17825792;
constexpr size_t O_SF = 18874368;
constexpr size_t O_SB = 20971520;
constexpr size_t O_CKV = 23068672;
constexpr size_t O_KPE = 24117248;

constexpr size_t KB = 1024, MB = 1024 * 1024;
constexpr size_t W_ABIN = 0;
constexpr size_t W_ABOUT = W_ABIN + (size_t)ABIN_N * 1024 * 2;
constexpr size_t W_MIN = W_ABOUT + 1024 * 1536 * 2;
constexpr size_t W_UQ = W_MIN + 1536 * 1024 * 2;
constexpr size_t W_UKV = W_UQ + 1536 * 256 * 2;
constexpr size_t W_MOUT = W_UKV + 2048 * 128 * 2;
constexpr size_t W_END = W_MOUT + 1024 * 1024 * 2;
constexpr size_t WS_ROWSQ = 17 * MB + 768 * KB + 96 * KB;
constexpr size_t WS_ROWSQ_Q = WS_ROWSQ + 64 * KB;
constexpr size_t WS_ZERO_BYTES = 96 * KB + 128 * KB;
constexpr size_t WS_X2B = 50 * MB;
constexpr size_t WS_MODP = 17 * MB + 768 * KB + 16 * KB;
constexpr size_t WS_CDEC = 17 * MB + 512 * KB;
constexpr size_t WS_BAR = 17 * MB + 768 * KB;
constexpr size_t WS_H = 18 * MB;
constexpr size_t WS_XT = 18 * MB;
constexpr size_t WS_XBCR = 50 * MB;
constexpr size_t WS_HIN = 50 * MB;
constexpr size_t WS_QA = 90 * MB;
constexpr size_t WS_KA = 106 * MB;
constexpr size_t WS_VTA = WS_KA + 4352 * KB;
constexpr size_t WS_GA = WS_VTA + 4352 * KB;
constexpr size_t WS_ZS = WS_GA + 16 * MB;
constexpr size_t WS_DTP = WS_ZS + 32 * MB;
constexpr size_t WS_BT = WS_DTP + 2 * MB;
constexpr size_t WS_BCM = WS_BT + 4 * MB;
constexpr size_t WS_SSQ = WS_BCM + 8 * MB;
constexpr size_t WS_STATES = WS_SSQ + 1 * MB;
constexpr size_t WS_L0_END = WS_STATES + 64 * MB;
constexpr size_t WS_AOM = 18 * MB;
constexpr size_t WS_GM = 50 * MB;
constexpr size_t WS_CQN = 82 * MB;
constexpr size_t WS_CKVN = 90 * MB;
constexpr size_t WS_KPEB = WS_CKVN + 4352 * KB;
constexpr size_t WS_QM = WS_KPEB + 1280 * KB;
constexpr size_t WS_KNOPE = WS_QM + 48 * MB;
constexpr size_t WS_VTM = WS_KNOPE + 33 * MB;
constexpr size_t WS_CQ = WS_VTM;
constexpr size_t WS_CKV = WS_CQ + 16 * MB;
constexpr size_t WS_KPE = WS_CKV + 8 * MB;
constexpr size_t WS_X1B = WS_VTM + 33 * MB;
constexpr size_t WS_L1_END = WS_X1B + 32 * MB;
static_assert(W_END <= 17 * MB, "weights");
static_assert(WS_L0_END <= 256 * MB && WS_L1_END <= 256 * MB && WS_X1B >= WS_STATES && WS_X1B >= WS_SSQ + 1 * MB, "workspace");

struct Params {
  const float* in[29];
  float* out;
  unsigned char* ws;
  int ph_lo, ph_hi;
};
enum { I_XP = 0, I_XS, I_CAK, I_CAV, I_SF, I_SB, I_CCKV, I_CKPE, I_C, I_CCTX, I_ADAW, I_ADAB, I_NORMW, I_ABWIN, I_SINK, I_CONVW, I_CONVB,
       I_DTB, I_ALOG, I_DSKIP, I_GNW, I_ABWOUT, I_MWIN, I_QNW, I_KVNW, I_WUQ, I_WUKV, I_MWOUT, I_FNW };

DI unsigned pack2(float a, float b) { fl2v v = {a, b}; bf2v r = __builtin_convertvector(v, bf2v); return __builtin_bit_cast(unsigned, r); }
DI bf16_t f2bf(float a) { return (bf16_t)(pack2(a, 0.f) & 0xffffu); }
DI float bf2f(bf16_t b) { return __uint_as_float(((unsigned)b) << 16); }
DI float bflo(unsigned u) { return __uint_as_float(u << 16); }
DI float bfhi(unsigned u) { return __uint_as_float(u & 0xffff0000u); }
DI float silu_f(float x) { return x * __builtin_amdgcn_rcpf(1.f + __builtin_amdgcn_exp2f(-x * 1.4426950408889634f)); }
DI float softplus_f(float x) { return x > 20.f ? x : log1pf(__expf(x)); }
DI float ex2(float x) { return __builtin_amdgcn_exp2f(x); }
DI bf16x8 mk8(unsigned a, unsigned b, unsigned c, unsigned d) { uint4 u = make_uint4(a, b, c, d); return __builtin_bit_cast(bf16x8, u); }
DI int cond_of(int row) { return row < NCTX ? 0 : 1 + ((row - NCTX) >> 12); }
DI float wave_sum(float v) {
#pragma unroll
  for (int o = 32; o > 0; o >>= 1) v += __shfl_xor(v, o);
  return v;
}
DI float mod_val(const Params& p, int layer, int cond, int which, int c) {
  return ((const float*)(p.ws + WS_MODP))[(layer * 3 + cond) * 3072 + which * 1024 + c];
}
DI void chunk_rows(int gc, int& row0, int& s0, int& s1) {
  if (gc < 64) { int seq = gc >> 1; s0 = seq * 256; s1 = s0 + 256; row0 = s0 + (gc & 1) * 128; }
  else { int g2 = gc - 64; int seq = g2 >> 5; s0 = NCTX + seq * 4096; s1 = s0 + 4096; row0 = s0 + (g2 & 31) * 128; }
}

DI void p0_mod_item(const Params& p, int item, unsigned char* smem) {
  const int tid = threadIdx.x;
  const int kc = item & 31, cgp = (item >> 5) % 12, layer = item / 384;
  float* sl = (float*)smem;
  __syncthreads();
  if (tid < 96) {
    int j = tid >> 5, k = kc * 32 + (tid & 31);
    const float* cv = j == 0 ? p.in[I_CCTX] : p.in[I_C] + (j - 1) * 1024;
    sl[tid] = silu_f(cv[k]);
  }
  __syncthreads();
  const int col = cgp * 256 + tid;
  const float* W = p.in[I_ADAW] + (size_t)layer * 1024 * 3072 + (size_t)(kc * 32) * 3072 + col;
  float wv[32];
#pragma unroll
  for (int kk = 0; kk < 32; ++kk) wv[kk] = W[(size_t)kk * 3072];
  float a0 = 0.f, a1 = 0.f, a2 = 0.f;
#pragma unroll
  for (int kk = 0; kk < 32; ++kk) { a0 += sl[kk] * wv[kk]; a1 += sl[32 + kk] * wv[kk]; a2 += sl[64 + kk] * wv[kk]; }
  if (kc == 0) { float bb = p.in[I_ADAB][layer * 3072 + col]; a0 += bb; a1 += bb; a2 += bb; }
  float* mp = (float*)(p.ws + WS_MODP) + (size_t)layer * 3 * 3072 + col;
  atomicAdd(mp, a0); atomicAdd(mp + 3072, a1); atomicAdd(mp + 6144, a2);
}
DI void p0_wt_tile(const float* src, int ldsrc, bf16_t* dst, int K, int k0, int n0, int nvalid, int mode, const float* rowscale, int rs_off, unsigned char* smem) {
  const int tid = threadIdx.x;
  float* tile = (float*)smem;
  const int c = tid & 63, r0 = tid >> 6;
  int n = n0 + c, sc;
  if (mode == 0) sc = n < nvalid ? n : -1;
  else sc = n < 384 ? n : (n < 1408 ? n + 32 : (n < 1440 ? n - 1024 : -1));
  __syncthreads();
  float vv[16];
#pragma unroll
  for (int i = 0; i < 16; ++i) { int k = k0 + r0 + 4 * i; vv[i] = sc >= 0 ? src[(size_t)k * ldsrc + sc] : 0.f; }
#pragma unroll
  for (int i = 0; i < 16; ++i) {
    int k = k0 + r0 + 4 * i; float v = vv[i];
    if (rowscale && k >= rs_off) v *= rowscale[k - rs_off];
    tile[(r0 + 4 * i) * 65 + c] = v;
  }
  __syncthreads();
  const int nn = tid >> 2, kk0 = (tid & 3) * 16;
  unsigned u[8];
#pragma unroll
  for (int e = 0; e < 8; ++e) u[e] = pack2(tile[(kk0 + 2 * e) * 65 + nn], tile[(kk0 + 2 * e + 1) * 65 + nn]);
  uint4* d = (uint4*)(dst + (size_t)(n0 + nn) * K + k0 + kk0);
  d[0] = make_uint4(u[0], u[1], u[2], u[3]); d[1] = make_uint4(u[4], u[5], u[6], u[7]);
}
constexpr int T_ABIN = 16 * 58, T_ABOUT = 24 * 16, T_MIN = 16 * 24, T_UQ = 4 * 24, T_UKV = 2 * 32, T_MOUT = 16 * 16;
constexpr int N_WT = T_ABIN + T_ABOUT + T_MIN + T_UQ + T_UKV + T_MOUT;
DI void wt_item(const Params& p, int t, unsigned char* smem) {
  if (t < T_ABIN) { int nt = t % 58, kt = t / 58; p0_wt_tile(p.in[I_ABWIN], 3616, (bf16_t*)(p.ws + W_ABIN), 1024, kt * 64, nt * 64, 3616, 0, nullptr, 0, smem); return; }
  t -= T_ABIN;
  if (t < T_ABOUT) { int nt = t % 16, kt = t / 16; p0_wt_tile(p.in[I_ABWOUT], 1024, (bf16_t*)(p.ws + W_ABOUT), 1536, kt * 64, nt * 64, 1024, 0, p.in[I_GNW], 512, smem); return; }
  t -= T_ABOUT;
  if (t < T_MIN) { int nt = t % 24, kt = t / 24; p0_wt_tile(p.in[I_MWIN], 1440, (bf16_t*)(p.ws + W_MIN), 1024, kt * 64, nt * 64, 1440, 1, nullptr, 0, smem); return; }
  t -= T_MIN;
  if (t < T_UQ) { int nt = t % 24, kt = t / 24; p0_wt_tile(p.in[I_WUQ], 1536, (bf16_t*)(p.ws + W_UQ), 256, kt * 64, nt * 64, 1536, 0, p.in[I_QNW], 0, smem); return; }
  t -= T_UQ;
  if (t < T_UKV) { int nt = t % 32, kt = t / 32; p0_wt_tile(p.in[I_WUKV], 2048, (bf16_t*)(p.ws + W_UKV), 128, kt * 64, nt * 64, 2048, 0, nullptr, 0, smem); return; }
  t -= T_UKV;
  { int nt = t % 16, kt = t / 16; p0_wt_tile(p.in[I_MWOUT], 1024, (bf16_t*)(p.ws + W_MOUT), 1024, kt * 64, nt * 64, 1024, 0, nullptr, 0, smem); }
}
DI void phase0(const Params& p, unsigned char* smem) {
  constexpr int N_MOD = 384;
  constexpr int N_CACHE = 64;
  constexpr int N_ALL = N_MOD + N_CACHE;
  for (int item = blockIdx.x; item < N_ALL; item += gridDim.x) {
    if (item < N_MOD) { p0_mod_item(p, item, smem); continue; }
    int t = item - N_MOD;
    const int tid = threadIdx.x;
    if (t < 32) {
      int e0 = t * 2048 + tid * 8;
      const float4* s = (const float4*)(p.in[I_CAK] + e0);
      float4 a = s[0], b = s[1];
      *(uint4*)((bf16_t*)(p.ws + WS_KA) + (size_t)NTOK * 128 + e0) = make_uint4(pack2(a.x, a.y), pack2(a.z, a.w), pack2(b.x, b.y), pack2(b.z, b.w));
    } else {
      int e0 = (t - 32) * 2048 + tid * 8;
      bf16_t* vt = (bf16_t*)(p.ws + WS_VTA);
#pragma unroll
      for (int e = 0; e < 8; ++e) {
        int idx = e0 + e;
        int d = idx & 63, kvh = (idx >> 6) & 1, rj = idx >> 7;
        int row = NTOK + rj;
        vt[((size_t)(row >> 6) * 2 + kvh) * 4096 + d * 64 + (row & 63)] = f2bf(p.in[I_CAV][idx]);
      }
    }
  }
}

DI void phase_modnorm(const Params& p, int layer, unsigned char* smem) {
  const int tid = threadIdx.x, lane = tid & 63, w = tid >> 6;
  float* em = (float*)smem;
  float* ea = em + 3072;
  __syncthreads();
  for (int i = tid; i < 3072; i += 256) {
    int cond = i >> 10, c = i & 1023;
    float sh = mod_val(p, layer, cond, 0, c), sc = mod_val(p, layer, cond, 1, c);
    em[i] = p.in[I_NORMW][layer * 1024 + c] * (1.f + sc); ea[i] = sh;
  }
  __syncthreads();
  bf16_t* H = (bf16_t*)(p.ws + WS_H);
  for (int item = blockIdx.x; item < NTOK / 4; item += gridDim.x) {
    int row = item * 4 + w;
    float4 v[4]; float ss = 0.f;
    if (layer == 0) {
      const float* xr = row < NCTX ? p.in[I_XP] + (size_t)row * 1024 : p.in[I_XS] + (size_t)(row - NCTX) * 1024;
#pragma unroll
      for (int i = 0; i < 4; ++i) v[i] = ((const float4*)xr)[lane + 64 * i];
    } else {
      const uint2* xr = (const uint2*)((const bf16_t*)(p.ws + WS_X1B) + (size_t)row * 1024);
#pragma unroll
      for (int i = 0; i < 4; ++i) { uint2 u = xr[lane + 64 * i]; v[i] = make_float4(bflo(u.x), bfhi(u.x), bflo(u.y), bfhi(u.y)); }
    }
#pragma unroll
    for (int i = 0; i < 4; ++i) ss += v[i].x * v[i].x + v[i].y * v[i].y + v[i].z * v[i].z + v[i].w * v[i].w;
    ss = wave_sum(ss);
    float rstd = rsqrtf(ss * (1.f / 1024.f) + EPS);
    int cond = cond_of(row);
#pragma unroll
    for (int i = 0; i < 4; ++i) {
      int col = (lane + 64 * i) * 4;
      float4 m = *(const float4*)(em + cond * 1024 + col), a = *(const float4*)(ea + cond * 1024 + col);
      uint2 o = make_uint2(pack2(v[i].x * rstd * m.x + a.x, v[i].y * rstd * m.y + a.y), pack2(v[i].z * rstd * m.z + a.z, v[i].w * rstd * m.w + a.w));
      *(uint2*)(H + (size_t)row * 1024 + col) = o;
    }
  }
}

template <bool NARROW = false>
DI void gemm_mainloop(f32x4 (&acc)[4][4], const bf16_t* __restrict__ A, int lda, const bf16_t* __restrict__ B, int ldb, int K, int m0, int n0, unsigned char* smem) {
  const int tid = threadIdx.x, lane = tid & 63, w = tid >> 6, wm = w >> 1, wn = w & 1, lc = lane & 15, g = lane >> 4;
  const int rr = w * 8 + (lane >> 3);
  const int q = (lane & 7) ^ (((w & 1) * 4 + (lane >> 4)) & 7);
  const bf16_t* ga = A + (size_t)(m0 + rr) * lda + q * 8;
  const bf16_t* gb = B + (size_t)(n0 + rr) * ldb + q * 8;
  const int sw = (lc >> 1) & 7;
  const int nk = K >> 6;
#define GSTAGE(s, kt) do { _Pragma("unroll") for (int i = 0; i < 4; ++i) { \
    __builtin_amdgcn_global_load_lds((const unsigned*)(ga + (size_t)(i * 32) * lda + (kt) * 64), (unsigned*)(smem + (s) * 32768 + w * 1024 + i * 4096), 16, 0, 0); \
    if (!NARROW || i == 0) __builtin_amdgcn_global_load_lds((const unsigned*)(gb + (size_t)(i * 32) * ldb + (kt) * 64), (unsigned*)(smem + (s) * 32768 + 16384 + w * 1024 + i * 4096), 16, 0, 0); } } while (0)
  __syncthreads();
  GSTAGE(0, 0);
  asm volatile("s_waitcnt vmcnt(0)" ::: "memory");
  __syncthreads();
  for (int kt = 0; kt < nk; ++kt) {
    const int cur = kt & 1;
    if (kt + 1 < nk) GSTAGE(cur ^ 1, kt + 1);
    const unsigned char* sa = smem + cur * 32768 + (wm * 64 + lc) * 128;
    const unsigned char* sb = smem + cur * 32768 + 16384 + (wn * 64 + lc) * 128;
#pragma unroll
    for (int ks = 0; ks < 2; ++ks) {
      const int co = ((ks * 4 + g) ^ sw) * 16;
      bf16x8 af[4], bfr[4];
      if (NARROW) {
        if (wn == 0) {
#pragma unroll
          for (int i = 0; i < 4; ++i) af[i] = *(const bf16x8*)(sa + i * 2048 + co);
#pragma unroll
          for (int j = 0; j < 2; ++j) bfr[j] = *(const bf16x8*)(sb + j * 2048 + co);
#pragma unroll
          for (int i = 0; i < 4; ++i)
#pragma unroll
            for (int j = 0; j < 2; ++j) acc[i][j] = MFMA16(af[i], bfr[j], acc[i][j]);
        }
      } else {
#pragma unroll
        for (int i = 0; i < 4; ++i) af[i] = *(const bf16x8*)(sa + i * 2048 + co);
#pragma unroll
        for (int j = 0; j < 4; ++j) bfr[j] = *(const bf16x8*)(sb + j * 2048 + co);
#pragma unroll
        for (int i = 0; i < 4; ++i)
#pragma unroll
          for (int j = 0; j < 4; ++j) acc[i][j] = MFMA16(af[i], bfr[j], acc[i][j]);
      }
    }
    asm volatile("s_waitcnt vmcnt(0)" ::: "memory");
    __syncthreads();
  }
#undef GSTAGE
}
DI void acc_zero(f32x4 (&acc)[4][4]) {
#pragma unroll
  for (int i = 0; i < 4; ++i)
#pragma unroll
    for (int j = 0; j < 4; ++j) acc[i][j] = f32x4{0.f, 0.f, 0.f, 0.f};
}
DI void rope64(f32x4 (&acc)[4][4], int rowbase  , int lc, int g) {
  const float inv = ex2(-(float)lc * (13.287712379549449f / 16.f));
#pragma unroll
  for (int i = 0; i < 4; ++i)
#pragma unroll
    for (int r = 0; r < 4; ++r) {
      int l = (rowbase + i * 16 + 4 * g + r - NCTX) & 4095;
      float tr = (float)(l >> 6) * inv, tc = (float)(l & 63) * inv;
      float cr = __cosf(tr), sr = __sinf(tr), cc = __cosf(tc), sc = __sinf(tc);
      float a = acc[i][0][r], b = acc[i][1][r];
      acc[i][0][r] = a * cr - b * sr; acc[i][1][r] = b * cr + a * sr;
      a = acc[i][2][r]; b = acc[i][3][r];
      acc[i][2][r] = a * cc - b * sc; acc[i][3][r] = b * cc + a * sc;
    }
}

DI float* stage_wave_tile(const f32x4 (&acc)[4][4], unsigned char* smem) {
  const int lane = threadIdx.x & 63, w = threadIdx.x >> 6, lc = lane & 15, g = lane >> 4;
  float* wb = (float*)smem + w * (64 * 68);
#pragma unroll
  for (int i = 0; i < 4; ++i)
#pragma unroll
    for (int j = 0; j < 4; ++j)
#pragma unroll
      for (int r = 0; r < 4; ++r) wb[(i * 16 + 4 * g + r) * 68 + j * 16 + lc] = acc[i][j][r];
  __builtin_amdgcn_wave_barrier();
  return wb;
}
DI uint2 pk4(float4 v) { return make_uint2(pack2(v.x, v.y), pack2(v.z, v.w)); }
DI float4 silu4(float4 v) { return make_float4(silu_f(v.x), silu_f(v.y), silu_f(v.z), silu_f(v.w)); }
DI void xcd_tile(int v, int NT, int& mt, int& nt) { const int x = v & 7, j = v >> 3; mt = (j / NT) * 8 + x; nt = j % NT; }

DI void phase_ab_in(const Params& p, unsigned char* smem) {
  const int tid = threadIdx.x, lane = tid & 63, w = tid >> 6, wm = w >> 1, wn = w & 1, lc = lane & 15, g = lane >> 4;
  const bf16_t* H = (const bf16_t*)(p.ws + WS_H);
  const bf16_t* W = (const bf16_t*)(p.ws + W_ABIN);
  bf16_t* QA = (bf16_t*)(p.ws + WS_QA); bf16_t* KA = (bf16_t*)(p.ws + WS_KA); bf16_t* VTA = (bf16_t*)(p.ws + WS_VTA);
  bf16_t* GA = (bf16_t*)(p.ws + WS_GA); bf16_t* ZS = (bf16_t*)(p.ws + WS_ZS); bf16_t* XB = (bf16_t*)(p.ws + WS_XBCR);
  float* DTP = (float*)(p.ws + WS_DTP);
  constexpr int NT = ABIN_N / 128;
  for (int tile = blockIdx.x; tile < 128 * NT; tile += gridDim.x) {
    int mt, nt; if (tile < 128 * (NT - 1)) xcd_tile(tile, NT - 1, mt, nt); else { mt = tile - 128 * (NT - 1); nt = NT - 1; }
    const int m0 = mt * 128, n0 = nt * 128;
    f32x4 acc[4][4]; acc_zero(acc);
    if (n0 >= 3584) gemm_mainloop<true>(acc, H, 1024, W, 1024, 1024, m0, n0, smem); else gemm_mainloop<false>(acc, H, 1024, W, 1024, 1024, m0, n0, smem);
    const int rb = m0 + wm * 64, cb = n0 + wn * 64;
    const bool lat = m0 >= NCTX;
    if (n0 < 640 && lat) rope64(acc, rb, lc, g);
    if (n0 >= 640 && n0 < 768) {
#pragma unroll
      for (int i = 0; i < 4; ++i)
#pragma unroll
        for (int j = 0; j < 4; ++j) {
          int row = rb + i * 16 + 4 * g, d = j * 16 + lc;
          *(uint2*)(VTA + ((size_t)(row >> 6) * 2 + wn) * 4096 + d * 64 + (row & 63)) = make_uint2(pack2(acc[i][j][0], acc[i][j][1]), pack2(acc[i][j][2], acc[i][j][3]));
        }
    }
    if (n0 < 3584) {
      const float* wb = stage_wave_tile(acc, smem);
      const int c4 = (lane & 15) * 4, col = cb + c4;
#pragma unroll 4
      for (int it = 0; it < 16; ++it) {
        const int rl = it * 4 + (lane >> 4); const size_t row = (size_t)(rb + rl);
        float4 v = *(const float4*)(wb + rl * 68 + c4);
        if (n0 < 512) { const float qs = 0.125f * LOG2E; *(uint2*)(QA + row * 512 + col) = pk4(make_float4(v.x * qs, v.y * qs, v.z * qs, v.w * qs)); }
        else if (n0 < 640) { *(uint2*)(KA + row * 128 + col - 512) = pk4(v); if (!lat) *(float4*)(p.out + O_CAK + row * 128 + col - 512) = v; }
        else if (n0 < 768) { if (!lat) *(float4*)(p.out + O_CAV + row * 128 + col - 640) = v; }
        else if (n0 < 1280) *(uint2*)(GA + row * 512 + col - 768) = pk4(silu4(v));
        else if (n0 < 2304) *(uint2*)(ZS + row * 1024 + col - 1280) = pk4(silu4(v));
        else *(uint2*)(XB + row * 1280 + col - 2304) = pk4(v);
      }
    } else if (wn == 0) {
#pragma unroll
      for (int i = 0; i < 4; ++i)
#pragma unroll
        for (int j = 0; j < 2; ++j)
#pragma unroll
          for (int r = 0; r < 4; ++r) {
            int row = rb + i * 16 + 4 * g + r, col = j * 16 + lc;
            DTP[(size_t)row * 32 + col] = softplus_f(acc[i][j][r] + p.in[I_DTB][col]);
          }
    }
  }
}

DI void phase_conv(const Params& p, unsigned char* smem) {
  const int tid = threadIdx.x;
  bf16_t* raw = (bf16_t*)smem;
  bf16_t* outl = raw + 132 * 64;
  const bf16_t* XB = (const bf16_t*)(p.ws + WS_XBCR);
  bf16_t* XT = (bf16_t*)(p.ws + WS_XT); bf16_t* BT = (bf16_t*)(p.ws + WS_BT); bf16_t* BCM = (bf16_t*)(p.ws + WS_BCM);
  for (int item = blockIdx.x; item < 128 * 20; item += gridDim.x) {
    const int gc = item / 20, cgp = item % 20;
    int row0, s0, s1; chunk_rows(gc, row0, s0, s1);
    __syncthreads();
    for (int c = tid; c < 132 * 8; c += 256) {
      int t = c >> 3, c8 = c & 7, row = row0 - 2 + t;
      uint4 v = make_uint4(0, 0, 0, 0);
      if (row >= s0 && row < s1) v = *(const uint4*)(XB + (size_t)row * 1280 + cgp * 64 + c8 * 8);
      *(uint4*)(raw + t * 64 + c8 * 8) = v;
    }
    __syncthreads();
    {
      const int c = tid & 63, tg = tid >> 6, ch = cgp * 64 + c;
      float wv[5];
#pragma unroll
      for (int j = 0; j < 5; ++j) wv[j] = p.in[I_CONVW][j * 1280 + ch];
      const float bias = p.in[I_CONVB][ch];
      float x0 = bf2f(raw[(tg * 32 + 0) * 64 + c]), x1 = bf2f(raw[(tg * 32 + 1) * 64 + c]), x2 = bf2f(raw[(tg * 32 + 2) * 64 + c]), x3 = bf2f(raw[(tg * 32 + 3) * 64 + c]);
#pragma unroll 8
      for (int t = 0; t < 32; ++t) {
        int tt = tg * 32 + t;
        float x4 = bf2f(raw[(tt + 4) * 64 + c]);
        float o = bias + wv[0] * x0 + wv[1] * x1 + wv[2] * x2 + wv[3] * x3 + wv[4] * x4;
        outl[tt * 66 + c] = f2bf(silu_f(o));
        x0 = x1; x1 = x2; x2 = x3; x3 = x4;
      }
    }
    __syncthreads();
    if (cgp >= 16) {
      for (int c = tid; c < 1024; c += 256) {
        int tt = c >> 3, c8 = c & 7;
        const unsigned* s = (const unsigned*)(outl + tt * 66 + c8 * 8);
        *(uint4*)(BCM + (size_t)(row0 + tt) * 256 + (cgp - 16) * 64 + c8 * 8) = make_uint4(s[0], s[1], s[2], s[3]);
      }
    }
    if (cgp < 18) {
      for (int c = tid; c < 1024; c += 256) {
        int ch = c >> 4, t8 = c & 15;
        unsigned u[4];
#pragma unroll
        for (int e = 0; e < 4; ++e) u[e] = (unsigned)outl[(t8 * 8 + 2 * e) * 66 + ch] | ((unsigned)outl[(t8 * 8 + 2 * e + 1) * 66 + ch] << 16);
        bf16_t* dst = cgp < 16 ? XT + ((size_t)gc * 1024 + cgp * 64 + ch) * 128 + t8 * 8 : BT + ((size_t)gc * 128 + (cgp - 16) * 64 + ch) * 128 + t8 * 8;
        *(uint4*)dst = make_uint4(u[0], u[1], u[2], u[3]);
      }
    }
  }
}

DI float chunk_cums(const Params& p, int row0, int head, int dir, int lane, float* dtv, float* cumv, float* facv) {
  const float* DTP = (const float*)(p.ws + WS_DTP);
  const float a = -__expf(p.in[I_ALOG][dir * 16 + head]);
  float d0 = DTP[(size_t)(row0 + 2 * lane) * 32 + dir * 16 + head], d1 = DTP[(size_t)(row0 + 2 * lane + 1) * 32 + dir * 16 + head];
  float v0 = d0 * a, v1 = d1 * a, s = v0 + v1, sc = s;
#pragma unroll
  for (int o = 1; o < 64; o <<= 1) { float t = __shfl_up(sc, o); if (lane >= o) sc += t; }
  float total = __shfl(sc, 63);
  float e = sc - s, c0 = e + v0, c1 = e + s;
  if (facv) {
    dtv[dir * 128 + 2 * lane] = d0; dtv[dir * 128 + 2 * lane + 1] = d1;
    if (dir == 0) {
      cumv[2 * lane] = c0; cumv[2 * lane + 1] = c1;
      facv[2 * lane] = d0 * __expf(total - c0); facv[2 * lane + 1] = d1 * __expf(total - c1);
    } else {
      cumv[128 + 2 * lane] = total - c0 + v0; cumv[128 + 2 * lane + 1] = total - c1 + v1;
      facv[128 + 2 * lane] = d0 * __expf(c0 - v0); facv[128 + 2 * lane + 1] = d1 * __expf(c1 - v1);
    }
  } else {
    const float q0 = dir == 0 ? c0 : total - c0 + v0, q1 = dir == 0 ? c1 : total - c1 + v1;
    cumv[dir * 128 + 2 * lane] = q0 * LOG2E; cumv[dir * 128 + 2 * lane + 1] = q1 * LOG2E;
    dtv[dir * 128 + 2 * lane] = q0 * LOG2E - __log2f(d0); dtv[dir * 128 + 2 * lane + 1] = q1 * LOG2E - __log2f(d1);
  }
  return total;
}

DI void phase_ssd_states(const Params& p, unsigned char* smem) {
  const int tid = threadIdx.x, lane = tid & 63, w = tid >> 6, lc = lane & 15, g = lane >> 4;
  bf16_t* xf = (bf16_t*)smem;
  bf16_t* xb = xf + 64 * 136;
  bf16_t* bt = xb + 64 * 136;
  float* dtv = (float*)(bt + 64 * 136);
  float* cumv = dtv + 256;
  float* facv = cumv + 256;
  const bf16_t* XT = (const bf16_t*)(p.ws + WS_XT); const bf16_t* BT = (const bf16_t*)(p.ws + WS_BT);
  float* ST = (float*)(p.ws + WS_STATES); float* CD = (float*)(p.ws + WS_CDEC);
  for (int item = blockIdx.x; item < 2048; item += gridDim.x) {
    const int gc = item >> 4, head = item & 15, grp = head >> 3;
    int row0, s0, s1; chunk_rows(gc, row0, s0, s1);
    __syncthreads();
    if (w < 2) {
      float total = chunk_cums(p, row0, head, w, lane, dtv, cumv, facv);
      if (lane == 0) CD[(gc * 2 + w) * 16 + head] = __expf(total);
    }
    __syncthreads();
#pragma unroll
    for (int i = 0; i < 4; ++i) {
      int id = tid + 256 * i, r = id >> 4, c16 = id & 15;
      uint4 xv = *(const uint4*)(XT + ((size_t)gc * 1024 + head * 64 + r) * 128 + c16 * 8);
      uint4 bv = *(const uint4*)(BT + ((size_t)gc * 128 + grp * 64 + r) * 128 + c16 * 8);
      *(uint4*)(bt + r * 136 + c16 * 8) = bv;
      const float* ff = facv + c16 * 8; const float* fb = facv + 128 + c16 * 8;
      unsigned xs[4] = {xv.x, xv.y, xv.z, xv.w}, of[4], ob[4];
#pragma unroll
      for (int e = 0; e < 4; ++e) {
        float lo = bflo(xs[e]), hi = bfhi(xs[e]);
        of[e] = pack2(lo * ff[2 * e], hi * ff[2 * e + 1]); ob[e] = pack2(lo * fb[2 * e], hi * fb[2 * e + 1]);
      }
      *(uint4*)(xf + r * 136 + c16 * 8) = make_uint4(of[0], of[1], of[2], of[3]);
      *(uint4*)(xb + r * 136 + c16 * 8) = make_uint4(ob[0], ob[1], ob[2], ob[3]);
    }
    __syncthreads();
    f32x4 af[4], ab[4];
#pragma unroll
    for (int j = 0; j < 4; ++j) { af[j] = f32x4{0, 0, 0, 0}; ab[j] = f32x4{0, 0, 0, 0}; }
#pragma unroll
    for (int ks = 0; ks < 4; ++ks) {
      bf16x8 a_f = *(const bf16x8*)(xf + (w * 16 + lc) * 136 + ks * 32 + g * 8);
      bf16x8 a_b = *(const bf16x8*)(xb + (w * 16 + lc) * 136 + ks * 32 + g * 8);
#pragma unroll
      for (int j = 0; j < 4; ++j) {
        bf16x8 b = *(const bf16x8*)(bt + (j * 16 + lc) * 136 + ks * 32 + g * 8);
        af[j] = MFMA16(a_f, b, af[j]); ab[j] = MFMA16(a_b, b, ab[j]);
      }
    }
    bf16_t* o0 = (bf16_t*)ST + ((size_t)(gc * 2 + 0) * 16 + head) * 4096; bf16_t* o1 = (bf16_t*)ST + ((size_t)(gc * 2 + 1) * 16 + head) * 4096;
    const bool odd = lc & 1;
#pragma unroll
    for (int j = 0; j < 4; ++j) {
      const int n2 = j * 16 + (lc & ~1), pb = w * 16 + 4 * g + (odd ? 2 : 0);
      {
        const float y0 = __shfl_xor(odd ? af[j][0] : af[j][2], 1), y1 = __shfl_xor(odd ? af[j][1] : af[j][3], 1);
        const unsigned u0 = odd ? pack2(y0, af[j][2]) : pack2(af[j][0], y0), u1 = odd ? pack2(y1, af[j][3]) : pack2(af[j][1], y1);
        *(unsigned*)(o0 + (pb + 0) * 64 + n2) = u0; *(unsigned*)(o0 + (pb + 1) * 64 + n2) = u1;
      }
      {
        const float y0 = __shfl_xor(odd ? ab[j][0] : ab[j][2], 1), y1 = __shfl_xor(odd ? ab[j][1] : ab[j][3], 1);
        const unsigned u0 = odd ? pack2(y0, ab[j][2]) : pack2(ab[j][0], y0), u1 = odd ? pack2(y1, ab[j][3]) : pack2(ab[j][1], y1);
        *(unsigned*)(o1 + (pb + 0) * 64 + n2) = u0; *(unsigned*)(o1 + (pb + 1) * 64 + n2) = u1;
      }
    }
  }
}

struct AttnArgs {
  const bf16_t* q; int ldq;
  const bf16_t* k; int ldk;
  const bf16_t* kpe;
  const bf16_t* vt; int vt_heads, vhead;
  const bf16_t* gate; int ldg;
  bf16_t* out; int ldo;
  int qrow0, qpos0;
  int seg0_row, seg0_n, seg0_pos, band;
  int seg1_row, seg1_n;
  float sink2; int has_sink; float scale2;
};
using f32x16 = __attribute__((ext_vector_type(16))) float;
#define MFMA32(a, b, c) __builtin_amdgcn_mfma_f32_32x32x16_bf16((a), (b), (c), 0, 0, 0)
template <int DK, bool MLA>
DI void attn_item(const AttnArgs& a, unsigned char* smem, bool dost = true) {
  constexpr int KS = DK / 16, KSTR = DK + 8, KCH = DK / 8, VSTR = 68;
  const int tid = threadIdx.x, lane = tid & 63, w = tid >> 6, r32 = lane & 31, h = lane >> 5;
  bf16_t* sK = (bf16_t*)smem;
  bf16_t* sV = sK + 64 * KSTR;
  bf16x8 qf[KS];
#pragma unroll
  for (int ks = 0; ks < KS; ++ks) qf[ks] = *(const bf16x8*)(a.q + (size_t)(a.qrow0 + w * 32 + r32) * a.ldq + ks * 16 + h * 8);
  f32x16 O[2], L;
#pragma unroll
  for (int i = 0; i < 16; ++i) { O[0][i] = 0.f; O[1][i] = 0.f; L[i] = a.has_sink ? 1.f : 0.f; }
  float mrow = a.has_sink ? a.sink2 : -1e30f;
  const bf16x8 ones = mk8(0x3F803F80u, 0x3F803F80u, 0x3F803F80u, 0x3F803F80u);
  const int ntiles = (a.seg0_n + a.seg1_n) >> 6;
  const int qpos = a.qpos0 + w * 32 + r32;
  uint4 pk0, pk1, pk2, pv0, pv1;
#define KR(i) ((tid + 256 * (i)) / KCH)
#define KQ(i) ((tid + 256 * (i)) % KCH)
#define KSRC(i, krow) ((!MLA || KQ(i) < 8) ? a.k + (size_t)((krow) + KR(i)) * a.ldk + KQ(i) * 8 : a.kpe + (size_t)((krow) + KR(i)) * 32 + (KQ(i) - 8) * 8)
  const int vr = tid >> 3, vq = tid & 7;
#define ATT_LOAD(t_) do { const int kk0_ = (t_) * 64; const int krow_ = kk0_ < a.seg0_n ? a.seg0_row + kk0_ : a.seg1_row + kk0_ - a.seg0_n; \
    pk0 = *(const uint4*)KSRC(0, krow_); pk1 = *(const uint4*)KSRC(1, krow_); if (MLA) pk2 = *(const uint4*)KSRC(2, krow_); \
    const bf16_t* vsrc_ = a.vt + ((size_t)(krow_ >> 6) * a.vt_heads + a.vhead) * 4096; \
    pv0 = *(const uint4*)(vsrc_ + vr * 64 + vq * 8); pv1 = *(const uint4*)(vsrc_ + (vr + 32) * 64 + vq * 8); } while (0)
  ATT_LOAD(0);
  for (int t = 0; t < ntiles; ++t) {
    const int kk0 = t * 64; const bool loc = kk0 < a.seg0_n;
    __syncthreads();
    *(uint4*)(sK + KR(0) * KSTR + KQ(0) * 8) = pk0; *(uint4*)(sK + KR(1) * KSTR + KQ(1) * 8) = pk1; if (MLA) *(uint4*)(sK + KR(2) * KSTR + KQ(2) * 8) = pk2;
    *(uint2*)(sV + vr * VSTR + vq * 8) = make_uint2(pv0.x, pv0.y); *(uint2*)(sV + vr * VSTR + vq * 8 + 4) = make_uint2(pv0.z, pv0.w);
    *(uint2*)(sV + (vr + 32) * VSTR + vq * 8) = make_uint2(pv1.x, pv1.y); *(uint2*)(sV + (vr + 32) * VSTR + vq * 8 + 4) = make_uint2(pv1.z, pv1.w);
    __syncthreads();
    if (t + 1 < ntiles) ATT_LOAD(t + 1);
    f32x16 S[2];
#pragma unroll
    for (int i = 0; i < 16; ++i) { S[0][i] = 0.f; S[1][i] = 0.f; }
#pragma unroll
    for (int ks = 0; ks < KS; ++ks)
#pragma unroll
      for (int kt = 0; kt < 2; ++kt) {
        bf16x8 kf = *(const bf16x8*)(sK + (kt * 32 + r32) * KSTR + ks * 16 + h * 8);
        S[kt] = MFMA32(kf, qf[ks], S[kt]);
      }
    const bool msk = a.band && loc;
    float m = -1e30f;
#pragma unroll
    for (int kt = 0; kt < 2; ++kt)
#pragma unroll
      for (int ri = 0; ri < 16; ++ri) {
        float v = S[kt][ri];
        if (msk) { int dlt = a.seg0_pos + kk0 + kt * 32 + (ri & 3) + 8 * (ri >> 2) + 4 * h - qpos; if (dlt > 128 || dlt < -128) v = -1e30f; S[kt][ri] = v; }
        m = fmaxf(m, v);
      }
    m = fmaxf(m, __shfl_xor(m, 32));
    if (__builtin_amdgcn_ballot_w64(m > mrow + 8.f) != 0ull) {
      const float mnew = fmaxf(mrow, m), alpha = ex2(mrow - mnew);
      mrow = mnew;
#pragma unroll
      for (int i = 0; i < 16; ++i) { O[0][i] *= alpha; O[1][i] *= alpha; L[i] *= alpha; }
    }
#pragma unroll
    for (int kt = 0; kt < 2; ++kt)
#pragma unroll
      for (int s2 = 0; s2 < 2; ++s2) {
        const bf16x8 pf = mk8(pack2(ex2(S[kt][8 * s2 + 0] - mrow), ex2(S[kt][8 * s2 + 1] - mrow)), pack2(ex2(S[kt][8 * s2 + 2] - mrow), ex2(S[kt][8 * s2 + 3] - mrow)),
                              pack2(ex2(S[kt][8 * s2 + 4] - mrow), ex2(S[kt][8 * s2 + 5] - mrow)), pack2(ex2(S[kt][8 * s2 + 6] - mrow), ex2(S[kt][8 * s2 + 7] - mrow)));
        L = MFMA32(ones, pf, L);
#pragma unroll
        for (int dt = 0; dt < 2; ++dt) {
          const bf16_t* vp = sV + (dt * 32 + r32) * VSTR + kt * 32 + 16 * s2 + 4 * h;
          const uint2 lo = *(const uint2*)vp, hi = *(const uint2*)(vp + 8);
          O[dt] = MFMA32(mk8(lo.x, lo.y, hi.x, hi.y), pf, O[dt]);
        }
      }
  }
#undef KR
#undef KQ
#undef KSRC
#undef ATT_LOAD
  {
    const float inv = 1.f / L[0];
    const size_t row = (size_t)(a.qrow0 + w * 32 + r32);
#pragma unroll
    for (int dt = 0; dt < 2; ++dt)
#pragma unroll
      for (int gq = 0; gq < 4; ++gq) {
        const int d0 = dt * 32 + 8 * gq + 4 * h;
        const uint2 gt = *(const uint2*)(a.gate + row * a.ldg + d0);
        const float o0 = O[dt][4 * gq + 0] * inv * bflo(gt.x), o1 = O[dt][4 * gq + 1] * inv * bfhi(gt.x), o2 = O[dt][4 * gq + 2] * inv * bflo(gt.y), o3 = O[dt][4 * gq + 3] * inv * bfhi(gt.y);
        if (dost) *(uint2*)(a.out + row * a.ldo + d0) = make_uint2(pack2(o0, o1), pack2(o2, o3));
      }
  }
}

template <int DK, bool MLA>
DI void attn_item2(const AttnArgs& a, unsigned char* smem) {
  constexpr int KS = DK / 16, KSTR = DK + 8, KCH = DK / 8, VSTR = 68;
  const int tid = threadIdx.x, lane = tid & 63, w = tid >> 6, r32 = lane & 31, h = lane >> 5;
  bf16_t* sK = (bf16_t*)smem;
  bf16_t* sV = sK + 64 * KSTR;
  bf16_t* sQ = sV + 64 * VSTR;
  __syncthreads();
  for (int c = tid; c < 256 * KCH; c += 256) { const int r = c / KCH, cc = c % KCH; *(uint4*)(sQ + r * KSTR + cc * 8) = *(const uint4*)(a.q + (size_t)(a.qrow0 + r) * a.ldq + cc * 8); }
  const bf16_t* sQw = sQ + (w * 64 + r32) * KSTR + h * 8;
  f32x16 O[2][2];
#pragma unroll
  for (int i = 0; i < 16; ++i) { O[0][0][i] = 0.f; O[0][1][i] = 0.f; O[1][0][i] = 0.f; O[1][1][i] = 0.f; }
  float mrow[2], lsum[2];
  mrow[0] = mrow[1] = a.has_sink ? a.sink2 : -1e30f;
  lsum[0] = lsum[1] = (a.has_sink && h == 0) ? 1.f : 0.f;
  const int ntiles = (a.seg0_n + a.seg1_n) >> 6;
  uint4 pk0, pk1, pk2, pv0, pv1;
#define KR(i) ((tid + 256 * (i)) / KCH)
#define KQ(i) ((tid + 256 * (i)) % KCH)
#define KSRC(i, krow) ((!MLA || KQ(i) < 8) ? a.k + (size_t)((krow) + KR(i)) * a.ldk + KQ(i) * 8 : a.kpe + (size_t)((krow) + KR(i)) * 32 + (KQ(i) - 8) * 8)
  const int vr = tid >> 3, vq = tid & 7;
#define ATT_LOAD(t_) do { const int kk0_ = (t_) * 64; const int krow_ = kk0_ < a.seg0_n ? a.seg0_row + kk0_ : a.seg1_row + kk0_ - a.seg0_n; \
    pk0 = *(const uint4*)KSRC(0, krow_); pk1 = *(const uint4*)KSRC(1, krow_); if (MLA) pk2 = *(const uint4*)KSRC(2, krow_); \
    const bf16_t* vsrc_ = a.vt + ((size_t)(krow_ >> 6) * a.vt_heads + a.vhead) * 4096; \
    pv0 = *(const uint4*)(vsrc_ + vr * 64 + vq * 8); pv1 = *(const uint4*)(vsrc_ + (vr + 32) * 64 + vq * 8); } while (0)
  ATT_LOAD(0);
  for (int t = 0; t < ntiles; ++t) {
    __syncthreads();
    *(uint4*)(sK + KR(0) * KSTR + KQ(0) * 8) = pk0; *(uint4*)(sK + KR(1) * KSTR + KQ(1) * 8) = pk1; if (MLA) *(uint4*)(sK + KR(2) * KSTR + KQ(2) * 8) = pk2;
    *(uint2*)(sV + vr * VSTR + vq * 8) = make_uint2(pv0.x, pv0.y); *(uint2*)(sV + vr * VSTR + vq * 8 + 4) = make_uint2(pv0.z, pv0.w);
    *(uint2*)(sV + (vr + 32) * VSTR + vq * 8) = make_uint2(pv1.x, pv1.y); *(uint2*)(sV + (vr + 32) * VSTR + vq * 8 + 4) = make_uint2(pv1.z, pv1.w);
    __syncthreads();
    if (t + 1 < ntiles) ATT_LOAD(t + 1);
    f32x16 S[2][2];
#pragma unroll
    for (int i = 0; i < 16; ++i) { S[0][0][i] = 0.f; S[0][1][i] = 0.f; S[1][0][i] = 0.f; S[1][1][i] = 0.f; }
#pragma unroll
    for (int ks = 0; ks < KS; ++ks)
#pragma unroll
      for (int kt = 0; kt < 2; ++kt) {
        bf16x8 kf = *(const bf16x8*)(sK + (kt * 32 + r32) * KSTR + ks * 16 + h * 8);
        const bf16x8 q0 = *(const bf16x8*)(sQw + ks * 16), q1 = *(const bf16x8*)(sQw + 32 * KSTR + ks * 16);
        S[0][kt] = MFMA32(kf, q0, S[0][kt]); S[1][kt] = MFMA32(kf, q1, S[1][kt]);
      }
    float mx[2];
#pragma unroll
    for (int gq = 0; gq < 2; ++gq) {
      float m = -1e30f;
#pragma unroll
      for (int kt = 0; kt < 2; ++kt)
#pragma unroll
        for (int ri = 0; ri < 16; ++ri) m = fmaxf(m, S[gq][kt][ri]);
      mx[gq] = fmaxf(m, __shfl_xor(m, 32));
    }
    if (__builtin_amdgcn_ballot_w64((mx[0] > mrow[0] + 8.f) || (mx[1] > mrow[1] + 8.f)) != 0ull) {
#pragma unroll
      for (int gq = 0; gq < 2; ++gq) {
        const float mnew = fmaxf(mrow[gq], mx[gq]), alpha = ex2(mrow[gq] - mnew);
        mrow[gq] = mnew; lsum[gq] *= alpha;
#pragma unroll
        for (int i = 0; i < 16; ++i) { O[gq][0][i] *= alpha; O[gq][1][i] *= alpha; }
      }
    }
#pragma unroll
    for (int kt = 0; kt < 2; ++kt)
#pragma unroll
      for (int s2 = 0; s2 < 2; ++s2) {
        bf16x8 pf[2];
#pragma unroll
        for (int gq = 0; gq < 2; ++gq) {
          float e[8];
#pragma unroll
          for (int j = 0; j < 8; ++j) e[j] = ex2(S[gq][kt][8 * s2 + j] - mrow[gq]);
          lsum[gq] += ((e[0] + e[1]) + (e[2] + e[3])) + ((e[4] + e[5]) + (e[6] + e[7]));
          pf[gq] = mk8(pack2(e[0], e[1]), pack2(e[2], e[3]), pack2(e[4], e[5]), pack2(e[6], e[7]));
        }
#pragma unroll
        for (int dt = 0; dt < 2; ++dt) {
          const bf16_t* vp = sV + (dt * 32 + r32) * VSTR + kt * 32 + 16 * s2 + 4 * h;
          const uint2 lo = *(const uint2*)vp, hi = *(const uint2*)(vp + 8);
          const bf16x8 vf = mk8(lo.x, lo.y, hi.x, hi.y);
          O[0][dt] = MFMA32(vf, pf[0], O[0][dt]); O[1][dt] = MFMA32(vf, pf[1], O[1][dt]);
        }
      }
  }
#undef KR
#undef KQ
#undef KSRC
#undef ATT_LOAD
#pragma unroll
  for (int gq = 0; gq < 2; ++gq) {
    const float l = lsum[gq] + __shfl_xor(lsum[gq], 32);
    const float inv = 1.f / l;
    const size_t row = (size_t)(a.qrow0 + w * 64 + gq * 32 + r32);
#pragma unroll
    for (int dt = 0; dt < 2; ++dt)
#pragma unroll
      for (int g4 = 0; g4 < 4; ++g4) {
        const int d0 = dt * 32 + 8 * g4 + 4 * h;
        const uint2 gt = *(const uint2*)(a.gate + row * a.ldg + d0);
        const float o0 = O[gq][dt][4 * g4 + 0] * inv * bflo(gt.x), o1 = O[gq][dt][4 * g4 + 1] * inv * bfhi(gt.x), o2 = O[gq][dt][4 * g4 + 2] * inv * bflo(gt.y), o3 = O[gq][dt][4 * g4 + 3] * inv * bfhi(gt.y);
        *(uint2*)(a.out + row * a.ldo + d0) = make_uint2(pack2(o0, o1), pack2(o2, o3));
      }
  }
}

DI void scan_item(const Params& p, int it, bool latent, bool dost = true) {
  const int tid = threadIdx.x;
  const int quarter = it & 3, head = (it >> 2) & 15, dir = (it >> 6) & 1, b = it >> 7;
  const int e = quarter * 1024 + tid * 4;
  const float* ST = (const float*)(p.ws + WS_STATES); const float* CD = (const float*)(p.ws + WS_CDEC);
  bf16_t* HIN = (bf16_t*)(p.ws + WS_HIN);
  float4 h = make_float4(0.f, 0.f, 0.f, 0.f);
  const int nc = latent ? 32 : 2, gc0 = latent ? 64 + b * 32 : b * 2;
  if (latent) h = *(const float4*)((dir == 0 ? p.in[I_SF] : p.in[I_SB]) + ((size_t)b * 16 + head) * 4096 + e);
  if (latent) {
    for (int s0 = 0; s0 < 32; s0 += 8) {
      float4 st[8]; float dec[8];
#pragma unroll
      for (int u = 0; u < 8; ++u) {
        const int c = dir == 0 ? s0 + u : 31 - s0 - u;
        const size_t base = ((size_t)((gc0 + c) * 2 + dir) * 16 + head);
        dec[u] = CD[base]; { const uint2 q2 = *(const uint2*)((const bf16_t*)ST + base * 4096 + e); st[u] = make_float4(bflo(q2.x), bfhi(q2.x), bflo(q2.y), bfhi(q2.y)); }
      }
#pragma unroll
      for (int u = 0; u < 8; ++u) {
        const int c = dir == 0 ? s0 + u : 31 - s0 - u;
        const size_t base = ((size_t)((gc0 + c) * 2 + dir) * 16 + head);
        if (dost) *(uint2*)(HIN + base * 4096 + e) = make_uint2(pack2(h.x, h.y), pack2(h.z, h.w));
        h.x = h.x * dec[u] + st[u].x; h.y = h.y * dec[u] + st[u].y; h.z = h.z * dec[u] + st[u].z; h.w = h.w * dec[u] + st[u].w;
      }
    }
  }
}
DI void scan_ctx_item(const Params& p, int it, bool dost = true) {
  const int tid = threadIdx.x;
  const int head = it & 15, dir = (it >> 4) & 1, b = it >> 5;
  const float* ST = (const float*)(p.ws + WS_STATES); const float* CD = (const float*)(p.ws + WS_CDEC);
  bf16_t* HIN = (bf16_t*)(p.ws + WS_HIN);
  const int c0 = dir == 0 ? 0 : 1, c1 = 1 - c0;
  const size_t b0 = ((size_t)((b * 2 + c0) * 2 + dir) * 16 + head), b1 = ((size_t)((b * 2 + c1) * 2 + dir) * 16 + head);
  const float dec1 = CD[b1];
  float4 s0[4], s1[4];
#pragma unroll
  for (int qq = 0; qq < 4; ++qq) { const int e = qq * 1024 + tid * 4; const uint2 q0 = *(const uint2*)((const bf16_t*)ST + b0 * 4096 + e), q1 = *(const uint2*)((const bf16_t*)ST + b1 * 4096 + e);
    s0[qq] = make_float4(bflo(q0.x), bfhi(q0.x), bflo(q0.y), bfhi(q0.y)); s1[qq] = make_float4(bflo(q1.x), bfhi(q1.x), bflo(q1.y), bfhi(q1.y)); }
#pragma unroll
  for (int qq = 0; qq < 4; ++qq) {
    const int e = qq * 1024 + tid * 4;
    if (dost) {
      *(uint2*)(HIN + b0 * 4096 + e) = make_uint2(0u, 0u);
      *(uint2*)(HIN + b1 * 4096 + e) = make_uint2(pack2(s0[qq].x, s0[qq].y), pack2(s0[qq].z, s0[qq].w));
    }
    *(float4*)(p.out + (dir == 0 ? O_SF : O_SB) + ((size_t)b * 16 + head) * 4096 + e) =
        make_float4(s0[qq].x * dec1 + s1[qq].x, s0[qq].y * dec1 + s1[qq].y, s0[qq].z * dec1 + s1[qq].z, s0[qq].w * dec1 + s1[qq].w);
  }
}
DI void attn_a_item(const Params& p, int it, bool latent, unsigned char* smem, bool dost = true) {
  AttnArgs a;
  const int qb = latent ? (it & 31) : (it & 1), head = latent ? ((it >> 5) & 7) : ((it >> 1) & 7), b = latent ? (it >> 8) : (it >> 4);
  const int kvh = head >> 2;
  const int seqrow = latent ? NCTX + b * 4096 : b * 256;
  a.q = (const bf16_t*)(p.ws + WS_QA) + head * 64; a.ldq = 512;
  a.k = (const bf16_t*)(p.ws + WS_KA) + kvh * 64; a.ldk = 128; a.kpe = nullptr;
  a.vt = (const bf16_t*)(p.ws + WS_VTA); a.vt_heads = 2; a.vhead = kvh;
  a.gate = (const bf16_t*)(p.ws + WS_GA) + head * 64; a.ldg = 512;
  a.out = (bf16_t*)(p.ws + WS_QA) + head * 64; a.ldo = 512;
  a.qrow0 = seqrow + qb * 128; a.qpos0 = qb * 128;
  if (latent) {
    int klo = qb * 128 - 128; if (klo < 0) klo = 0; int khi = qb * 128 + 256; if (khi > 4096) khi = 4096;
    a.seg0_row = seqrow + klo; a.seg0_n = khi - klo; a.seg0_pos = klo; a.band = 1;
    a.seg1_row = NTOK + b * 256; a.seg1_n = 256;
  } else {
    a.seg0_row = seqrow; a.seg0_n = 256; a.seg0_pos = 0; a.band = 0; a.seg1_row = 0; a.seg1_n = 0;
  }
  a.sink2 = p.in[I_SINK][head] * LOG2E; a.has_sink = 1; a.scale2 = 0.125f * LOG2E;
  attn_item<64, false>(a, smem, dost);
}
DI void phase_scan_attn_a(const Params& p, unsigned char* smem, bool dost = true) {
  for (int item = blockIdx.x; item < 2304; item += gridDim.x) {
    if (item < 512) attn_a_item(p, item, true, smem, dost);
    else if (item < 768) scan_item(p, item - 512, true, dost);
    else if (item < 1280) attn_a_item(p, item - 768, false, smem, dost);
    else scan_ctx_item(p, item - 1280, dost);
  }
}

DI void phase_ssd_out(const Params& p, unsigned char* smem, bool dost = true) {
  const int tid = threadIdx.x, lane = tid & 63, w = tid >> 6, lc = lane & 15, g = lane >> 4;
  bf16_t* sB = (bf16_t*)smem;
  bf16_t* sC = sB + 128 * 72;
  bf16_t* sX = sC + 128 * 72;
  bf16_t* sHf = sX + 64 * 136;
  bf16_t* sHb = sHf + 64 * 72;
  float* dtv = (float*)(sHb + 64 * 72);
  float* cumv = dtv + 256;
  const bf16_t* XT = (const bf16_t*)(p.ws + WS_XT); const bf16_t* BCM = (const bf16_t*)(p.ws + WS_BCM); const bf16_t* HIN = (const bf16_t*)(p.ws + WS_HIN);
  bf16_t* ZS = (bf16_t*)(p.ws + WS_ZS); float* SSQ = (float*)(p.ws + WS_SSQ);
  for (int item = blockIdx.x; item < 2048; item += gridDim.x) {
    const int gc = item >> 4, head = item & 15, grp = head >> 3;
    int row0, s0, s1; chunk_rows(gc, row0, s0, s1);
    __syncthreads();
    if (w < 2) chunk_cums(p, row0, head, w, lane, dtv, cumv, nullptr);
#pragma unroll
    for (int i = 0; i < 4; ++i) {
      int id = tid + 256 * i;
      { int r = id >> 3, c8 = id & 7;
        *(uint4*)(sB + r * 72 + c8 * 8) = *(const uint4*)(BCM + (size_t)(row0 + r) * 256 + grp * 64 + c8 * 8);
        *(uint4*)(sC + r * 72 + c8 * 8) = *(const uint4*)(BCM + (size_t)(row0 + r) * 256 + 128 + grp * 64 + c8 * 8); }
      { int r = id >> 4, c16 = id & 15; *(uint4*)(sX + r * 136 + c16 * 8) = *(const uint4*)(XT + ((size_t)gc * 1024 + head * 64 + r) * 128 + c16 * 8); }
    }
#pragma unroll
    for (int i = 0; i < 2; ++i) {
      int id = tid + 256 * i, r = id >> 3, c8 = id & 7;
      *(uint4*)(sHf + r * 72 + c8 * 8) = *(const uint4*)(HIN + ((size_t)(gc * 2 + 0) * 16 + head) * 4096 + r * 64 + c8 * 8);
      *(uint4*)(sHb + r * 72 + c8 * 8) = *(const uint4*)(HIN + ((size_t)(gc * 2 + 1) * 16 + head) * 4096 + r * 64 + c8 * 8);
    }
    __syncthreads();
    bf16x8 cf[2][2];
#pragma unroll
    for (int lt = 0; lt < 2; ++lt)
#pragma unroll
      for (int ks = 0; ks < 2; ++ks) cf[lt][ks] = *(const bf16x8*)(sC + (w * 32 + lt * 16 + lc) * 72 + ks * 32 + g * 8);
    float cfl[2], crl[2];
#pragma unroll
    for (int lt = 0; lt < 2; ++lt) { cfl[lt] = cumv[w * 32 + lt * 16 + lc]; crl[lt] = cumv[128 + w * 32 + lt * 16 + lc]; }
    f32x4 Y[4][2], T[4][2];
#pragma unroll
    for (int pt = 0; pt < 4; ++pt) { T[pt][0] = f32x4{0, 0, 0, 0}; T[pt][1] = f32x4{0, 0, 0, 0}; }
#pragma unroll
    for (int ks = 0; ks < 2; ++ks)
#pragma unroll
      for (int pt = 0; pt < 4; ++pt) {
        bf16x8 hf = *(const bf16x8*)(sHf + (pt * 16 + lc) * 72 + ks * 32 + g * 8);
        T[pt][0] = MFMA16(hf, cf[0][ks], T[pt][0]); T[pt][1] = MFMA16(hf, cf[1][ks], T[pt][1]);
      }
    {
      float e0 = ex2(cfl[0]), e1 = ex2(cfl[1]);
#pragma unroll
      for (int pt = 0; pt < 4; ++pt) { Y[pt][0] = T[pt][0] * e0; Y[pt][1] = T[pt][1] * e1; }
    }
#pragma unroll
    for (int pt = 0; pt < 4; ++pt) { T[pt][0] = f32x4{0, 0, 0, 0}; T[pt][1] = f32x4{0, 0, 0, 0}; }
#pragma unroll
    for (int ks = 0; ks < 2; ++ks)
#pragma unroll
      for (int pt = 0; pt < 4; ++pt) {
        bf16x8 hb = *(const bf16x8*)(sHb + (pt * 16 + lc) * 72 + ks * 32 + g * 8);
        T[pt][0] = MFMA16(hb, cf[0][ks], T[pt][0]); T[pt][1] = MFMA16(hb, cf[1][ks], T[pt][1]);
      }
    {
      float e0 = ex2(crl[0]), e1 = ex2(crl[1]);
#pragma unroll
      for (int pt = 0; pt < 4; ++pt) { Y[pt][0] += T[pt][0] * e0; Y[pt][1] += T[pt][1] * e1; }
    }
    const float dskip = p.in[I_DSKIP][head];
#pragma unroll
    for (int sb = 0; sb < 2; ++sb) {
      f32x4 S[4][2];
#pragma unroll
      for (int st = 0; st < 4; ++st) { S[st][0] = f32x4{0, 0, 0, 0}; S[st][1] = f32x4{0, 0, 0, 0}; }
#pragma unroll
      for (int ks = 0; ks < 2; ++ks)
#pragma unroll
        for (int st = 0; st < 4; ++st) {
          bf16x8 bf = *(const bf16x8*)(sB + (sb * 64 + st * 16 + lc) * 72 + ks * 32 + g * 8);
          S[st][0] = MFMA16(bf, cf[0][ks], S[st][0]); S[st][1] = MFMA16(bf, cf[1][ks], S[st][1]);
        }
#pragma unroll
      for (int st = 0; st < 4; ++st) {
        const int sbase = sb * 64 + st * 16 + 4 * g;
        const f32x4 rfs = *(const f32x4*)(dtv + sbase), rbs = *(const f32x4*)(dtv + 128 + sbase);
#pragma unroll
        for (int lt = 0; lt < 2; ++lt) {
          const int l = w * 32 + lt * 16 + lc;
#pragma unroll
          for (int r = 0; r < 4; ++r) {
            const int s = sbase + r;
            const float af = s <= l ? cfl[lt] - rfs[r] : -1e30f, ab = s >= l ? crl[lt] - rbs[r] : -1e30f;
            S[st][lt][r] = S[st][lt][r] * (ex2(af) + ex2(ab)) + (s == l ? dskip : 0.f);
          }
        }
      }
      bf16x8 pf[2][2];
#pragma unroll
      for (int lt = 0; lt < 2; ++lt)
#pragma unroll
        for (int k2 = 0; k2 < 2; ++k2)
          pf[lt][k2] = mk8(pack2(S[2 * k2][lt][0], S[2 * k2][lt][1]), pack2(S[2 * k2][lt][2], S[2 * k2][lt][3]),
                           pack2(S[2 * k2 + 1][lt][0], S[2 * k2 + 1][lt][1]), pack2(S[2 * k2 + 1][lt][2], S[2 * k2 + 1][lt][3]));
#pragma unroll
      for (int pt = 0; pt < 4; ++pt)
#pragma unroll
        for (int k2 = 0; k2 < 2; ++k2) {
          uint2 lo = *(const uint2*)(sX + (pt * 16 + lc) * 136 + sb * 64 + k2 * 32 + 4 * g);
          uint2 hi = *(const uint2*)(sX + (pt * 16 + lc) * 136 + sb * 64 + k2 * 32 + 16 + 4 * g);
          bf16x8 xf = mk8(lo.x, lo.y, hi.x, hi.y);
          Y[pt][0] = MFMA16(xf, pf[0][k2], Y[pt][0]); Y[pt][1] = MFMA16(xf, pf[1][k2], Y[pt][1]);
        }
    }
#pragma unroll
    for (int lt = 0; lt < 2; ++lt) {
      const size_t row = (size_t)(row0 + w * 32 + lt * 16 + lc);
      float ss = 0.f;
#pragma unroll
      for (int pt = 0; pt < 4; ++pt) {
        bf16_t* zp = ZS + row * 1024 + head * 64 + pt * 16 + 4 * g;
        uint2 z = *(const uint2*)zp;
        float o0 = Y[pt][lt][0] * bflo(z.x), o1 = Y[pt][lt][1] * bfhi(z.x), o2 = Y[pt][lt][2] * bflo(z.y), o3 = Y[pt][lt][3] * bfhi(z.y);
        ss += o0 * o0 + o1 * o1 + o2 * o2 + o3 * o3;
        if (dost) *(uint2*)zp = make_uint2(pack2(o0, o1), pack2(o2, o3));
      }
      ss += __shfl_xor(ss, 16); ss += __shfl_xor(ss, 32);
      if (g == 0 && dost) SSQ[row * 16 + head] = ss;
    }
  }
}

DI void resid_epilogue(const Params& p, f32x4 (&acc)[4][4], int layer, int m0, int n0, unsigned char* smem) {
  const int tid = threadIdx.x, lane = tid & 63, w = tid >> 6, wm = w >> 1, wn = w & 1;
  const int cond = cond_of(m0);
  const float* wb = stage_wave_tile(acc, smem);
  const int c4 = (lane & 15) * 4, colb = n0 + wn * 64 + c4;
  const float4 gt = *(const float4*)((const float*)(p.ws + WS_MODP) + (layer * 3 + cond) * 3072 + 2048 + colb);
  bf16_t* X1B = (bf16_t*)(p.ws + WS_X1B);
#pragma unroll 4
  for (int it = 0; it < 16; ++it) {
    const int rl = it * 4 + (lane >> 4), row = m0 + wm * 64 + rl;
    const float4 av = *(const float4*)(wb + rl * 68 + c4);
    if (layer == 0) {
      const float* xr = row < NCTX ? p.in[I_XP] + (size_t)row * 1024 : p.in[I_XS] + (size_t)(row - NCTX) * 1024;
      const float4 xv = *(const float4*)(xr + colb);
      *(uint2*)(X1B + (size_t)row * 1024 + colb) = pk4(make_float4(xv.x + gt.x * av.x, xv.y + gt.y * av.y, xv.z + gt.z * av.z, xv.w + gt.w * av.w));
    } else {
      const uint2 xb = *(const uint2*)(X1B + (size_t)row * 1024 + colb);
      const float4 v = make_float4(bflo(xb.x) + gt.x * av.x, bfhi(xb.x) + gt.y * av.y, bflo(xb.y) + gt.z * av.z, bfhi(xb.y) + gt.w * av.w);
      *(uint2*)((bf16_t*)(p.ws + WS_X2B) + (size_t)row * 1024 + colb) = pk4(v);
      float ss = v.x * v.x + v.y * v.y + v.z * v.z + v.w * v.w;
      ss += __shfl_xor(ss, 8); ss += __shfl_xor(ss, 4); ss += __shfl_xor(ss, 2); ss += __shfl_xor(ss, 1);
      if ((lane & 15) == 0) __hip_atomic_fetch_add((float*)(p.ws + WS_ROWSQ) + row, ss, __ATOMIC_RELAXED, __HIP_MEMORY_SCOPE_AGENT);
    }
  }
}
DI void phase_ab_out(const Params& p, unsigned char* smem) {
  const int tid = threadIdx.x, lane = tid & 63, w = tid >> 6, wm = w >> 1, g = lane >> 4;
  float* srs = (float*)(smem + 65536);
  const float* SSQ = (const float*)(p.ws + WS_SSQ);
  const bf16_t* W = (const bf16_t*)(p.ws + W_ABOUT);
  for (int tile = blockIdx.x; tile < 128 * 8; tile += gridDim.x) {
    int mt, nt; xcd_tile(tile, 8, mt, nt); const int m0 = mt * 128, n0 = nt * 128;
    __syncthreads();
    if (tid < 128) {
      const float4* s = (const float4*)(SSQ + (size_t)(m0 + tid) * 16);
      float4 a = s[0], b = s[1], c = s[2], d = s[3];
      float t = a.x + a.y + a.z + a.w + b.x + b.y + b.z + b.w + c.x + c.y + c.z + c.w + d.x + d.y + d.z + d.w;
      srs[tid] = rsqrtf(t * (1.f / 1024.f) + EPS);
    }
    f32x4 acc[4][4]; acc_zero(acc);
    gemm_mainloop(acc, (const bf16_t*)(p.ws + WS_ZS), 1024, W + 512, 1536, 1024, m0, n0, smem);
#pragma unroll
    for (int i = 0; i < 4; ++i)
#pragma unroll
      for (int r = 0; r < 4; ++r) {
        float rs = srs[wm * 64 + i * 16 + 4 * g + r];
#pragma unroll
        for (int j = 0; j < 4; ++j) acc[i][j][r] *= rs;
      }
    gemm_mainloop(acc, (const bf16_t*)(p.ws + WS_QA), 512, W, 1536, 512, m0, n0, smem);
    resid_epilogue(p, acc, 0, m0, n0, smem);
  }
}
DI void phase_mla_out(const Params& p, unsigned char* smem) {
  for (int tile = blockIdx.x; tile < 128 * 8; tile += gridDim.x) {
    int mt, nt; xcd_tile(tile, 8, mt, nt); const int m0 = mt * 128, n0 = nt * 128;
    f32x4 acc[4][4]; acc_zero(acc);
    gemm_mainloop(acc, (const bf16_t*)(p.ws + WS_AOM), 1024, (const bf16_t*)(p.ws + W_MOUT), 1024, 1024, m0, n0, smem);
    resid_epilogue(p, acc, 1, m0, n0, smem);
  }
}

DI void phase_mla_in(const Params& p, unsigned char* smem) {
  const int tid = threadIdx.x, lane = tid & 63, w = tid >> 6, wm = w >> 1, wn = w & 1, lc = lane & 15, g = lane >> 4;
  bf16_t* GM = (bf16_t*)(p.ws + WS_GM);
  constexpr int NT = MIN_N / 128;
  for (int tile = blockIdx.x; tile < 128 * NT; tile += gridDim.x) {
    int mt, nt; xcd_tile(tile, NT, mt, nt); const int m0 = mt * 128, n0 = nt * 128;
    f32x4 acc[4][4]; acc_zero(acc);
    gemm_mainloop(acc, (const bf16_t*)(p.ws + WS_H), 1024, (const bf16_t*)(p.ws + W_MIN), 1024, 1024, m0, n0, smem);
    const int rb = m0 + wm * 64, cb = n0 + wn * 64;
    const float* wb = stage_wave_tile(acc, smem);
    const int c4 = (lane & 15) * 4, col = cb + c4;
    if (n0 < 256) {
      bf16_t* CQB = (bf16_t*)(p.ws + WS_CQN); float* rsq = (float*)(p.ws + WS_ROWSQ_Q);
#pragma unroll 4
      for (int it = 0; it < 16; ++it) {
        const int rl = it * 4 + (lane >> 4); const size_t row = (size_t)(rb + rl);
        const float4 v = *(const float4*)(wb + rl * 68 + c4);
        *(uint2*)(CQB + row * 256 + col) = pk4(v);
        float ss = v.x * v.x + v.y * v.y + v.z * v.z + v.w * v.w;
        ss += __shfl_xor(ss, 8); ss += __shfl_xor(ss, 4); ss += __shfl_xor(ss, 2); ss += __shfl_xor(ss, 1);
        if ((lane & 15) == 0) __hip_atomic_fetch_add(rsq + row, ss, __ATOMIC_RELAXED, __HIP_MEMORY_SCOPE_AGENT);
      }
    } else if (n0 < 384) {
      float* ex = (float*)(smem + 69632);
#pragma unroll 4
      for (int it = 0; it < 16; ++it) {
        const int rl = it * 4 + (lane >> 4);
        const float4 v = *(const float4*)(wb + rl * 68 + c4);
        float ss = v.x * v.x + v.y * v.y + v.z * v.z + v.w * v.w;
        ss += __shfl_xor(ss, 8); ss += __shfl_xor(ss, 4); ss += __shfl_xor(ss, 2); ss += __shfl_xor(ss, 1);
        if ((lane & 15) == 0) ex[(wm * 2 + wn) * 64 + rl] = ss;
      }
      __syncthreads();
      bf16_t* CKVN = (bf16_t*)(p.ws + WS_CKVN);
      const float4 nw = *(const float4*)(p.in[I_KVNW] + col - 256);
#pragma unroll 4
      for (int it = 0; it < 16; ++it) {
        const int rl = it * 4 + (lane >> 4); const size_t row = (size_t)(rb + rl);
        const float rs = rsqrtf((ex[(wm * 2 + 0) * 64 + rl] + ex[(wm * 2 + 1) * 64 + rl]) * (1.f / 128.f) + EPS);
        const float4 v = *(const float4*)(wb + rl * 68 + c4);
        const float4 o = make_float4(v.x * rs * nw.x, v.y * rs * nw.y, v.z * rs * nw.z, v.w * rs * nw.w);
        *(uint2*)(CKVN + row * 128 + col - 256) = pk4(o);
        if (m0 < NCTX) *(float4*)(p.out + O_CKV + row * 128 + col - 256) = o;
      }
    } else if (n0 < 1408) {
#pragma unroll 4
      for (int it = 0; it < 16; ++it) {
        const int rl = it * 4 + (lane >> 4); const size_t row = (size_t)(rb + rl);
        *(uint2*)(GM + row * 1024 + col - 384) = pk4(silu4(*(const float4*)(wb + rl * 68 + c4)));
      }
    } else if (wn == 0) {
      bf16_t* KPEB = (bf16_t*)(p.ws + WS_KPEB);
      const bool lat = m0 >= NCTX;
#pragma unroll 4
      for (int it = 0; it < 16; ++it) {
        const int rl = it * 4 + (lane >> 4); const size_t row = (size_t)(rb + rl);
        const float4 v = *(const float4*)(wb + rl * 68 + c4);
        const float4 pr = make_float4(__shfl_xor(v.x, 2), __shfl_xor(v.y, 2), __shfl_xor(v.z, 2), __shfl_xor(v.w, 2));
        float4 o = v;
        if (lat) {
          const int l = (int)(row - NCTX) & 4095;
          const float pos = (c4 & 16) ? (float)(l & 63) : (float)(l >> 6);
          const float vv[4] = {v.x, v.y, v.z, v.w}, pp[4] = {pr.x, pr.y, pr.z, pr.w}; float oo[4];
#pragma unroll
          for (int e = 0; e < 4; ++e) {
            const float th = pos * ex2(-(float)((c4 + e) & 7) * (13.287712379549449f / 8.f)), c = __cosf(th), sn = __sinf(th);
            oo[e] = (c4 & 8) ? vv[e] * c + pp[e] * sn : vv[e] * c - pp[e] * sn;
          }
          o = make_float4(oo[0], oo[1], oo[2], oo[3]);
        }
        if (c4 < 32) {
          *(uint2*)(KPEB + row * 32 + c4) = pk4(o);
          if (!lat) *(float4*)(p.out + O_KPE + row * 32 + c4) = v;
        }
      }
    }
  }
}

DI void mla_cache_convert(const Params& p) {
  bf16_t* CKVN = (bf16_t*)(p.ws + WS_CKVN) + (size_t)NTOK * 128; bf16_t* KPEB = (bf16_t*)(p.ws + WS_KPEB) + (size_t)NTOK * 32;
  for (int i = blockIdx.x * 256 + threadIdx.x; i < (65536 + 16384) / 4; i += gridDim.x * 256) {
    if (i < 16384) { float4 v = ((const float4*)p.in[I_CCKV])[i]; *(uint2*)(CKVN + i * 4) = make_uint2(pack2(v.x, v.y), pack2(v.z, v.w)); }
    else { int k = i - 16384; float4 v = ((const float4*)p.in[I_CKPE])[k]; *(uint2*)(KPEB + k * 4) = make_uint2(pack2(v.x, v.y), pack2(v.z, v.w)); }
  }
}
DI void phase_mla_prep(const Params& p) {
  const int tid = threadIdx.x, lane = tid & 63, w = tid >> 6;
  const float* CQ = (const float*)(p.ws + WS_CQ); const float* CKV = (const float*)(p.ws + WS_CKV); const float* KPE = (const float*)(p.ws + WS_KPE);
  bf16_t* CQN = (bf16_t*)(p.ws + WS_CQN); bf16_t* CKVN = (bf16_t*)(p.ws + WS_CKVN); bf16_t* KPEB = (bf16_t*)(p.ws + WS_KPEB);
  for (int item = blockIdx.x; item < NTOK / 4; item += gridDim.x) {
    const size_t row = (size_t)item * 4 + w;
    {
      float4 v = *(const float4*)(CQ + row * 256 + lane * 4);
      float ss = wave_sum(v.x * v.x + v.y * v.y + v.z * v.z + v.w * v.w);
      float rs = rsqrtf(ss * (1.f / 256.f) + EPS);
      float4 nw = *(const float4*)(p.in[I_QNW] + lane * 4);
      *(uint2*)(CQN + row * 256 + lane * 4) = make_uint2(pack2(v.x * rs * nw.x, v.y * rs * nw.y), pack2(v.z * rs * nw.z, v.w * rs * nw.w));
    }
    {
      float2 v = *(const float2*)(CKV + row * 128 + lane * 2);
      float ss = wave_sum(v.x * v.x + v.y * v.y);
      float rs = rsqrtf(ss * (1.f / 128.f) + EPS);
      float2 nw = *(const float2*)(p.in[I_KVNW] + lane * 2);
      float a = v.x * rs * nw.x, b = v.y * rs * nw.y;
      *(unsigned*)(CKVN + row * 128 + lane * 2) = pack2(a, b);
      if (row < NCTX) *(float2*)(p.out + O_CKV + row * 128 + lane * 2) = make_float2(a, b);
    }
    {
      float v = lane < 32 ? KPE[row * 32 + lane] : 0.f;
      float pr = __shfl_xor(v, 8);
      float o = v;
      if (row >= NCTX) {
        int l = (int)(row - NCTX) & 4095;
        float pos = (lane & 16) ? (float)(l & 63) : (float)(l >> 6);
        float th = pos * ex2(-(float)(lane & 7) * (13.287712379549449f / 8.f));
        float c = __cosf(th), s = __sinf(th);
        o = (lane & 8) ? v * c + pr * s : v * c - pr * s;
      } else if (lane < 32) p.out[O_KPE + row * 32 + lane] = v;
      if (lane < 32) KPEB[row * 32 + lane] = f2bf(o);
    }
  }
}

DI void phase_mla_up(const Params& p, unsigned char* smem) {
  const int tid = threadIdx.x, lane = tid & 63, w = tid >> 6, wm = w >> 1, wn = w & 1, lc = lane & 15, g = lane >> 4;
  bf16_t* QM = (bf16_t*)(p.ws + WS_QM); bf16_t* KN = (bf16_t*)(p.ws + WS_KNOPE); bf16_t* VTM = (bf16_t*)(p.ws + WS_VTM);
  constexpr int NQ = 128 * 12, NKV = 132 * 16;
  for (int tile = blockIdx.x; tile < NQ + NKV; tile += gridDim.x) {
    f32x4 acc[4][4]; acc_zero(acc);
    if (tile < NQ) {
      int mt, nt; xcd_tile(tile, 12, mt, nt); const int m0 = mt * 128, n0 = nt * 128;
      gemm_mainloop(acc, (const bf16_t*)(p.ws + WS_CQN), 256, (const bf16_t*)(p.ws + W_UQ), 256, 256, m0, n0, smem);
      const int rb = m0 + wm * 64, cb = n0 + wn * 64; const bool lat = m0 >= NCTX;
      const float inv = ex2(-(float)(lc & 7) * (13.287712379549449f / 8.f));
      if (lat) {
#pragma unroll
        for (int j = 0; j < 4; ++j) {
          const int col0 = cb + j * 16, d0 = col0 % 96;
          if (d0 >= 64) {
#pragma unroll
            for (int i = 0; i < 4; ++i)
#pragma unroll
              for (int r = 0; r < 4; ++r) {
                const int row = rb + i * 16 + 4 * g + r;
                float v = acc[i][j][r];
                float pr = __shfl_xor(v, 8);
                int l = (row - NCTX) & 4095;
                float pos = d0 >= 80 ? (float)(l & 63) : (float)(l >> 6);
                float th = pos * inv, c = __cosf(th), sn = __sinf(th);
                acc[i][j][r] = (lc & 8) ? v * c + pr * sn : v * c - pr * sn;
              }
          }
        }
      }
      {
        const float* wb = stage_wave_tile(acc, smem);
        const int c4 = (lane & 15) * 4; const float qs = 0.10206207261596575f * LOG2E;
#pragma unroll 4
        for (int it = 0; it < 16; ++it) {
          const int rl = it * 4 + (lane >> 4); const size_t row = (size_t)(rb + rl);
          const float4 v = *(const float4*)(wb + rl * 68 + c4);
          const float qr = qs * rsqrtf(((const float*)(p.ws + WS_ROWSQ_Q))[row] * (1.f / 256.f) + EPS);
          *(uint2*)(QM + row * 1536 + cb + c4) = pk4(make_float4(v.x * qr, v.y * qr, v.z * qr, v.w * qr));
        }
      }
    } else {
      const int t2 = tile - NQ; int mt, head; if (t2 < 128 * 16) xcd_tile(t2, 16, mt, head); else { mt = t2 >> 4; head = t2 & 15; } const int m0 = mt * 128, n0 = head * 128;
      gemm_mainloop(acc, (const bf16_t*)(p.ws + WS_CKVN), 128, (const bf16_t*)(p.ws + W_UKV), 128, 128, m0, n0, smem);
      const int rb = m0 + wm * 64;
      if (wn == 0) {
        const float* wb = stage_wave_tile(acc, smem);
        const int c4 = (lane & 15) * 4;
#pragma unroll 4
        for (int it = 0; it < 16; ++it) {
          const int rl = it * 4 + (lane >> 4);
          *(uint2*)(KN + (size_t)(rb + rl) * 1024 + head * 64 + c4) = pk4(*(const float4*)(wb + rl * 68 + c4));
        }
      } else {
#pragma unroll
        for (int i = 0; i < 4; ++i)
#pragma unroll
          for (int j = 0; j < 4; ++j) {
            int row = rb + i * 16 + 4 * g, d = j * 16 + lc;
            *(uint2*)(VTM + ((size_t)(row >> 6) * 16 + head) * 4096 + d * 64 + (row & 63)) = make_uint2(pack2(acc[i][j][0], acc[i][j][1]), pack2(acc[i][j][2], acc[i][j][3]));
          }
      }
    }
  }
}

DI void phase_mla_attn(const Params& p, unsigned char* smem) {
  for (int item = blockIdx.x; item < 1024; item += gridDim.x) {
    AttnArgs a;
    const bool latent = item < 512;
    const int it = latent ? item : item - 512;
    int qb, head, b;
    if (latent) { const int x = it & 7, j = it >> 3, pair = x * 4 + (j >> 4); qb = j & 15; head = pair & 15; b = pair >> 4; }
    else { qb = 0; head = it & 15; b = it >> 4; }
    const int seqrow = latent ? NCTX + b * 4096 : b * 256;
    a.q = (const bf16_t*)(p.ws + WS_QM) + head * 96; a.ldq = 1536;
    a.k = (const bf16_t*)(p.ws + WS_KNOPE) + head * 64; a.ldk = 1024; a.kpe = (const bf16_t*)(p.ws + WS_KPEB);
    a.vt = (const bf16_t*)(p.ws + WS_VTM); a.vt_heads = 16; a.vhead = head;
    a.gate = (const bf16_t*)(p.ws + WS_GM) + head * 64; a.ldg = 1024;
    a.out = (bf16_t*)(p.ws + WS_AOM) + head * 64; a.ldo = 1024;
    a.qrow0 = seqrow + qb * 256; a.qpos0 = qb * 256;
    a.seg0_row = seqrow; a.seg0_n = latent ? 4096 : 256; a.seg0_pos = 0; a.band = 0;
    a.seg1_row = NTOK + b * 256; a.seg1_n = latent ? 256 : 0;
    a.sink2 = 0.f; a.has_sink = 0; a.scale2 = 1.f;
    attn_item2<96, true>(a, smem);
  }
}

DI void phase_final_norm(const Params& p) {
  const int tid = threadIdx.x;
  const bf16_t* X2B = (const bf16_t*)(p.ws + WS_X2B); const float* rowsq = (const float*)(p.ws + WS_ROWSQ);
  const int c8 = (tid & 127) * 8;
  const float4 w0 = *(const float4*)(p.in[I_FNW] + c8), w1 = *(const float4*)(p.in[I_FNW] + c8 + 4);
  for (int item = blockIdx.x; item < NTOK / 2; item += gridDim.x) {
    const size_t row = (size_t)item * 2 + (tid >> 7);
    const float rs = rsqrtf(rowsq[row] * (1.f / 1024.f) + EPS);
    const uint4 u = *(const uint4*)(X2B + row * 1024 + c8);
    float* o = p.out + O_Y + row * 1024 + c8;
    *(float4*)o = make_float4(bflo(u.x) * rs * w0.x, bfhi(u.x) * rs * w0.y, bflo(u.y) * rs * w0.z, bfhi(u.y) * rs * w0.w);
    *(float4*)(o + 4) = make_float4(bflo(u.z) * rs * w1.x, bfhi(u.z) * rs * w1.y, bflo(u.w) * rs * w1.z, bfhi(u.w) * rs * w1.w);
  }
}

#define XB_TMO      128
#define XB_XCNT(j)  (256  + 64 * (j))
#define XB_XSUB(j)  (1280 + 64 * (j))
#define XB_XGEN(j)  (2304 + 64 * (j))
#define XB_TOP      3328
#define XB_TOPGEN   3392
#define XCD_BAR_WORDS 3456
#define XB_SPIN_CAP (1u << 18)
#define LAS __attribute__((address_space(3)))

__device__ __forceinline__ unsigned xb_ld(unsigned* p)              { return __hip_atomic_load(p, __ATOMIC_RELAXED, __HIP_MEMORY_SCOPE_AGENT); }
__device__ __forceinline__ unsigned xb_add(unsigned* p, unsigned v) { return __hip_atomic_fetch_add(p, v, __ATOMIC_RELAXED, __HIP_MEMORY_SCOPE_AGENT); }
__device__ __forceinline__ unsigned xb_xcc_id() { return (unsigned)__builtin_amdgcn_s_getreg((3 << 11) | 20) & 0xFu; }
#define XB_SPIN(cond, bar) do { unsigned _sp = 0; while (cond) { __builtin_amdgcn_s_sleep(1); \
    if ((++_sp & 255u) == 0u) { if (xb_ld(&(bar)[XB_TMO])) break; if (_sp > XB_SPIN_CAP) { atomicAdd(&(bar)[XB_TMO], 1u); break; } } } } while (0)

struct XcdBarrier {
    unsigned* bar; unsigned x;
    volatile LAS unsigned* st;
};

__device__ __forceinline__ XcdBarrier xcd_barrier_post(unsigned* bar, volatile LAS unsigned* st) {
    XcdBarrier b; b.bar = bar; b.x = xb_xcc_id(); b.st = st;
    if (threadIdx.x == 0) (void)xb_add(&bar[XB_XCNT(b.x)], 1u);
    return b;
}
__device__ __forceinline__ void xcd_barrier_complete(unsigned* bar, unsigned x, unsigned& nloc, unsigned& nx) {
    const unsigned G = gridDim.x * gridDim.y * gridDim.z;
    unsigned sum, cnt, mine, sp = 0u;
    for (;;) {
        sum = 0u; cnt = 0u; mine = 0u;
#pragma unroll
        for (unsigned j = 0; j < 16; ++j) { const unsigned c = xb_ld(&bar[XB_XCNT(j)]); sum += c; cnt += (c > 0u) ? 1u : 0u; mine = (j == x) ? c : mine; }
        if (sum == G) break;
        __builtin_amdgcn_s_sleep(1);
        if ((++sp & 255u) == 0u) { if (xb_ld(&bar[XB_TMO])) break; if (sp > XB_SPIN_CAP) { atomicAdd(&bar[XB_TMO], 1u); break; } }
    }
    nloc = mine > 0u ? mine : 1u; nx = cnt > 0u ? cnt : 1u;
}

__device__ __forceinline__ void xcd_barrier(const XcdBarrier& b) {
    asm volatile("s_waitcnt vmcnt(0)" ::: "memory");
    __syncthreads();
    if (threadIdx.x == 0) {
        unsigned* bar = b.bar;
        __builtin_amdgcn_s_waitcnt(0);
        unsigned nloc = b.st[0], nx = b.st[1];
        if (nloc == 0u) { xcd_barrier_complete(bar, b.x, nloc, nx); b.st[0] = nloc; b.st[1] = nx; }
        const unsigned old = xb_add(&bar[XB_XSUB(b.x)], 1u);
        const unsigned gen = old / nloc;
        if (old + 1u == (gen + 1u) * nloc) {
            __builtin_amdgcn_fence(__ATOMIC_RELEASE, "agent");
            asm volatile("s_waitcnt vmcnt(0)" ::: "memory");
            const unsigned og = xb_add(&bar[XB_TOP], 1u);
            const unsigned tg = og / nx;
            if (og + 1u == (tg + 1u) * nx) xb_add(&bar[XB_TOPGEN], 1u);
            else XB_SPIN(xb_ld(&bar[XB_TOPGEN]) == tg, bar);
            __builtin_amdgcn_fence(__ATOMIC_ACQUIRE, "agent");
            xb_add(&bar[XB_XGEN(b.x)], 1u);
            asm volatile("s_waitcnt vmcnt(0)" ::: "memory");
        } else {
            XB_SPIN(xb_ld(&bar[XB_XGEN(b.x)]) == gen, bar);
            __builtin_amdgcn_fence(__ATOMIC_ACQUIRE, "agent");
            asm volatile("s_waitcnt vmcnt(0)" ::: "memory");
        }
    }
    __syncthreads();
}


constexpr int N_PHASES = 15;
__global__ void __launch_bounds__(256, 2) mega(Params p) {
  __shared__ __attribute__((aligned(16))) unsigned char smem[75 * 1024];
  volatile LAS unsigned* xst = (volatile LAS unsigned*)(smem + 75 * 1024 - 16);
  if (threadIdx.x == 0) { xst[0] = 0u; xst[1] = 0u; }
  __syncthreads();
  XcdBarrier xb = xcd_barrier_post((unsigned*)(p.ws + WS_BAR), xst);
  if (p.ph_hi > 1000) cg::this_grid().sync();
#ifndef PROBE_D
#define PROBE_D 0
#endif
#ifndef REPEAT_MASK
#define REPEAT_MASK 0
#endif
#define PHASE(n, ...) if (p.ph_lo <= n && n < p.ph_hi) { __VA_ARGS__; if ((REPEAT_MASK >> n) & 1) { __VA_ARGS__; } if (n + 1 < p.ph_hi) xcd_barrier(xb); }
  PHASE(0, phase0(p, smem))
  PHASE(1, phase_modnorm(p, 0, smem); for (int t = blockIdx.x; t < N_WT; t += gridDim.x) wt_item(p, t, smem + 24576))
  PHASE(2, phase_ab_in(p, smem))
  PHASE(3, phase_conv(p, smem); for (int it = 384 + blockIdx.x; it < 768; it += gridDim.x) p0_mod_item(p, it, smem))
  PHASE(4, phase_ssd_states(p, smem))
#if PROBE_D == 1
  if (p.ph_lo <= 5 && 5 < p.ph_hi) phase_scan_attn_a(p, smem, p.ph_hi > 100);
#endif
  PHASE(5, phase_scan_attn_a(p, smem))
#if PROBE_D == 2
  if (p.ph_lo <= 6 && 6 < p.ph_hi) phase_ssd_out(p, smem, p.ph_hi > 100);
#endif
  PHASE(6, phase_ssd_out(p, smem))
  PHASE(7, phase_ab_out(p, smem))
  PHASE(8, phase_modnorm(p, 1, smem); mla_cache_convert(p))
  PHASE(9, phase_mla_in(p, smem))
  PHASE(11, phase_mla_up(p, smem))
  PHASE(12, phase_mla_attn(p, smem))
  PHASE(13, phase_mla_out(p, smem))
  PHASE(14, phase_final_norm(p))
}

extern "C" void kernel_launch(void* const* d_in, const int* in_sizes, int n_in, void* d_out, int out_size, void* d_ws, size_t ws_size, hipStream_t stream) {
  static int grid = 0;
  if (grid == 0) {
    int dev = 0, cus = 0, per_cu = 0;
    hipGetDevice(&dev);
    hipDeviceGetAttribute(&cus, hipDeviceAttributeMultiprocessorCount, dev);
    hipOccupancyMaxActiveBlocksPerMultiprocessor(&per_cu, (const void*)mega, 256, 0);
    if (per_cu < 1) per_cu = 1;
    if (per_cu > 2) per_cu = 2;
    grid = cus * per_cu;
  }
  Params p{};
  for (int i = 0; i < 29; ++i) p.in[i] = (const float*)d_in[i];
  p.out = (float*)d_out; p.ws = (unsigned char*)d_ws;
  hipMemsetAsync((unsigned char*)d_ws + WS_BAR, 0, WS_ZERO_BYTES, stream);
#if MULTI_LAUNCH
  for (int ph = 0; ph < N_PHASES; ++ph) {
    p.ph_lo = ph; p.ph_hi = ph + 1;
    hipLaunchKernelGGL(mega, dim3(grid), dim3(256), 0, stream, p);
  }
#else
  p.ph_lo = 0; p.ph_hi = N_PHASES;
  void* args[] = {&p};
  hipError_t e = hipLaunchCooperativeKernel((const void*)mega, dim3(grid), dim3(256), args, 0, stream);
  if (e != hipSuccess) fprintf(stderr, "cooperative launch failed: %s (grid %d)\n", hipGetErrorString(e), grid);
#endif
}
```

```cpp
#include <hip/hip_runtime.h>
#include <hip/hip_cooperative_groups.h>
#include <cstdio>
namespace cg = cooperative_groups;

#ifndef MULTI_LAUNCH
#define MULTI_LAUNCH 0
#endif

typedef unsigned short bf16_t;
using bf16x8 = __attribute__((ext_vector_type(8))) short;
using f32x4  = __attribute__((ext_vector_type(4))) float;
typedef __bf16 bf2v __attribute__((ext_vector_type(2)));
typedef float  fl2v __attribute__((ext_vector_type(2)));
#define DI __device__ __forceinline__
#define MFMA16(a, b, c) __builtin_amdgcn_mfma_f32_16x16x32_bf16((a), (b), (c), 0, 0, 0)

constexpr int NTOK = 16384;
constexpr int NCTX = 8192;
constexpr int NROWK = 16896;
constexpr int ABIN_N = 3712;
constexpr int MIN_N = 1536;
constexpr float EPS = 1e-6f;
constexpr float LOG2E = 1.4426950408889634f;

constexpr size_t O_Y = 0;
constexpr size_t O_CAK = 16777216;
constexpr size_t O_CAV = 17825792;
constexpr size_t O_SF = 18874368;
constexpr size_t O_SB = 20971520;
constexpr size_t O_CKV = 23068672;
constexpr size_t O_KPE = 24117248;

constexpr size_t KB = 1024, MB = 1024 * 1024;
constexpr size_t W_ABIN = 0;
constexpr size_t W_ABOUT = W_ABIN + (size_t)ABIN_N * 1024 * 2;
constexpr size_t W_MIN = W_ABOUT + 1024 * 1536 * 2;
constexpr size_t W_UQ = W_MIN + 1536 * 1024 * 2;
constexpr size_t W_UKV = W_UQ + 1536 * 256 * 2;
constexpr size_t W_MOUT = W_UKV + 2048 * 128 * 2;
constexpr size_t W_END = W_MOUT + 1024 * 1024 * 2;
constexpr size_t WS_ROWSQ = 17 * MB + 768 * KB + 96 * KB;
constexpr size_t WS_ROWSQ_Q = WS_ROWSQ + 64 * KB;
constexpr size_t WS_ZERO_BYTES = 96 * KB + 128 * KB;
constexpr size_t WS_X2B = 50 * MB;
constexpr size_t WS_GCNT = 17 * MB + 768 * KB + 15 * KB;
constexpr size_t WS_MODP = 17 * MB + 768 * KB + 16 * KB;
constexpr size_t WS_CDEC = 17 * MB + 512 * KB;
constexpr size_t WS_BAR = 17 * MB + 768 * KB;
constexpr size_t WS_H = 18 * MB;
constexpr size_t WS_XT = 18 * MB;
constexpr size_t WS_XBCR = 50 * MB;
constexpr size_t WS_HIN = 50 * MB;
constexpr size_t WS_QA = 90 * MB;
constexpr size_t WS_KA = 106 * MB;
constexpr size_t WS_VTA = WS_KA + 4352 * KB;
constexpr size_t WS_GA = WS_VTA + 4352 * KB;
constexpr size_t WS_ZS = WS_GA + 16 * MB;
constexpr size_t WS_DTP = WS_ZS + 32 * MB;
constexpr size_t WS_BT = WS_DTP + 2 * MB;
constexpr size_t WS_BCM = WS_BT + 4 * MB;
constexpr size_t WS_SSQ = WS_BCM + 8 * MB;
constexpr size_t WS_STATES = WS_SSQ + 1 * MB;
constexpr size_t WS_L0_END = WS_STATES + 64 * MB;
constexpr size_t WS_AOM = 18 * MB;
constexpr size_t WS_GM = 50 * MB;
constexpr size_t WS_CQN = 82 * MB;
constexpr size_t WS_CKVN = 90 * MB;
constexpr size_t WS_KPEB = WS_CKVN + 4352 * KB;
constexpr size_t WS_QM = WS_KPEB + 1280 * KB;
constexpr size_t WS_KNOPE = WS_QM + 48 * MB;
constexpr size_t WS_VTM = WS_KNOPE + 33 * MB;
constexpr size_t WS_CQ = WS_VTM;
constexpr size_t WS_CKV = WS_CQ + 16 * MB;
constexpr size_t WS_KPE = WS_CKV + 8 * MB;
constexpr size_t WS_X1B = WS_VTM + 33 * MB;
constexpr size_t WS_L1_END = WS_X1B + 32 * MB;
static_assert(W_END <= 17 * MB, "weights");
static_assert(WS_L0_END <= 256 * MB && WS_L1_END <= 256 * MB && WS_X1B >= WS_STATES && WS_X1B >= WS_SSQ + 1 * MB, "workspace");

struct Params {
  const float* in[29];
  float* out;
  unsigned char* ws;
  int ph_lo, ph_hi;
};
enum { I_XP = 0, I_XS, I_CAK, I_CAV, I_SF, I_SB, I_CCKV, I_CKPE, I_C, I_CCTX, I_ADAW, I_ADAB, I_NORMW, I_ABWIN, I_SINK, I_CONVW, I_CONVB,
       I_DTB, I_ALOG, I_DSKIP, I_GNW, I_ABWOUT, I_MWIN, I_QNW, I_KVNW, I_WUQ, I_WUKV, I_MWOUT, I_FNW };

DI unsigned pack2(float a, float b) { fl2v v = {a, b}; bf2v r = __builtin_convertvector(v, bf2v); return __builtin_bit_cast(unsigned, r); }
DI bf16_t f2bf(float a) { return (bf16_t)(pack2(a, 0.f) & 0xffffu); }
DI float bf2f(bf16_t b) { return __uint_as_float(((unsigned)b) << 16); }
DI float bflo(unsigned u) { return __uint_as_float(u << 16); }
DI float bfhi(unsigned u) { return __uint_as_float(u & 0xffff0000u); }
DI float silu_f(float x) { return x * __builtin_amdgcn_rcpf(1.f + __builtin_amdgcn_exp2f(-x * 1.4426950408889634f)); }
DI float softplus_f(float x) { return x > 20.f ? x : log1pf(__expf(x)); }
DI float ex2(float x) { return __builtin_amdgcn_exp2f(x); }
DI bf16x8 mk8(unsigned a, unsigned b, unsigned c, unsigned d) { uint4 u = make_uint4(a, b, c, d); return __builtin_bit_cast(bf16x8, u); }
DI int cond_of(int row) { return row < NCTX ? 0 : 1 + ((row - NCTX) >> 12); }
DI float wave_sum(float v) {
#pragma unroll
  for (int o = 32; o > 0; o >>= 1) v += __shfl_xor(v, o);
  return v;
}
DI float mod_val(const Params& p, int layer, int cond, int which, int c) {
  return ((const float*)(p.ws + WS_MODP))[(layer * 3 + cond) * 3072 + which * 1024 + c];
}
DI void chunk_rows(int gc, int& row0, int& s0, int& s1) {
  if (gc < 64) { int seq = gc >> 1; s0 = seq * 256; s1 = s0 + 256; row0 = s0 + (gc & 1) * 128; }
  else { int g2 = gc - 64; int seq = g2 >> 5; s0 = NCTX + seq * 4096; s1 = s0 + 4096; row0 = s0 + (g2 & 31) * 128; }
}

DI void p0_mod_item(const Params& p, int item, unsigned char* smem) {
  const int tid = threadIdx.x;
  const int kc = item & 31, cgp = (item >> 5) % 12, layer = item / 384;
  float* sl = (float*)smem;
  __syncthreads();
  if (tid < 96) {
    int j = tid >> 5, k = kc * 32 + (tid & 31);
    const float* cv = j == 0 ? p.in[I_CCTX] : p.in[I_C] + (j - 1) * 1024;
    sl[tid] = silu_f(cv[k]);
  }
  __syncthreads();
  const int col = cgp * 256 + tid;
  const float* W = p.in[I_ADAW] + (size_t)layer * 1024 * 3072 + (size_t)(kc * 32) * 3072 + col;
  float wv[32];
#pragma unroll
  for (int kk = 0; kk < 32; ++kk) wv[kk] = W[(size_t)kk * 3072];
  float a0 = 0.f, a1 = 0.f, a2 = 0.f;
#pragma unroll
  for (int kk = 0; kk < 32; ++kk) { a0 += sl[kk] * wv[kk]; a1 += sl[32 + kk] * wv[kk]; a2 += sl[64 + kk] * wv[kk]; }
  if (kc == 0) { float bb = p.in[I_ADAB][layer * 3072 + col]; a0 += bb; a1 += bb; a2 += bb; }
  float* mp = (float*)(p.ws + WS_MODP) + (size_t)layer * 3 * 3072 + col;
  atomicAdd(mp, a0); atomicAdd(mp + 3072, a1); atomicAdd(mp + 6144, a2);
  if (layer == 0) {
    asm volatile("s_waitcnt vmcnt(0)" ::: "memory");
    __syncthreads();
    if (tid == 0) __hip_atomic_fetch_add((unsigned*)(p.ws + WS_GCNT), 1u, __ATOMIC_RELAXED, __HIP_MEMORY_SCOPE_AGENT);
  }
}
DI void p0_wt_tile(const float* src, int ldsrc, bf16_t* dst, int K, int k0, int n0, int nvalid, int mode, const float* rowscale, int rs_off, unsigned char* smem) {
  const int tid = threadIdx.x;
  float* tile = (float*)smem;
  const int c = tid & 63, r0 = tid >> 6;
  int n = n0 + c, sc;
  if (mode == 0) sc = n < nvalid ? n : -1;
  else sc = n < 384 ? n : (n < 1408 ? n + 32 : (n < 1440 ? n - 1024 : -1));
  __syncthreads();
  float vv[16];
#pragma unroll
  for (int i = 0; i < 16; ++i) { int k = k0 + r0 + 4 * i; vv[i] = sc >= 0 ? src[(size_t)k * ldsrc + sc] : 0.f; }
#pragma unroll
  for (int i = 0; i < 16; ++i) {
    int k = k0 + r0 + 4 * i; float v = vv[i];
    if (rowscale && k >= rs_off) v *= rowscale[k - rs_off];
    tile[(r0 + 4 * i) * 65 + c] = v;
  }
  __syncthreads();
  const int nn = tid >> 2, kk0 = (tid & 3) * 16;
  unsigned u[8];
#pragma unroll
  for (int e = 0; e < 8; ++e) u[e] = pack2(tile[(kk0 + 2 * e) * 65 + nn], tile[(kk0 + 2 * e + 1) * 65 + nn]);
  uint4* d = (uint4*)(dst + (size_t)(n0 + nn) * K + k0 + kk0);
  d[0] = make_uint4(u[0], u[1], u[2], u[3]); d[1] = make_uint4(u[4], u[5], u[6], u[7]);
}
constexpr int T_ABIN = 16 * 58, T_ABOUT = 24 * 16, T_MIN = 16 * 24, T_UQ = 4 * 24, T_UKV = 2 * 32, T_MOUT = 16 * 16;
constexpr int N_WT = T_ABIN + T_ABOUT + T_MIN + T_UQ + T_UKV + T_MOUT;
DI void wt_item(const Params& p, int t, unsigned char* smem) {
  if (t < T_ABIN) { int nt = t % 58, kt = t / 58; p0_wt_tile(p.in[I_ABWIN], 3616, (bf16_t*)(p.ws + W_ABIN), 1024, kt * 64, nt * 64, 3616, 0, nullptr, 0, smem); return; }
  t -= T_ABIN;
  if (t < T_ABOUT) { int nt = t % 16, kt = t / 16; p0_wt_tile(p.in[I_ABWOUT], 1024, (bf16_t*)(p.ws + W_ABOUT), 1536, kt * 64, nt * 64, 1024, 0, p.in[I_GNW], 512, smem); return; }
  t -= T_ABOUT;
  if (t < T_MIN) { int nt = t % 24, kt = t / 24; p0_wt_tile(p.in[I_MWIN], 1440, (bf16_t*)(p.ws + W_MIN), 1024, kt * 64, nt * 64, 1440, 1, nullptr, 0, smem); return; }
  t -= T_MIN;
  if (t < T_UQ) { int nt = t % 24, kt = t / 24; p0_wt_tile(p.in[I_WUQ], 1536, (bf16_t*)(p.ws + W_UQ), 256, kt * 64, nt * 64, 1536, 0, p.in[I_QNW], 0, smem); return; }
  t -= T_UQ;
  if (t < T_UKV) { int nt = t % 32, kt = t / 32; p0_wt_tile(p.in[I_WUKV], 2048, (bf16_t*)(p.ws + W_UKV), 128, kt * 64, nt * 64, 2048, 0, nullptr, 0, smem); return; }
  t -= T_UKV;
  { int nt = t % 16, kt = t / 16; p0_wt_tile(p.in[I_MWOUT], 1024, (bf16_t*)(p.ws + W_MOUT), 1024, kt * 64, nt * 64, 1024, 0, nullptr, 0, smem); }
}
DI void phase0(const Params& p, unsigned char* smem) {
  constexpr int N_MOD = 384;
  constexpr int N_CACHE = 64;
  constexpr int N_ALL = N_MOD + N_CACHE;
  for (int item = blockIdx.x; item < N_ALL; item += gridDim.x) {
    if (item < N_MOD) { p0_mod_item(p, item, smem); continue; }
    int t = item - N_MOD;
    const int tid = threadIdx.x;
    if (t < 32) {
      int e0 = t * 2048 + tid * 8;
      const float4* s = (const float4*)(p.in[I_CAK] + e0);
      float4 a = s[0], b = s[1];
      *(uint4*)((bf16_t*)(p.ws + WS_KA) + (size_t)NTOK * 128 + e0) = make_uint4(pack2(a.x, a.y), pack2(a.z, a.w), pack2(b.x, b.y), pack2(b.z, b.w));
    } else {
      int e0 = (t - 32) * 2048 + tid * 8;
      bf16_t* vt = (bf16_t*)(p.ws + WS_VTA);
#pragma unroll
      for (int e = 0; e < 8; ++e) {
        int idx = e0 + e;
        int d = idx & 63, kvh = (idx >> 6) & 1, rj = idx >> 7;
        int row = NTOK + rj;
        vt[((size_t)(row >> 6) * 2 + kvh) * 4096 + d * 64 + (row & 63)] = f2bf(p.in[I_CAV][idx]);
      }
    }
  }
}

DI void phase_modnorm(const Params& p, int layer, unsigned char* smem) {
  const int tid = threadIdx.x, lane = tid & 63, w = tid >> 6;
  float* em = (float*)smem;
  float* ea = em + 3072;
  if (layer == 0 && tid == 0) {
    unsigned spins = 0;
    while (__hip_atomic_load((unsigned*)(p.ws + WS_GCNT), __ATOMIC_RELAXED, __HIP_MEMORY_SCOPE_AGENT) < 384u && ++spins < (1u << 22)) __builtin_amdgcn_s_sleep(2);
  }
  __syncthreads();
  for (int i = tid; i < 3072; i += 256) {
    int cond = i >> 10, c = i & 1023;
    float* mpa = (float*)(p.ws + WS_MODP) + (layer * 3 + cond) * 3072;
    float sh = __hip_atomic_load(mpa + c, __ATOMIC_RELAXED, __HIP_MEMORY_SCOPE_AGENT), sc = __hip_atomic_load(mpa + 1024 + c, __ATOMIC_RELAXED, __HIP_MEMORY_SCOPE_AGENT);
    em[i] = p.in[I_NORMW][layer * 1024 + c] * (1.f + sc); ea[i] = sh;
  }
  __syncthreads();
  bf16_t* H = (bf16_t*)(p.ws + WS_H);
  for (int item = blockIdx.x; item < NTOK / 4; item += gridDim.x) {
    int row = item * 4 + w;
    float4 v[4]; float ss = 0.f;
    if (layer == 0) {
      const float* xr = row < NCTX ? p.in[I_XP] + (size_t)row * 1024 : p.in[I_XS] + (size_t)(row - NCTX) * 1024;
#pragma unroll
      for (int i = 0; i < 4; ++i) v[i] = ((const float4*)xr)[lane + 64 * i];
    } else {
      const uint2* xr = (const uint2*)((const bf16_t*)(p.ws + WS_X1B) + (size_t)row * 1024);
#pragma unroll
      for (int i = 0; i < 4; ++i) { uint2 u = xr[lane + 64 * i]; v[i] = make_float4(bflo(u.x), bfhi(u.x), bflo(u.y), bfhi(u.y)); }
    }
#pragma unroll
    for (int i = 0; i < 4; ++i) ss += v[i].x * v[i].x + v[i].y * v[i].y + v[i].z * v[i].z + v[i].w * v[i].w;
    ss = wave_sum(ss);
    float rstd = rsqrtf(ss * (1.f / 1024.f) + EPS);
    int cond = cond_of(row);
#pragma unroll
    for (int i = 0; i < 4; ++i) {
      int col = (lane + 64 * i) * 4;
      float4 m = *(const float4*)(em + cond * 1024 + col), a = *(const float4*)(ea + cond * 1024 + col);
      uint2 o = make_uint2(pack2(v[i].x * rstd * m.x + a.x, v[i].y * rstd * m.y + a.y), pack2(v[i].z * rstd * m.z + a.z, v[i].w * rstd * m.w + a.w));
      *(uint2*)(H + (size_t)row * 1024 + col) = o;
    }
  }
}

template <bool NARROW = false>
DI void gemm_mainloop(f32x4 (&acc)[4][4], const bf16_t* __restrict__ A, int lda, const bf16_t* __restrict__ B, int ldb, int K, int m0, int n0, unsigned char* smem) {
  const int tid = threadIdx.x, lane = tid & 63, w = tid >> 6, wm = w >> 1, wn = w & 1, lc = lane & 15, g = lane >> 4;
  const int rr = w * 8 + (lane >> 3);
  const int q = (lane & 7) ^ (((w & 1) * 4 + (lane >> 4)) & 7);
  const bf16_t* ga = A + (size_t)(m0 + rr) * lda + q * 8;
  const bf16_t* gb = B + (size_t)(n0 + rr) * ldb + q * 8;
  const int sw = (lc >> 1) & 7;
  const int nk = K >> 6;
#define GSTAGE(s, kt) do { _Pragma("unroll") for (int i = 0; i < 4; ++i) { \
    __builtin_amdgcn_global_load_lds((const unsigned*)(ga + (size_t)(i * 32) * lda + (kt) * 64), (unsigned*)(smem + (s) * 32768 + w * 1024 + i * 4096), 16, 0, 0); \
    if (!NARROW || i == 0) __builtin_amdgcn_global_load_lds((const unsigned*)(gb + (size_t)(i * 32) * ldb + (kt) * 64), (unsigned*)(smem + (s) * 32768 + 16384 + w * 1024 + i * 4096), 16, 0, 0); } } while (0)
  __syncthreads();
  GSTAGE(0, 0);
  asm volatile("s_waitcnt vmcnt(0)" ::: "memory");
  __syncthreads();
  for (int kt = 0; kt < nk; ++kt) {
    const int cur = kt & 1;
    if (kt + 1 < nk) GSTAGE(cur ^ 1, kt + 1);
    const unsigned char* sa = smem + cur * 32768 + (wm * 64 + lc) * 128;
    const unsigned char* sb = smem + cur * 32768 + 16384 + (wn * 64 + lc) * 128;
#pragma unroll
    for (int ks = 0; ks < 2; ++ks) {
      const int co = ((ks * 4 + g) ^ sw) * 16;
      bf16x8 af[4], bfr[4];
      if (NARROW) {
        if (wn == 0) {
#pragma unroll
          for (int i = 0; i < 4; ++i) af[i] = *(const bf16x8*)(sa + i * 2048 + co);
#pragma unroll
          for (int j = 0; j < 2; ++j) bfr[j] = *(const bf16x8*)(sb + j * 2048 + co);
#pragma unroll
          for (int i = 0; i < 4; ++i)
#pragma unroll
            for (int j = 0; j < 2; ++j) acc[i][j] = MFMA16(af[i], bfr[j], acc[i][j]);
        }
      } else {
#pragma unroll
        for (int i = 0; i < 4; ++i) af[i] = *(const bf16x8*)(sa + i * 2048 + co);
#pragma unroll
        for (int j = 0; j < 4; ++j) bfr[j] = *(const bf16x8*)(sb + j * 2048 + co);
#pragma unroll
        for (int i = 0; i < 4; ++i)
#pragma unroll
          for (int j = 0; j < 4; ++j) acc[i][j] = MFMA16(af[i], bfr[j], acc[i][j]);
      }
    }
    asm volatile("s_waitcnt vmcnt(0)" ::: "memory");
    __syncthreads();
  }
#undef GSTAGE
}
DI void acc_zero(f32x4 (&acc)[4][4]) {
#pragma unroll
  for (int i = 0; i < 4; ++i)
#pragma unroll
    for (int j = 0; j < 4; ++j) acc[i][j] = f32x4{0.f, 0.f, 0.f, 0.f};
}
DI void rope64(f32x4 (&acc)[4][4], int rowbase  , int lc, int g) {
  const float inv = ex2(-(float)lc * (13.287712379549449f / 16.f));
#pragma unroll
  for (int i = 0; i < 4; ++i)
#pragma unroll
    for (int r = 0; r < 4; ++r) {
      int l = (rowbase + i * 16 + 4 * g + r - NCTX) & 4095;
      float tr = (float)(l >> 6) * inv, tc = (float)(l & 63) * inv;
      float cr = __cosf(tr), sr = __sinf(tr), cc = __cosf(tc), sc = __sinf(tc);
      float a = acc[i][0][r], b = acc[i][1][r];
      acc[i][0][r] = a * cr - b * sr; acc[i][1][r] = b * cr + a * sr;
      a = acc[i][2][r]; b = acc[i][3][r];
      acc[i][2][r] = a * cc - b * sc; acc[i][3][r] = b * cc + a * sc;
    }
}

DI float* stage_wave_tile(const f32x4 (&acc)[4][4], unsigned char* smem) {
  const int lane = threadIdx.x & 63, w = threadIdx.x >> 6, lc = lane & 15, g = lane >> 4;
  float* wb = (float*)smem + w * (64 * 68);
#pragma unroll
  for (int i = 0; i < 4; ++i)
#pragma unroll
    for (int j = 0; j < 4; ++j)
#pragma unroll
      for (int r = 0; r < 4; ++r) wb[(i * 16 + 4 * g + r) * 68 + j * 16 + lc] = acc[i][j][r];
  __builtin_amdgcn_wave_barrier();
  return wb;
}
DI uint2 pk4(float4 v) { return make_uint2(pack2(v.x, v.y), pack2(v.z, v.w)); }
DI float4 silu4(float4 v) { return make_float4(silu_f(v.x), silu_f(v.y), silu_f(v.z), silu_f(v.w)); }
DI void xcd_tile(int v, int NT, int& mt, int& nt) { const int x = v & 7, j = v >> 3; mt = (j / NT) * 8 + x; nt = j % NT; }

DI void phase_ab_in(const Params& p, unsigned char* smem) {
  const int tid = threadIdx.x, lane = tid & 63, w = tid >> 6, wm = w >> 1, wn = w & 1, lc = lane & 15, g = lane >> 4;
  const bf16_t* H = (const bf16_t*)(p.ws + WS_H);
  const bf16_t* W = (const bf16_t*)(p.ws + W_ABIN);
  bf16_t* QA = (bf16_t*)(p.ws + WS_QA); bf16_t* KA = (bf16_t*)(p.ws + WS_KA); bf16_t* VTA = (bf16_t*)(p.ws + WS_VTA);
  bf16_t* GA = (bf16_t*)(p.ws + WS_GA); bf16_t* ZS = (bf16_t*)(p.ws + WS_ZS); bf16_t* XB = (bf16_t*)(p.ws + WS_XBCR);
  float* DTP = (float*)(p.ws + WS_DTP);
  constexpr int NT = ABIN_N / 128;
  for (int tile = blockIdx.x; tile < 128 * NT; tile += gridDim.x) {
    int mt, nt; if (tile < 128 * (NT - 1)) xcd_tile(tile, NT - 1, mt, nt); else { mt = tile - 128 * (NT - 1); nt = NT - 1; }
    const int m0 = mt * 128, n0 = nt * 128;
    f32x4 acc[4][4]; acc_zero(acc);
    if (n0 >= 3584) gemm_mainloop<true>(acc, H, 1024, W, 1024, 1024, m0, n0, smem); else gemm_mainloop<false>(acc, H, 1024, W, 1024, 1024, m0, n0, smem);
    const int rb = m0 + wm * 64, cb = n0 + wn * 64;
    const bool lat = m0 >= NCTX;
    if (n0 < 640 && lat) rope64(acc, rb, lc, g);
    if (n0 >= 640 && n0 < 768) {
#pragma unroll
      for (int i = 0; i < 4; ++i)
#pragma unroll
        for (int j = 0; j < 4; ++j) {
          int row = rb + i * 16 + 4 * g, d = j * 16 + lc;
          *(uint2*)(VTA + ((size_t)(row >> 6) * 2 + wn) * 4096 + d * 64 + (row & 63)) = make_uint2(pack2(acc[i][j][0], acc[i][j][1]), pack2(acc[i][j][2], acc[i][j][3]));
        }
    }
    if (n0 < 3584) {
      const float* wb = stage_wave_tile(acc, smem);
      const int c4 = (lane & 15) * 4, col = cb + c4;
#pragma unroll 4
      for (int it = 0; it < 16; ++it) {
        const int rl = it * 4 + (lane >> 4); const size_t row = (size_t)(rb + rl);
        float4 v = *(const float4*)(wb + rl * 68 + c4);
        if (n0 < 512) { const float qs = 0.125f * LOG2E; *(uint2*)(QA + row * 512 + col) = pk4(make_float4(v.x * qs, v.y * qs, v.z * qs, v.w * qs)); }
        else if (n0 < 640) { *(uint2*)(KA + row * 128 + col - 512) = pk4(v); if (!lat) *(float4*)(p.out + O_CAK + row * 128 + col - 512) = v; }
        else if (n0 < 768) { if (!lat) *(float4*)(p.out + O_CAV + row * 128 + col - 640) = v; }
        else if (n0 < 1280) *(uint2*)(GA + row * 512 + col - 768) = pk4(silu4(v));
        else if (n0 < 2304) *(uint2*)(ZS + row * 1024 + col - 1280) = pk4(silu4(v));
        else *(uint2*)(XB + row * 1280 + col - 2304) = pk4(v);
      }
    } else if (wn == 0) {
#pragma unroll
      for (int i = 0; i < 4; ++i)
#pragma unroll
        for (int j = 0; j < 2; ++j)
#pragma unroll
          for (int r = 0; r < 4; ++r) {
            int row = rb + i * 16 + 4 * g + r, col = j * 16 + lc;
            DTP[(size_t)row * 32 + col] = softplus_f(acc[i][j][r] + p.in[I_DTB][col]);
          }
    }
  }
}

DI void phase_conv(const Params& p, unsigned char* smem) {
  const int tid = threadIdx.x;
  bf16_t* raw = (bf16_t*)smem;
  bf16_t* outl = raw + 132 * 64;
  const bf16_t* XB = (const bf16_t*)(p.ws + WS_XBCR);
  bf16_t* XT = (bf16_t*)(p.ws + WS_XT); bf16_t* BT = (bf16_t*)(p.ws + WS_BT); bf16_t* BCM = (bf16_t*)(p.ws + WS_BCM);
  for (int item = blockIdx.x; item < 128 * 20; item += gridDim.x) {
    const int gc = item / 20, cgp = item % 20;
    int row0, s0, s1; chunk_rows(gc, row0, s0, s1);
    __syncthreads();
    for (int c = tid; c < 132 * 8; c += 256) {
      int t = c >> 3, c8 = c & 7, row = row0 - 2 + t;
      uint4 v = make_uint4(0, 0, 0, 0);
      if (row >= s0 && row < s1) v = *(const uint4*)(XB + (size_t)row * 1280 + cgp * 64 + c8 * 8);
      *(uint4*)(raw + t * 64 + c8 * 8) = v;
    }
    __syncthreads();
    {
      const int c = tid & 63, tg = tid >> 6, ch = cgp * 64 + c;
      float wv[5];
#pragma unroll
      for (int j = 0; j < 5; ++j) wv[j] = p.in[I_CONVW][j * 1280 + ch];
      const float bias = p.in[I_CONVB][ch];
      float x0 = bf2f(raw[(tg * 32 + 0) * 64 + c]), x1 = bf2f(raw[(tg * 32 + 1) * 64 + c]), x2 = bf2f(raw[(tg * 32 + 2) * 64 + c]), x3 = bf2f(raw[(tg * 32 + 3) * 64 + c]);
#pragma unroll 8
      for (int t = 0; t < 32; ++t) {
        int tt = tg * 32 + t;
        float x4 = bf2f(raw[(tt + 4) * 64 + c]);
        float o = bias + wv[0] * x0 + wv[1] * x1 + wv[2] * x2 + wv[3] * x3 + wv[4] * x4;
        outl[tt * 66 + c] = f2bf(silu_f(o));
        x0 = x1; x1 = x2; x2 = x3; x3 = x4;
      }
    }
    __syncthreads();
    if (cgp >= 16) {
      for (int c = tid; c < 1024; c += 256) {
        int tt = c >> 3, c8 = c & 7;
        const unsigned* s = (const unsigned*)(outl + tt * 66 + c8 * 8);
        *(uint4*)(BCM + (size_t)(row0 + tt) * 256 + (cgp - 16) * 64 + c8 * 8) = make_uint4(s[0], s[1], s[2], s[3]);
      }
    }
    if (cgp < 18) {
      for (int c = tid; c < 1024; c += 256) {
        int ch = c >> 4, t8 = c & 15;
        unsigned u[4];
#pragma unroll
        for (int e = 0; e < 4; ++e) u[e] = (unsigned)outl[(t8 * 8 + 2 * e) * 66 + ch] | ((unsigned)outl[(t8 * 8 + 2 * e + 1) * 66 + ch] << 16);
        bf16_t* dst = cgp < 16 ? XT + ((size_t)gc * 1024 + cgp * 64 + ch) * 128 + t8 * 8 : BT + ((size_t)gc * 128 + (cgp - 16) * 64 + ch) * 128 + t8 * 8;
        *(uint4*)dst = make_uint4(u[0], u[1], u[2], u[3]);
      }
    }
  }
}

DI float chunk_cums(const Params& p, int row0, int head, int dir, int lane, float* dtv, float* cumv, float* facv) {
  const float* DTP = (const float*)(p.ws + WS_DTP);
  const float a = -__expf(p.in[I_ALOG][dir * 16 + head]);
  float d0 = DTP[(size_t)(row0 + 2 * lane) * 32 + dir * 16 + head], d1 = DTP[(size_t)(row0 + 2 * lane + 1) * 32 + dir * 16 + head];
  float v0 = d0 * a, v1 = d1 * a, s = v0 + v1, sc = s;
#pragma unroll
  for (int o = 1; o < 64; o <<= 1) { float t = __shfl_up(sc, o); if (lane >= o) sc += t; }
  float total = __shfl(sc, 63);
  float e = sc - s, c0 = e + v0, c1 = e + s;
  if (facv) {
    dtv[dir * 128 + 2 * lane] = d0; dtv[dir * 128 + 2 * lane + 1] = d1;
    if (dir == 0) {
      cumv[2 * lane] = c0; cumv[2 * lane + 1] = c1;
      facv[2 * lane] = d0 * __expf(total - c0); facv[2 * lane + 1] = d1 * __expf(total - c1);
    } else {
      cumv[128 + 2 * lane] = total - c0 + v0; cumv[128 + 2 * lane + 1] = total - c1 + v1;
      facv[128 + 2 * lane] = d0 * __expf(c0 - v0); facv[128 + 2 * lane + 1] = d1 * __expf(c1 - v1);
    }
  } else {
    const float q0 = dir == 0 ? c0 : total - c0 + v0, q1 = dir == 0 ? c1 : total - c1 + v1;
    cumv[dir * 128 + 2 * lane] = q0 * LOG2E; cumv[dir * 128 + 2 * lane + 1] = q1 * LOG2E;
    dtv[dir * 128 + 2 * lane] = q0 * LOG2E - __log2f(d0); dtv[dir * 128 + 2 * lane + 1] = q1 * LOG2E - __log2f(d1);
  }
  return total;
}

DI void phase_ssd_states(const Params& p, unsigned char* smem) {
  const int tid = threadIdx.x, lane = tid & 63, w = tid >> 6, lc = lane & 15, g = lane >> 4;
  bf16_t* xf = (bf16_t*)smem;
  bf16_t* xb = xf + 64 * 136;
  bf16_t* bt = xb + 64 * 136;
  float* dtv = (float*)(bt + 64 * 136);
  float* cumv = dtv + 256;
  float* facv = cumv + 256;
  const bf16_t* XT = (const bf16_t*)(p.ws + WS_XT); const bf16_t* BT = (const bf16_t*)(p.ws + WS_BT);
  float* ST = (float*)(p.ws + WS_STATES); float* CD = (float*)(p.ws + WS_CDEC);
  for (int item = blockIdx.x; item < 2048; item += gridDim.x) {
    const int gc = item >> 4, head = item & 15, grp = head >> 3;
    int row0, s0, s1; chunk_rows(gc, row0, s0, s1);
    __syncthreads();
    if (w < 2) {
      float total = chunk_cums(p, row0, head, w, lane, dtv, cumv, facv);
      if (lane == 0) CD[(gc * 2 + w) * 16 + head] = __expf(total);
    }
    __syncthreads();
#pragma unroll
    for (int i = 0; i < 4; ++i) {
      int id = tid + 256 * i, r = id >> 4, c16 = id & 15;
      uint4 xv = *(const uint4*)(XT + ((size_t)gc * 1024 + head * 64 + r) * 128 + c16 * 8);
      uint4 bv = *(const uint4*)(BT + ((size_t)gc * 128 + grp * 64 + r) * 128 + c16 * 8);
      *(uint4*)(bt + r * 136 + c16 * 8) = bv;
      const float* ff = facv + c16 * 8; const float* fb = facv + 128 + c16 * 8;
      unsigned xs[4] = {xv.x, xv.y, xv.z, xv.w}, of[4], ob[4];
#pragma unroll
      for (int e = 0; e < 4; ++e) {
        float lo = bflo(xs[e]), hi = bfhi(xs[e]);
        of[e] = pack2(lo * ff[2 * e], hi * ff[2 * e + 1]); ob[e] = pack2(lo * fb[2 * e], hi * fb[2 * e + 1]);
      }
      *(uint4*)(xf + r * 136 + c16 * 8) = make_uint4(of[0], of[1], of[2], of[3]);
      *(uint4*)(xb + r * 136 + c16 * 8) = make_uint4(ob[0], ob[1], ob[2], ob[3]);
    }
    __syncthreads();
    f32x4 af[4], ab[4];
#pragma unroll
    for (int j = 0; j < 4; ++j) { af[j] = f32x4{0, 0, 0, 0}; ab[j] = f32x4{0, 0, 0, 0}; }
#pragma unroll
    for (int ks = 0; ks < 4; ++ks) {
      bf16x8 a_f = *(const bf16x8*)(xf + (w * 16 + lc) * 136 + ks * 32 + g * 8);
      bf16x8 a_b = *(const bf16x8*)(xb + (w * 16 + lc) * 136 + ks * 32 + g * 8);
#pragma unroll
      for (int j = 0; j < 4; ++j) {
        bf16x8 b = *(const bf16x8*)(bt + (j * 16 + lc) * 136 + ks * 32 + g * 8);
        af[j] = MFMA16(a_f, b, af[j]); ab[j] = MFMA16(a_b, b, ab[j]);
      }
    }
    bf16_t* o0 = (bf16_t*)ST + ((size_t)(gc * 2 + 0) * 16 + head) * 4096; bf16_t* o1 = (bf16_t*)ST + ((size_t)(gc * 2 + 1) * 16 + head) * 4096;
    const bool odd = lc & 1;
#pragma unroll
    for (int j = 0; j < 4; ++j) {
      const int n2 = j * 16 + (lc & ~1), pb = w * 16 + 4 * g + (odd ? 2 : 0);
      {
        const float y0 = __shfl_xor(odd ? af[j][0] : af[j][2], 1), y1 = __shfl_xor(odd ? af[j][1] : af[j][3], 1);
        const unsigned u0 = odd ? pack2(y0, af[j][2]) : pack2(af[j][0], y0), u1 = odd ? pack2(y1, af[j][3]) : pack2(af[j][1], y1);
        *(unsigned*)(o0 + (pb + 0) * 64 + n2) = u0; *(unsigned*)(o0 + (pb + 1) * 64 + n2) = u1;
      }
      {
        const float y0 = __shfl_xor(odd ? ab[j][0] : ab[j][2], 1), y1 = __shfl_xor(odd ? ab[j][1] : ab[j][3], 1);
        const unsigned u0 = odd ? pack2(y0, ab[j][2]) : pack2(ab[j][0], y0), u1 = odd ? pack2(y1, ab[j][3]) : pack2(ab[j][1], y1);
        *(unsigned*)(o1 + (pb + 0) * 64 + n2) = u0; *(unsigned*)(o1 + (pb + 1) * 64 + n2) = u1;
      }
    }
  }
}

struct AttnArgs {
  const bf16_t* q; int ldq;
  const bf16_t* k; int ldk;
  const bf16_t* kpe;
  const bf16_t* vt; int vt_heads, vhead;
  const bf16_t* gate; int ldg;
  bf16_t* out; int ldo;
  int qrow0, qpos0;
  int seg0_row, seg0_n, seg0_pos, band;
  int seg1_row, seg1_n;
  float sink2; int has_sink; float scale2;
};
using f32x16 = __attribute__((ext_vector_type(16))) float;
#define MFMA32(a, b, c) __builtin_amdgcn_mfma_f32_32x32x16_bf16((a), (b), (c), 0, 0, 0)
template <int DK, bool MLA>
DI void attn_item(const AttnArgs& a, unsigned char* smem, bool dost = true) {
  constexpr int KS = DK / 16, KSTR = DK + 8, KCH = DK / 8, VSTR = 68;
  const int tid = threadIdx.x, lane = tid & 63, w = tid >> 6, r32 = lane & 31, h = lane >> 5;
  bf16_t* sK = (bf16_t*)smem;
  bf16_t* sV = sK + 64 * KSTR;
  bf16x8 qf[KS];
#pragma unroll
  for (int ks = 0; ks < KS; ++ks) qf[ks] = *(const bf16x8*)(a.q + (size_t)(a.qrow0 + w * 32 + r32) * a.ldq + ks * 16 + h * 8);
  f32x16 O[2], L;
#pragma unroll
  for (int i = 0; i < 16; ++i) { O[0][i] = 0.f; O[1][i] = 0.f; L[i] = a.has_sink ? 1.f : 0.f; }
  float mrow = a.has_sink ? a.sink2 : -1e30f;
  const bf16x8 ones = mk8(0x3F803F80u, 0x3F803F80u, 0x3F803F80u, 0x3F803F80u);
  const int ntiles = (a.seg0_n + a.seg1_n) >> 6;
  const int qpos = a.qpos0 + w * 32 + r32;
  uint4 pk0, pk1, pk2, pv0, pv1;
#define KR(i) ((tid + 256 * (i)) / KCH)
#define KQ(i) ((tid + 256 * (i)) % KCH)
#define KSRC(i, krow) ((!MLA || KQ(i) < 8) ? a.k + (size_t)((krow) + KR(i)) * a.ldk + KQ(i) * 8 : a.kpe + (size_t)((krow) + KR(i)) * 32 + (KQ(i) - 8) * 8)
  const int vr = tid >> 3, vq = tid & 7;
#define ATT_LOAD(t_) do { const int kk0_ = (t_) * 64; const int krow_ = kk0_ < a.seg0_n ? a.seg0_row + kk0_ : a.seg1_row + kk0_ - a.seg0_n; \
    pk0 = *(const uint4*)KSRC(0, krow_); pk1 = *(const uint4*)KSRC(1, krow_); if (MLA) pk2 = *(const uint4*)KSRC(2, krow_); \
    const bf16_t* vsrc_ = a.vt + ((size_t)(krow_ >> 6) * a.vt_heads + a.vhead) * 4096; \
    pv0 = *(const uint4*)(vsrc_ + vr * 64 + vq * 8); pv1 = *(const uint4*)(vsrc_ + (vr + 32) * 64 + vq * 8); } while (0)
  ATT_LOAD(0);
  for (int t = 0; t < ntiles; ++t) {
    const int kk0 = t * 64; const bool loc = kk0 < a.seg0_n;
    __syncthreads();
    *(uint4*)(sK + KR(0) * KSTR + KQ(0) * 8) = pk0; *(uint4*)(sK + KR(1) * KSTR + KQ(1) * 8) = pk1; if (MLA) *(uint4*)(sK + KR(2) * KSTR + KQ(2) * 8) = pk2;
    *(uint2*)(sV + vr * VSTR + vq * 8) = make_uint2(pv0.x, pv0.y); *(uint2*)(sV + vr * VSTR + vq * 8 + 4) = make_uint2(pv0.z, pv0.w);
    *(uint2*)(sV + (vr + 32) * VSTR + vq * 8) = make_uint2(pv1.x, pv1.y); *(uint2*)(sV + (vr + 32) * VSTR + vq * 8 + 4) = make_uint2(pv1.z, pv1.w);
    __syncthreads();
    if (t + 1 < ntiles) ATT_LOAD(t + 1);
    f32x16 S[2];
#pragma unroll
    for (int i = 0; i < 16; ++i) { S[0][i] = 0.f; S[1][i] = 0.f; }
#pragma unroll
    for (int ks = 0; ks < KS; ++ks)
#pragma unroll
      for (int kt = 0; kt < 2; ++kt) {
        bf16x8 kf = *(const bf16x8*)(sK + (kt * 32 + r32) * KSTR + ks * 16 + h * 8);
        S[kt] = MFMA32(kf, qf[ks], S[kt]);
      }
    const bool msk = a.band && loc;
    float m = -1e30f;
#pragma unroll
    for (int kt = 0; kt < 2; ++kt)
#pragma unroll
      for (int ri = 0; ri < 16; ++ri) {
        float v = S[kt][ri];
        if (msk) { int dlt = a.seg0_pos + kk0 + kt * 32 + (ri & 3) + 8 * (ri >> 2) + 4 * h - qpos; if (dlt > 128 || dlt < -128) v = -1e30f; S[kt][ri] = v; }
        m = fmaxf(m, v);
      }
    m = fmaxf(m, __shfl_xor(m, 32));
    if (__builtin_amdgcn_ballot_w64(m > mrow + 8.f) != 0ull) {
      const float mnew = fmaxf(mrow, m), alpha = ex2(mrow - mnew);
      mrow = mnew;
#pragma unroll
      for (int i = 0; i < 16; ++i) { O[0][i] *= alpha; O[1][i] *= alpha; L[i] *= alpha; }
    }
#pragma unroll
    for (int kt = 0; kt < 2; ++kt)
#pragma unroll
      for (int s2 = 0; s2 < 2; ++s2) {
        const bf16x8 pf = mk8(pack2(ex2(S[kt][8 * s2 + 0] - mrow), ex2(S[kt][8 * s2 + 1] - mrow)), pack2(ex2(S[kt][8 * s2 + 2] - mrow), ex2(S[kt][8 * s2 + 3] - mrow)),
                              pack2(ex2(S[kt][8 * s2 + 4] - mrow), ex2(S[kt][8 * s2 + 5] - mrow)), pack2(ex2(S[kt][8 * s2 + 6] - mrow), ex2(S[kt][8 * s2 + 7] - mrow)));
        L = MFMA32(ones, pf, L);
#pragma unroll
        for (int dt = 0; dt < 2; ++dt) {
          const bf16_t* vp = sV + (dt * 32 + r32) * VSTR + kt * 32 + 16 * s2 + 4 * h;
          const uint2 lo = *(const uint2*)vp, hi = *(const uint2*)(vp + 8);
          O[dt] = MFMA32(mk8(lo.x, lo.y, hi.x, hi.y), pf, O[dt]);
        }
      }
  }
#undef KR
#undef KQ
#undef KSRC
#undef ATT_LOAD
  {
    const float inv = 1.f / L[0];
    const size_t row = (size_t)(a.qrow0 + w * 32 + r32);
#pragma unroll
    for (int dt = 0; dt < 2; ++dt)
#pragma unroll
      for (int gq = 0; gq < 4; ++gq) {
        const int d0 = dt * 32 + 8 * gq + 4 * h;
        const uint2 gt = *(const uint2*)(a.gate + row * a.ldg + d0);
        const float o0 = O[dt][4 * gq + 0] * inv * bflo(gt.x), o1 = O[dt][4 * gq + 1] * inv * bfhi(gt.x), o2 = O[dt][4 * gq + 2] * inv * bflo(gt.y), o3 = O[dt][4 * gq + 3] * inv * bfhi(gt.y);
        if (dost) *(uint2*)(a.out + row * a.ldo + d0) = make_uint2(pack2(o0, o1), pack2(o2, o3));
      }
  }
}

template <int DK, bool MLA>
DI void attn_item2(const AttnArgs& a, unsigned char* smem) {
  constexpr int KS = DK / 16, KSTR = DK + 8, KCH = DK / 8, VSTR = 68;
  const int tid = threadIdx.x, lane = tid & 63, w = tid >> 6, r32 = lane & 31, h = lane >> 5;
  bf16_t* sK = (bf16_t*)smem;
  bf16_t* sV = sK + 64 * KSTR;
  bf16_t* sQ = sV + 64 * VSTR;
  __syncthreads();
  for (int c = tid; c < 256 * KCH; c += 256) { const int r = c / KCH, cc = c % KCH; *(uint4*)(sQ + r * KSTR + cc * 8) = *(const uint4*)(a.q + (size_t)(a.qrow0 + r) * a.ldq + cc * 8); }
  const bf16_t* sQw = sQ + (w * 64 + r32) * KSTR + h * 8;
  f32x16 O[2][2];
#pragma unroll
  for (int i = 0; i < 16; ++i) { O[0][0][i] = 0.f; O[0][1][i] = 0.f; O[1][0][i] = 0.f; O[1][1][i] = 0.f; }
  float mrow[2], lsum[2];
  mrow[0] = mrow[1] = a.has_sink ? a.sink2 : -1e30f;
  lsum[0] = lsum[1] = (a.has_sink && h == 0) ? 1.f : 0.f;
  const int ntiles = (a.seg0_n + a.seg1_n) >> 6;
  uint4 pk0, pk1, pk2, pv0, pv1;
#define KR(i) ((tid + 256 * (i)) / KCH)
#define KQ(i) ((tid + 256 * (i)) % KCH)
#define KSRC(i, krow) ((!MLA || KQ(i) < 8) ? a.k + (size_t)((krow) + KR(i)) * a.ldk + KQ(i) * 8 : a.kpe + (size_t)((krow) + KR(i)) * 32 + (KQ(i) - 8) * 8)
  const int vr = tid >> 3, vq = tid & 7;
#define ATT_LOAD(t_) do { const int kk0_ = (t_) * 64; const int krow_ = kk0_ < a.seg0_n ? a.seg0_row + kk0_ : a.seg1_row + kk0_ - a.seg0_n; \
    pk0 = *(const uint4*)KSRC(0, krow_); pk1 = *(const uint4*)KSRC(1, krow_); if (MLA) pk2 = *(const uint4*)KSRC(2, krow_); \
    const bf16_t* vsrc_ = a.vt + ((size_t)(krow_ >> 6) * a.vt_heads + a.vhead) * 4096; \
    pv0 = *(const uint4*)(vsrc_ + vr * 64 + vq * 8); pv1 = *(const uint4*)(vsrc_ + (vr + 32) * 64 + vq * 8); } while (0)
  ATT_LOAD(0);
  for (int t = 0; t < ntiles; ++t) {
    __syncthreads();
    *(uint4*)(sK + KR(0) * KSTR + KQ(0) * 8) = pk0; *(uint4*)(sK + KR(1) * KSTR + KQ(1) * 8) = pk1; if (MLA) *(uint4*)(sK + KR(2) * KSTR + KQ(2) * 8) = pk2;
    *(uint2*)(sV + vr * VSTR + vq * 8) = make_uint2(pv0.x, pv0.y); *(uint2*)(sV + vr * VSTR + vq * 8 + 4) = make_uint2(pv0.z, pv0.w);
    *(uint2*)(sV + (vr + 32) * VSTR + vq * 8) = make_uint2(pv1.x, pv1.y); *(uint2*)(sV + (vr + 32) * VSTR + vq * 8 + 4) = make_uint2(pv1.z, pv1.w);
    __syncthreads();
    if (t + 1 < ntiles) ATT_LOAD(t + 1);
    f32x16 S[2][2];
#pragma unroll
    for (int i = 0; i < 16; ++i) { S[0][0][i] = 0.f; S[0][1][i] = 0.f; S[1][0][i] = 0.f; S[1][1][i] = 0.f; }
#pragma unroll
    for (int ks = 0; ks < KS; ++ks)
#pragma unroll
      for (int kt = 0; kt < 2; ++kt) {
        bf16x8 kf = *(const bf16x8*)(sK + (kt * 32 + r32) * KSTR + ks * 16 + h * 8);
        const bf16x8 q0 = *(const bf16x8*)(sQw + ks * 16), q1 = *(const bf16x8*)(sQw + 32 * KSTR + ks * 16);
        S[0][kt] = MFMA32(kf, q0, S[0][kt]); S[1][kt] = MFMA32(kf, q1, S[1][kt]);
      }
    float mx[2];
#pragma unroll
    for (int gq = 0; gq < 2; ++gq) {
      float m = -1e30f;
#pragma unroll
      for (int kt = 0; kt < 2; ++kt)
#pragma unroll
        for (int ri = 0; ri < 16; ++ri) m = fmaxf(m, S[gq][kt][ri]);
      mx[gq] = fmaxf(m, __shfl_xor(m, 32));
    }
    if (__builtin_amdgcn_ballot_w64((mx[0] > mrow[0] + 8.f) || (mx[1] > mrow[1] + 8.f)) != 0ull) {
#pragma unroll
      for (int gq = 0; gq < 2; ++gq) {
        const float mnew = fmaxf(mrow[gq], mx[gq]), alpha = ex2(mrow[gq] - mnew);
        mrow[gq] = mnew; lsum[gq] *= alpha;
#pragma unroll
        for (int i = 0; i < 16; ++i) { O[gq][0][i] *= alpha; O[gq][1][i] *= alpha; }
      }
    }
#pragma unroll
    for (int kt = 0; kt < 2; ++kt)
#pragma unroll
      for (int s2 = 0; s2 < 2; ++s2) {
        bf16x8 pf[2];
#pragma unroll
        for (int gq = 0; gq < 2; ++gq) {
          float e[8];
#pragma unroll
          for (int j = 0; j < 8; ++j) e[j] = ex2(S[gq][kt][8 * s2 + j] - mrow[gq]);
          lsum[gq] += ((e[0] + e[1]) + (e[2] + e[3])) + ((e[4] + e[5]) + (e[6] + e[7]));
          pf[gq] = mk8(pack2(e[0], e[1]), pack2(e[2], e[3]), pack2(e[4], e[5]), pack2(e[6], e[7]));
        }
#pragma unroll
        for (int dt = 0; dt < 2; ++dt) {
          const bf16_t* vp = sV + (dt * 32 + r32) * VSTR + kt * 32 + 16 * s2 + 4 * h;
          const uint2 lo = *(const uint2*)vp, hi = *(const uint2*)(vp + 8);
          const bf16x8 vf = mk8(lo.x, lo.y, hi.x, hi.y);
          O[0][dt] = MFMA32(vf, pf[0], O[0][dt]); O[1][dt] = MFMA32(vf, pf[1], O[1][dt]);
        }
      }
  }
#undef KR
#undef KQ
#undef KSRC
#undef ATT_LOAD
#pragma unroll
  for (int gq = 0; gq < 2; ++gq) {
    const float l = lsum[gq] + __shfl_xor(lsum[gq], 32);
    const float inv = 1.f / l;
    const size_t row = (size_t)(a.qrow0 + w * 64 + gq * 32 + r32);
#pragma unroll
    for (int dt = 0; dt < 2; ++dt)
#pragma unroll
      for (int g4 = 0; g4 < 4; ++g4) {
        const int d0 = dt * 32 + 8 * g4 + 4 * h;
        const uint2 gt = *(const uint2*)(a.gate + row * a.ldg + d0);
        const float o0 = O[gq][dt][4 * g4 + 0] * inv * bflo(gt.x), o1 = O[gq][dt][4 * g4 + 1] * inv * bfhi(gt.x), o2 = O[gq][dt][4 * g4 + 2] * inv * bflo(gt.y), o3 = O[gq][dt][4 * g4 + 3] * inv * bfhi(gt.y);
        *(uint2*)(a.out + row * a.ldo + d0) = make_uint2(pack2(o0, o1), pack2(o2, o3));
      }
  }
}

DI void scan_item(const Params& p, int it, bool latent, bool dost = true) {
  const int tid = threadIdx.x;
  const int quarter = it & 3, head = (it >> 2) & 15, dir = (it >> 6) & 1, b = it >> 7;
  const int e = quarter * 1024 + tid * 4;
  const float* ST = (const float*)(p.ws + WS_STATES); const float* CD = (const float*)(p.ws + WS_CDEC);
  bf16_t* HIN = (bf16_t*)(p.ws + WS_HIN);
  float4 h = make_float4(0.f, 0.f, 0.f, 0.f);
  const int nc = latent ? 32 : 2, gc0 = latent ? 64 + b * 32 : b * 2;
  if (latent) h = *(const float4*)((dir == 0 ? p.in[I_SF] : p.in[I_SB]) + ((size_t)b * 16 + head) * 4096 + e);
  if (latent) {
    for (int s0 = 0; s0 < 32; s0 += 8) {
      float4 st[8]; float dec[8];
#pragma unroll
      for (int u = 0; u < 8; ++u) {
        const int c = dir == 0 ? s0 + u : 31 - s0 - u;
        const size_t base = ((size_t)((gc0 + c) * 2 + dir) * 16 + head);
        dec[u] = CD[base]; { const uint2 q2 = *(const uint2*)((const bf16_t*)ST + base * 4096 + e); st[u] = make_float4(bflo(q2.x), bfhi(q2.x), bflo(q2.y), bfhi(q2.y)); }
      }
#pragma unroll
      for (int u = 0; u < 8; ++u) {
        const int c = dir == 0 ? s0 + u : 31 - s0 - u;
        const size_t base = ((size_t)((gc0 + c) * 2 + dir) * 16 + head);
        if (dost) *(uint2*)(HIN + base * 4096 + e) = make_uint2(pack2(h.x, h.y), pack2(h.z, h.w));
        h.x = h.x * dec[u] + st[u].x; h.y = h.y * dec[u] + st[u].y; h.z = h.z * dec[u] + st[u].z; h.w = h.w * dec[u] + st[u].w;
      }
    }
  }
}
DI void scan_ctx_item(const Params& p, int it, bool dost = true) {
  const int tid = threadIdx.x;
  const int head = it & 15, dir = (it >> 4) & 1, b = it >> 5;
  const float* ST = (const float*)(p.ws + WS_STATES); const float* CD = (const float*)(p.ws + WS_CDEC);
  bf16_t* HIN = (bf16_t*)(p.ws + WS_HIN);
  const int c0 = dir == 0 ? 0 : 1, c1 = 1 - c0;
  const size_t b0 = ((size_t)((b * 2 + c0) * 2 + dir) * 16 + head), b1 = ((size_t)((b * 2 + c1) * 2 + dir) * 16 + head);
  const float dec1 = CD[b1];
  float4 s0[4], s1[4];
#pragma unroll
  for (int qq = 0; qq < 4; ++qq) { const int e = qq * 1024 + tid * 4; const uint2 q0 = *(const uint2*)((const bf16_t*)ST + b0 * 4096 + e), q1 = *(const uint2*)((const bf16_t*)ST + b1 * 4096 + e);
    s0[qq] = make_float4(bflo(q0.x), bfhi(q0.x), bflo(q0.y), bfhi(q0.y)); s1[qq] = make_float4(bflo(q1.x), bfhi(q1.x), bflo(q1.y), bfhi(q1.y)); }
#pragma unroll
  for (int qq = 0; qq < 4; ++qq) {
    const int e = qq * 1024 + tid * 4;
    if (dost) {
      *(uint2*)(HIN + b0 * 4096 + e) = make_uint2(0u, 0u);
      *(uint2*)(HIN + b1 * 4096 + e) = make_uint2(pack2(s0[qq].x, s0[qq].y), pack2(s0[qq].z, s0[qq].w));
    }
    *(float4*)(p.out + (dir == 0 ? O_SF : O_SB) + ((size_t)b * 16 + head) * 4096 + e) =
        make_float4(s0[qq].x * dec1 + s1[qq].x, s0[qq].y * dec1 + s1[qq].y, s0[qq].z * dec1 + s1[qq].z, s0[qq].w * dec1 + s1[qq].w);
  }
}
DI void attn_a_item(const Params& p, int it, bool latent, unsigned char* smem, bool dost = true) {
  AttnArgs a;
  const int qb = latent ? (it & 31) : (it & 1), head = latent ? ((it >> 5) & 7) : ((it >> 1) & 7), b = latent ? (it >> 8) : (it >> 4);
  const int kvh = head >> 2;
  const int seqrow = latent ? NCTX + b * 4096 : b * 256;
  a.q = (const bf16_t*)(p.ws + WS_QA) + head * 64; a.ldq = 512;
  a.k = (const bf16_t*)(p.ws + WS_KA) + kvh * 64; a.ldk = 128; a.kpe = nullptr;
  a.vt = (const bf16_t*)(p.ws + WS_VTA); a.vt_heads = 2; a.vhead = kvh;
  a.gate = (const bf16_t*)(p.ws + WS_GA) + head * 64; a.ldg = 512;
  a.out = (bf16_t*)(p.ws + WS_QA) + head * 64; a.ldo = 512;
  a.qrow0 = seqrow + qb * 128; a.qpos0 = qb * 128;
  if (latent) {
    int klo = qb * 128 - 128; if (klo < 0) klo = 0; int khi = qb * 128 + 256; if (khi > 4096) khi = 4096;
    a.seg0_row = seqrow + klo; a.seg0_n = khi - klo; a.seg0_pos = klo; a.band = 1;
    a.seg1_row = NTOK + b * 256; a.seg1_n = 256;
  } else {
    a.seg0_row = seqrow; a.seg0_n = 256; a.seg0_pos = 0; a.band = 0; a.seg1_row = 0; a.seg1_n = 0;
  }
  a.sink2 = p.in[I_SINK][head] * LOG2E; a.has_sink = 1; a.scale2 = 0.125f * LOG2E;
  attn_item<64, false>(a, smem, dost);
}
DI void phase_scan_attn_a(const Params& p, unsigned char* smem, bool dost = true) {
  for (int item = blockIdx.x; item < 2304; item += gridDim.x) {
    if (item < 512) attn_a_item(p, item, true, smem, dost);
    else if (item < 768) scan_item(p, item - 512, true, dost);
    else if (item < 1280) attn_a_item(p, item - 768, false, smem, dost);
    else scan_ctx_item(p, item - 1280, dost);
  }
}

DI void phase_ssd_out(const Params& p, unsigned char* smem, bool dost = true) {
  const int tid = threadIdx.x, lane = tid & 63, w = tid >> 6, lc = lane & 15, g = lane >> 4;
  bf16_t* sB = (bf16_t*)smem;
  bf16_t* sC = sB + 128 * 72;
  bf16_t* sX = sC + 128 * 72;
  bf16_t* sHf = sX + 64 * 136;
  bf16_t* sHb = sHf + 64 * 72;
  float* dtv = (float*)(sHb + 64 * 72);
  float* cumv = dtv + 256;
  const bf16_t* XT = (const bf16_t*)(p.ws + WS_XT); const bf16_t* BCM = (const bf16_t*)(p.ws + WS_BCM); const bf16_t* HIN = (const bf16_t*)(p.ws + WS_HIN);
  bf16_t* ZS = (bf16_t*)(p.ws + WS_ZS); float* SSQ = (float*)(p.ws + WS_SSQ);
  for (int item = blockIdx.x; item < 2048; item += gridDim.x) {
    const int gc = item >> 4, head = item & 15, grp = head >> 3;
    int row0, s0, s1; chunk_rows(gc, row0, s0, s1);
    __syncthreads();
    if (w < 2) chunk_cums(p, row0, head, w, lane, dtv, cumv, nullptr);
#pragma unroll
    for (int i = 0; i < 4; ++i) {
      int id = tid + 256 * i;
      { int r = id >> 3, c8 = id & 7;
        *(uint4*)(sB + r * 72 + c8 * 8) = *(const uint4*)(BCM + (size_t)(row0 + r) * 256 + grp * 64 + c8 * 8);
        *(uint4*)(sC + r * 72 + c8 * 8) = *(const uint4*)(BCM + (size_t)(row0 + r) * 256 + 128 + grp * 64 + c8 * 8); }
      { int r = id >> 4, c16 = id & 15; *(uint4*)(sX + r * 136 + c16 * 8) = *(const uint4*)(XT + ((size_t)gc * 1024 + head * 64 + r) * 128 + c16 * 8); }
    }
#pragma unroll
    for (int i = 0; i < 2; ++i) {
      int id = tid + 256 * i, r = id >> 3, c8 = id & 7;
      *(uint4*)(sHf + r * 72 + c8 * 8) = *(const uint4*)(HIN + ((size_t)(gc * 2 + 0) * 16 + head) * 4096 + r * 64 + c8 * 8);
      *(uint4*)(sHb + r * 72 + c8 * 8) = *(const uint4*)(HIN + ((size_t)(gc * 2 + 1) * 16 + head) * 4096 + r * 64 + c8 * 8);
    }
    __syncthreads();
    bf16x8 cf[2][2];
#pragma unroll
    for (int lt = 0; lt < 2; ++lt)
#pragma unroll
      for (int ks = 0; ks < 2; ++ks) cf[lt][ks] = *(const bf16x8*)(sC + (w * 32 + lt * 16 + lc) * 72 + ks * 32 + g * 8);
    float cfl[2], crl[2];
#pragma unroll
    for (int lt = 0; lt < 2; ++lt) { cfl[lt] = cumv[w * 32 + lt * 16 + lc]; crl[lt] = cumv[128 + w * 32 + lt * 16 + lc]; }
    f32x4 Y[4][2], T[4][2];
#pragma unroll
    for (int pt = 0; pt < 4; ++pt) { T[pt][0] = f32x4{0, 0, 0, 0}; T[pt][1] = f32x4{0, 0, 0, 0}; }
#pragma unroll
    for (int ks = 0; ks < 2; ++ks)
#pragma unroll
      for (int pt = 0; pt < 4; ++pt) {
        bf16x8 hf = *(const bf16x8*)(sHf + (pt * 16 + lc) * 72 + ks * 32 + g * 8);
        T[pt][0] = MFMA16(hf, cf[0][ks], T[pt][0]); T[pt][1] = MFMA16(hf, cf[1][ks], T[pt][1]);
      }
    {
      float e0 = ex2(cfl[0]), e1 = ex2(cfl[1]);
#pragma unroll
      for (int pt = 0; pt < 4; ++pt) { Y[pt][0] = T[pt][0] * e0; Y[pt][1] = T[pt][1] * e1; }
    }
#pragma unroll
    for (int pt = 0; pt < 4; ++pt) { T[pt][0] = f32x4{0, 0, 0, 0}; T[pt][1] = f32x4{0, 0, 0, 0}; }
#pragma unroll
    for (int ks = 0; ks < 2; ++ks)
#pragma unroll
      for (int pt = 0; pt < 4; ++pt) {
        bf16x8 hb = *(const bf16x8*)(sHb + (pt * 16 + lc) * 72 + ks * 32 + g * 8);
        T[pt][0] = MFMA16(hb, cf[0][ks], T[pt][0]); T[pt][1] = MFMA16(hb, cf[1][ks], T[pt][1]);
      }
    {
      float e0 = ex2(crl[0]), e1 = ex2(crl[1]);
#pragma unroll
      for (int pt = 0; pt < 4; ++pt) { Y[pt][0] += T[pt][0] * e0; Y[pt][1] += T[pt][1] * e1; }
    }
    const float dskip = p.in[I_DSKIP][head];
#pragma unroll
    for (int sb = 0; sb < 2; ++sb) {
      f32x4 S[4][2];
#pragma unroll
      for (int st = 0; st < 4; ++st) { S[st][0] = f32x4{0, 0, 0, 0}; S[st][1] = f32x4{0, 0, 0, 0}; }
#pragma unroll
      for (int ks = 0; ks < 2; ++ks)
#pragma unroll
        for (int st = 0; st < 4; ++st) {
          bf16x8 bf = *(const bf16x8*)(sB + (sb * 64 + st * 16 + lc) * 72 + ks * 32 + g * 8);
          S[st][0] = MFMA16(bf, cf[0][ks], S[st][0]); S[st][1] = MFMA16(bf, cf[1][ks], S[st][1]);
        }
#pragma unroll
      for (int st = 0; st < 4; ++st) {
        const int sbase = sb * 64 + st * 16 + 4 * g;
        const f32x4 rfs = *(const f32x4*)(dtv + sbase), rbs = *(const f32x4*)(dtv + 128 + sbase);
#pragma unroll
        for (int lt = 0; lt < 2; ++lt) {
          const int l = w * 32 + lt * 16 + lc;
#pragma unroll
          for (int r = 0; r < 4; ++r) {
            const int s = sbase + r;
            const float af = s <= l ? cfl[lt] - rfs[r] : -1e30f, ab = s >= l ? crl[lt] - rbs[r] : -1e30f;
            S[st][lt][r] = S[st][lt][r] * (ex2(af) + ex2(ab)) + (s == l ? dskip : 0.f);
          }
        }
      }
      bf16x8 pf[2][2];
#pragma unroll
      for (int lt = 0; lt < 2; ++lt)
#pragma unroll
        for (int k2 = 0; k2 < 2; ++k2)
          pf[lt][k2] = mk8(pack2(S[2 * k2][lt][0], S[2 * k2][lt][1]), pack2(S[2 * k2][lt][2], S[2 * k2][lt][3]),
                           pack2(S[2 * k2 + 1][lt][0], S[2 * k2 + 1][lt][1]), pack2(S[2 * k2 + 1][lt][2], S[2 * k2 + 1][lt][3]));
#pragma unroll
      for (int pt = 0; pt < 4; ++pt)
#pragma unroll
        for (int k2 = 0; k2 < 2; ++k2) {
          uint2 lo = *(const uint2*)(sX + (pt * 16 + lc) * 136 + sb * 64 + k2 * 32 + 4 * g);
          uint2 hi = *(const uint2*)(sX + (pt * 16 + lc) * 136 + sb * 64 + k2 * 32 + 16 + 4 * g);
          bf16x8 xf = mk8(lo.x, lo.y, hi.x, hi.y);
          Y[pt][0] = MFMA16(xf, pf[0][k2], Y[pt][0]); Y[pt][1] = MFMA16(xf, pf[1][k2], Y[pt][1]);
        }
    }
#pragma unroll
    for (int lt = 0; lt < 2; ++lt) {
      const size_t row = (size_t)(row0 + w * 32 + lt * 16 + lc);
      float ss = 0.f;
#pragma unroll
      for (int pt = 0; pt < 4; ++pt) {
        bf16_t* zp = ZS + row * 1024 + head * 64 + pt * 16 + 4 * g;
        uint2 z = *(const uint2*)zp;
        float o0 = Y[pt][lt][0] * bflo(z.x), o1 = Y[pt][lt][1] * bfhi(z.x), o2 = Y[pt][lt][2] * bflo(z.y), o3 = Y[pt][lt][3] * bfhi(z.y);
        ss += o0 * o0 + o1 * o1 + o2 * o2 + o3 * o3;
        if (dost) *(uint2*)zp = make_uint2(pack2(o0, o1), pack2(o2, o3));
      }
      ss += __shfl_xor(ss, 16); ss += __shfl_xor(ss, 32);
      if (g == 0 && dost) SSQ[row * 16 + head] = ss;
    }
  }
}

DI void resid_epilogue(const Params& p, f32x4 (&acc)[4][4], int layer, int m0, int n0, unsigned char* smem) {
  const int tid = threadIdx.x, lane = tid & 63, w = tid >> 6, wm = w >> 1, wn = w & 1;
  const int cond = cond_of(m0);
  const float* wb = stage_wave_tile(acc, smem);
  const int c4 = (lane & 15) * 4, colb = n0 + wn * 64 + c4;
  const float4 gt = *(const float4*)((const float*)(p.ws + WS_MODP) + (layer * 3 + cond) * 3072 + 2048 + colb);
  bf16_t* X1B = (bf16_t*)(p.ws + WS_X1B);
#pragma unroll 4
  for (int it = 0; it < 16; ++it) {
    const int rl = it * 4 + (lane >> 4), row = m0 + wm * 64 + rl;
    const float4 av = *(const float4*)(wb + rl * 68 + c4);
    if (layer == 0) {
      const float* xr = row < NCTX ? p.in[I_XP] + (size_t)row * 1024 : p.in[I_XS] + (size_t)(row - NCTX) * 1024;
      const float4 xv = *(const float4*)(xr + colb);
      *(uint2*)(X1B + (size_t)row * 1024 + colb) = pk4(make_float4(xv.x + gt.x * av.x, xv.y + gt.y * av.y, xv.z + gt.z * av.z, xv.w + gt.w * av.w));
    } else {
      const uint2 xb = *(const uint2*)(X1B + (size_t)row * 1024 + colb);
      const float4 v = make_float4(bflo(xb.x) + gt.x * av.x, bfhi(xb.x) + gt.y * av.y, bflo(xb.y) + gt.z * av.z, bfhi(xb.y) + gt.w * av.w);
      *(uint2*)((bf16_t*)(p.ws + WS_X2B) + (size_t)row * 1024 + colb) = pk4(v);
      float ss = v.x * v.x + v.y * v.y + v.z * v.z + v.w * v.w;
      ss += __shfl_xor(ss, 8); ss += __shfl_xor(ss, 4); ss += __shfl_xor(ss, 2); ss += __shfl_xor(ss, 1);
      if ((lane & 15) == 0) __hip_atomic_fetch_add((float*)(p.ws + WS_ROWSQ) + row, ss, __ATOMIC_RELAXED, __HIP_MEMORY_SCOPE_AGENT);
    }
  }
}
DI void phase_ab_out(const Params& p, unsigned char* smem) {
  const int tid = threadIdx.x, lane = tid & 63, w = tid >> 6, wm = w >> 1, g = lane >> 4;
  float* srs = (float*)(smem + 65536);
  const float* SSQ = (const float*)(p.ws + WS_SSQ);
  const bf16_t* W = (const bf16_t*)(p.ws + W_ABOUT);
  for (int tile = blockIdx.x; tile < 128 * 8; tile += gridDim.x) {
    int mt, nt; xcd_tile(tile, 8, mt, nt); const int m0 = mt * 128, n0 = nt * 128;
    __syncthreads();
    if (tid < 128) {
      const float4* s = (const float4*)(SSQ + (size_t)(m0 + tid) * 16);
      float4 a = s[0], b = s[1], c = s[2], d = s[3];
      float t = a.x + a.y + a.z + a.w + b.x + b.y + b.z + b.w + c.x + c.y + c.z + c.w + d.x + d.y + d.z + d.w;
      srs[tid] = rsqrtf(t * (1.f / 1024.f) + EPS);
    }
    f32x4 acc[4][4]; acc_zero(acc);
    gemm_mainloop(acc, (const bf16_t*)(p.ws + WS_ZS), 1024, W + 512, 1536, 1024, m0, n0, smem);
#pragma unroll
    for (int i = 0; i < 4; ++i)
#pragma unroll
      for (int r = 0; r < 4; ++r) {
        float rs = srs[wm * 64 + i * 16 + 4 * g + r];
#pragma unroll
        for (int j = 0; j < 4; ++j) acc[i][j][r] *= rs;
      }
    gemm_mainloop(acc, (const bf16_t*)(p.ws + WS_QA), 512, W, 1536, 512, m0, n0, smem);
    resid_epilogue(p, acc, 0, m0, n0, smem);
  }
}
DI void phase_mla_out(const Params& p, unsigned char* smem) {
  for (int tile = blockIdx.x; tile < 128 * 8; tile += gridDim.x) {
    int mt, nt; xcd_tile(tile, 8, mt, nt); const int m0 = mt * 128, n0 = nt * 128;
    f32x4 acc[4][4]; acc_zero(acc);
    gemm_mainloop(acc, (const bf16_t*)(p.ws + WS_AOM), 1024, (const bf16_t*)(p.ws + W_MOUT), 1024, 1024, m0, n0, smem);
    resid_epilogue(p, acc, 1, m0, n0, smem);
  }
}

DI void phase_mla_in(const Params& p, unsigned char* smem) {
  const int tid = threadIdx.x, lane = tid & 63, w = tid >> 6, wm = w >> 1, wn = w & 1, lc = lane & 15, g = lane >> 4;
  bf16_t* GM = (bf16_t*)(p.ws + WS_GM);
  constexpr int NT = MIN_N / 128;
  for (int tile = blockIdx.x; tile < 128 * NT; tile += gridDim.x) {
    int mt, nt; xcd_tile(tile, NT, mt, nt); const int m0 = mt * 128, n0 = nt * 128;
    f32x4 acc[4][4]; acc_zero(acc);
    gemm_mainloop(acc, (const bf16_t*)(p.ws + WS_H), 1024, (const bf16_t*)(p.ws + W_MIN), 1024, 1024, m0, n0, smem);
    const int rb = m0 + wm * 64, cb = n0 + wn * 64;
    const float* wb = stage_wave_tile(acc, smem);
    const int c4 = (lane & 15) * 4, col = cb + c4;
    if (n0 < 256) {
      bf16_t* CQB = (bf16_t*)(p.ws + WS_CQN); float* rsq = (float*)(p.ws + WS_ROWSQ_Q);
#pragma unroll 4
      for (int it = 0; it < 16; ++it) {
        const int rl = it * 4 + (lane >> 4); const size_t row = (size_t)(rb + rl);
        const float4 v = *(const float4*)(wb + rl * 68 + c4);
        *(uint2*)(CQB + row * 256 + col) = pk4(v);
        float ss = v.x * v.x + v.y * v.y + v.z * v.z + v.w * v.w;
        ss += __shfl_xor(ss, 8); ss += __shfl_xor(ss, 4); ss += __shfl_xor(ss, 2); ss += __shfl_xor(ss, 1);
        if ((lane & 15) == 0) __hip_atomic_fetch_add(rsq + row, ss, __ATOMIC_RELAXED, __HIP_MEMORY_SCOPE_AGENT);
      }
    } else if (n0 < 384) {
      float* ex = (float*)(smem + 69632);
#pragma unroll 4
      for (int it = 0; it < 16; ++it) {
        const int rl = it * 4 + (lane >> 4);
        const float4 v = *(const float4*)(wb + rl * 68 + c4);
        float ss = v.x * v.x + v.y * v.y + v.z * v.z + v.w * v.w;
        ss += __shfl_xor(ss, 8); ss += __shfl_xor(ss, 4); ss += __shfl_xor(ss, 2); ss += __shfl_xor(ss, 1);
        if ((lane & 15) == 0) ex[(wm * 2 + wn) * 64 + rl] = ss;
      }
      __syncthreads();
      bf16_t* CKVN = (bf16_t*)(p.ws + WS_CKVN);
      const float4 nw = *(const float4*)(p.in[I_KVNW] + col - 256);
#pragma unroll 4
      for (int it = 0; it < 16; ++it) {
        const int rl = it * 4 + (lane >> 4); const size_t row = (size_t)(rb + rl);
        const float rs = rsqrtf((ex[(wm * 2 + 0) * 64 + rl] + ex[(wm * 2 + 1) * 64 + rl]) * (1.f / 128.f) + EPS);
        const float4 v = *(const float4*)(wb + rl * 68 + c4);
        const float4 o = make_float4(v.x * rs * nw.x, v.y * rs * nw.y, v.z * rs * nw.z, v.w * rs * nw.w);
        *(uint2*)(CKVN + row * 128 + col - 256) = pk4(o);
        if (m0 < NCTX) *(float4*)(p.out + O_CKV + row * 128 + col - 256) = o;
      }
    } else if (n0 < 1408) {
#pragma unroll 4
      for (int it = 0; it < 16; ++it) {
        const int rl = it * 4 + (lane >> 4); const size_t row = (size_t)(rb + rl);
        *(uint2*)(GM + row * 1024 + col - 384) = pk4(silu4(*(const float4*)(wb + rl * 68 + c4)));
      }
    } else if (wn == 0) {
      bf16_t* KPEB = (bf16_t*)(p.ws + WS_KPEB);
      const bool lat = m0 >= NCTX;
#pragma unroll 4
      for (int it = 0; it < 16; ++it) {
        const int rl = it * 4 + (lane >> 4); const size_t row = (size_t)(rb + rl);
        const float4 v = *(const float4*)(wb + rl * 68 + c4);
        const float4 pr = make_float4(__shfl_xor(v.x, 2), __shfl_xor(v.y, 2), __shfl_xor(v.z, 2), __shfl_xor(v.w, 2));
        float4 o = v;
        if (lat) {
          const int l = (int)(row - NCTX) & 4095;
          const float pos = (c4 & 16) ? (float)(l & 63) : (float)(l >> 6);
          const float vv[4] = {v.x, v.y, v.z, v.w}, pp[4] = {pr.x, pr.y, pr.z, pr.w}; float oo[4];
#pragma unroll
          for (int e = 0; e < 4; ++e) {
            const float th = pos * ex2(-(float)((c4 + e) & 7) * (13.287712379549449f / 8.f)), c = __cosf(th), sn = __sinf(th);
            oo[e] = (c4 & 8) ? vv[e] * c + pp[e] * sn : vv[e] * c - pp[e] * sn;
          }
          o = make_float4(oo[0], oo[1], oo[2], oo[3]);
        }
        if (c4 < 32) {
          *(uint2*)(KPEB + row * 32 + c4) = pk4(o);
          if (!lat) *(float4*)(p.out + O_KPE + row * 32 + c4) = v;
        }
      }
    }
  }
}

DI void mla_cache_convert(const Params& p) {
  bf16_t* CKVN = (bf16_t*)(p.ws + WS_CKVN) + (size_t)NTOK * 128; bf16_t* KPEB = (bf16_t*)(p.ws + WS_KPEB) + (size_t)NTOK * 32;
  for (int i = blockIdx.x * 256 + threadIdx.x; i < (65536 + 16384) / 4; i += gridDim.x * 256) {
    if (i < 16384) { float4 v = ((const float4*)p.in[I_CCKV])[i]; *(uint2*)(CKVN + i * 4) = make_uint2(pack2(v.x, v.y), pack2(v.z, v.w)); }
    else { int k = i - 16384; float4 v = ((const float4*)p.in[I_CKPE])[k]; *(uint2*)(KPEB + k * 4) = make_uint2(pack2(v.x, v.y), pack2(v.z, v.w)); }
  }
}
DI void phase_mla_prep(const Params& p) {
  const int tid = threadIdx.x, lane = tid & 63, w = tid >> 6;
  const float* CQ = (const float*)(p.ws + WS_CQ); const float* CKV = (const float*)(p.ws + WS_CKV); const float* KPE = (const float*)(p.ws + WS_KPE);
  bf16_t* CQN = (bf16_t*)(p.ws + WS_CQN); bf16_t* CKVN = (bf16_t*)(p.ws + WS_CKVN); bf16_t* KPEB = (bf16_t*)(p.ws + WS_KPEB);
  for (int item = blockIdx.x; item < NTOK / 4; item += gridDim.x) {
    const size_t row = (size_t)item * 4 + w;
    {
      float4 v = *(const float4*)(CQ + row * 256 + lane * 4);
      float ss = wave_sum(v.x * v.x + v.y * v.y + v.z * v.z + v.w * v.w);
      float rs = rsqrtf(ss * (1.f / 256.f) + EPS);
      float4 nw = *(const float4*)(p.in[I_QNW] + lane * 4);
      *(uint2*)(CQN + row * 256 + lane * 4) = make_uint2(pack2(v.x * rs * nw.x, v.y * rs * nw.y), pack2(v.z * rs * nw.z, v.w * rs * nw.w));
    }
    {
      float2 v = *(const float2*)(CKV + row * 128 + lane * 2);
      float ss = wave_sum(v.x * v.x + v.y * v.y);
      float rs = rsqrtf(ss * (1.f / 128.f) + EPS);
      float2 nw = *(const float2*)(p.in[I_KVNW] + lane * 2);
      float a = v.x * rs * nw.x, b = v.y * rs * nw.y;
      *(unsigned*)(CKVN + row * 128 + lane * 2) = pack2(a, b);
      if (row < NCTX) *(float2*)(p.out + O_CKV + row * 128 + lane * 2) = make_float2(a, b);
    }
    {
      float v = lane < 32 ? KPE[row * 32 + lane] : 0.f;
      float pr = __shfl_xor(v, 8);
      float o = v;
      if (row >= NCTX) {
        int l = (int)(row - NCTX) & 4095;
        float pos = (lane & 16) ? (float)(l & 63) : (float)(l >> 6);
        float th = pos * ex2(-(float)(lane & 7) * (13.287712379549449f / 8.f));
        float c = __cosf(th), s = __sinf(th);
        o = (lane & 8) ? v * c + pr * s : v * c - pr * s;
      } else if (lane < 32) p.out[O_KPE + row * 32 + lane] = v;
      if (lane < 32) KPEB[row * 32 + lane] = f2bf(o);
    }
  }
}

DI void phase_mla_up(const Params& p, unsigned char* smem) {
  const int tid = threadIdx.x, lane = tid & 63, w = tid >> 6, wm = w >> 1, wn = w & 1, lc = lane & 15, g = lane >> 4;
  bf16_t* QM = (bf16_t*)(p.ws + WS_QM); bf16_t* KN = (bf16_t*)(p.ws + WS_KNOPE); bf16_t* VTM = (bf16_t*)(p.ws + WS_VTM);
  constexpr int NQ = 128 * 12, NKV = 132 * 16;
  for (int tile = blockIdx.x; tile < NQ + NKV; tile += gridDim.x) {
    f32x4 acc[4][4]; acc_zero(acc);
    if (tile < NQ) {
      int mt, nt; xcd_tile(tile, 12, mt, nt); const int m0 = mt * 128, n0 = nt * 128;
      gemm_mainloop(acc, (const bf16_t*)(p.ws + WS_CQN), 256, (const bf16_t*)(p.ws + W_UQ), 256, 256, m0, n0, smem);
      const int rb = m0 + wm * 64, cb = n0 + wn * 64; const bool lat = m0 >= NCTX;
      const float inv = ex2(-(float)(lc & 7) * (13.287712379549449f / 8.f));
      if (lat) {
#pragma unroll
        for (int j = 0; j < 4; ++j) {
          const int col0 = cb + j * 16, d0 = col0 % 96;
          if (d0 >= 64) {
#pragma unroll
            for (int i = 0; i < 4; ++i)
#pragma unroll
              for (int r = 0; r < 4; ++r) {
                const int row = rb + i * 16 + 4 * g + r;
                float v = acc[i][j][r];
                float pr = __shfl_xor(v, 8);
                int l = (row - NCTX) & 4095;
                float pos = d0 >= 80 ? (float)(l & 63) : (float)(l >> 6);
                float th = pos * inv, c = __cosf(th), sn = __sinf(th);
                acc[i][j][r] = (lc & 8) ? v * c + pr * sn : v * c - pr * sn;
              }
          }
        }
      }
      {
        const float* wb = stage_wave_tile(acc, smem);
        const int c4 = (lane & 15) * 4; const float qs = 0.10206207261596575f * LOG2E;
#pragma unroll 4
        for (int it = 0; it < 16; ++it) {
          const int rl = it * 4 + (lane >> 4); const size_t row = (size_t)(rb + rl);
          const float4 v = *(const float4*)(wb + rl * 68 + c4);
          const float qr = qs * rsqrtf(((const float*)(p.ws + WS_ROWSQ_Q))[row] * (1.f / 256.f) + EPS);
          *(uint2*)(QM + row * 1536 + cb + c4) = pk4(make_float4(v.x * qr, v.y * qr, v.z * qr, v.w * qr));
        }
      }
    } else {
      const int t2 = tile - NQ; int mt, head; if (t2 < 128 * 16) xcd_tile(t2, 16, mt, head); else { mt = t2 >> 4; head = t2 & 15; } const int m0 = mt * 128, n0 = head * 128;
      gemm_mainloop(acc, (const bf16_t*)(p.ws + WS_CKVN), 128, (const bf16_t*)(p.ws + W_UKV), 128, 128, m0, n0, smem);
      const int rb = m0 + wm * 64;
      if (wn == 0) {
        const float* wb = stage_wave_tile(acc, smem);
        const int c4 = (lane & 15) * 4;
#pragma unroll 4
        for (int it = 0; it < 16; ++it) {
          const int rl = it * 4 + (lane >> 4);
          *(uint2*)(KN + (size_t)(rb + rl) * 1024 + head * 64 + c4) = pk4(*(const float4*)(wb + rl * 68 + c4));
        }
      } else {
#pragma unroll
        for (int i = 0; i < 4; ++i)
#pragma unroll
          for (int j = 0; j < 4; ++j) {
            int row = rb + i * 16 + 4 * g, d = j * 16 + lc;
            *(uint2*)(VTM + ((size_t)(row >> 6) * 16 + head) * 4096 + d * 64 + (row & 63)) = make_uint2(pack2(acc[i][j][0], acc[i][j][1]), pack2(acc[i][j][2], acc[i][j][3]));
          }
      }
    }
  }
}

DI void phase_mla_attn(const Params& p, unsigned char* smem) {
  for (int item = blockIdx.x; item < 1024; item += gridDim.x) {
    AttnArgs a;
    const bool latent = item < 512;
    const int it = latent ? item : item - 512;
    int qb, head, b;
    if (latent) { const int x = it & 7, j = it >> 3, pair = x * 4 + (j >> 4); qb = j & 15; head = pair & 15; b = pair >> 4; }
    else { qb = 0; head = it & 15; b = it >> 4; }
    const int seqrow = latent ? NCTX + b * 4096 : b * 256;
    a.q = (const bf16_t*)(p.ws + WS_QM) + head * 96; a.ldq = 1536;
    a.k = (const bf16_t*)(p.ws + WS_KNOPE) + head * 64; a.ldk = 1024; a.kpe = (const bf16_t*)(p.ws + WS_KPEB);
    a.vt = (const bf16_t*)(p.ws + WS_VTM); a.vt_heads = 16; a.vhead = head;
    a.gate = (const bf16_t*)(p.ws + WS_GM) + head * 64; a.ldg = 1024;
    a.out = (bf16_t*)(p.ws + WS_AOM) + head * 64; a.ldo = 1024;
    a.qrow0 = seqrow + qb * 256; a.qpos0 = qb * 256;
    a.seg0_row = seqrow; a.seg0_n = latent ? 4096 : 256; a.seg0_pos = 0; a.band = 0;
    a.seg1_row = NTOK + b * 256; a.seg1_n = latent ? 256 : 0;
    a.sink2 = 0.f; a.has_sink = 0; a.scale2 = 1.f;
    attn_item2<96, true>(a, smem);
  }
}

DI void phase_final_norm(const Params& p) {
  const int tid = threadIdx.x;
  const bf16_t* X2B = (const bf16_t*)(p.ws + WS_X2B); const float* rowsq = (const float*)(p.ws + WS_ROWSQ);
  const int c8 = (tid & 127) * 8;
  const float4 w0 = *(const float4*)(p.in[I_FNW] + c8), w1 = *(const float4*)(p.in[I_FNW] + c8 + 4);
  for (int item = blockIdx.x; item < NTOK / 2; item += gridDim.x) {
    const size_t row = (size_t)item * 2 + (tid >> 7);
    const float rs = rsqrtf(rowsq[row] * (1.f / 1024.f) + EPS);
    const uint4 u = *(const uint4*)(X2B + row * 1024 + c8);
    float* o = p.out + O_Y + row * 1024 + c8;
    *(float4*)o = make_float4(bflo(u.x) * rs * w0.x, bfhi(u.x) * rs * w0.y, bflo(u.y) * rs * w0.z, bfhi(u.y) * rs * w0.w);
    *(float4*)(o + 4) = make_float4(bflo(u.z) * rs * w1.x, bfhi(u.z) * rs * w1.y, bflo(u.w) * rs * w1.z, bfhi(u.w) * rs * w1.w);
  }
}

#define XB_TMO      128
#define XB_XCNT(j)  (256  + 64 * (j))
#define XB_XSUB(j)  (1280 + 64 * (j))
#define XB_XGEN(j)  (2304 + 64 * (j))
#define XB_TOP      3328
#define XB_TOPGEN   3392
#define XCD_BAR_WORDS 3456
#define XB_SPIN_CAP (1u << 18)
#define LAS __attribute__((address_space(3)))

__device__ __forceinline__ unsigned xb_ld(unsigned* p)              { return __hip_atomic_load(p, __ATOMIC_RELAXED, __HIP_MEMORY_SCOPE_AGENT); }
__device__ __forceinline__ unsigned xb_add(unsigned* p, unsigned v) { return __hip_atomic_fetch_add(p, v, __ATOMIC_RELAXED, __HIP_MEMORY_SCOPE_AGENT); }
__device__ __forceinline__ unsigned xb_xcc_id() { return (unsigned)__builtin_amdgcn_s_getreg((3 << 11) | 20) & 0xFu; }
#define XB_SPIN(cond, bar) do { unsigned _sp = 0; while (cond) { __builtin_amdgcn_s_sleep(1); \
    if ((++_sp & 255u) == 0u) { if (xb_ld(&(bar)[XB_TMO])) break; if (_sp > XB_SPIN_CAP) { atomicAdd(&(bar)[XB_TMO], 1u); break; } } } } while (0)

struct XcdBarrier {
    unsigned* bar; unsigned x;
    volatile LAS unsigned* st;
};

__device__ __forceinline__ XcdBarrier xcd_barrier_post(unsigned* bar, volatile LAS unsigned* st) {
    XcdBarrier b; b.bar = bar; b.x = xb_xcc_id(); b.st = st;
    if (threadIdx.x == 0) (void)xb_add(&bar[XB_XCNT(b.x)], 1u);
    return b;
}
__device__ __forceinline__ void xcd_barrier_complete(unsigned* bar, unsigned x, unsigned& nloc, unsigned& nx) {
    const unsigned G = gridDim.x * gridDim.y * gridDim.z;
    unsigned sum, cnt, mine, sp = 0u;
    for (;;) {
        sum = 0u; cnt = 0u; mine = 0u;
#pragma unroll
        for (unsigned j = 0; j < 16; ++j) { const unsigned c = xb_ld(&bar[XB_XCNT(j)]); sum += c; cnt += (c > 0u) ? 1u : 0u; mine = (j == x) ? c : mine; }
        if (sum == G) break;
        __builtin_amdgcn_s_sleep(1);
        if ((++sp & 255u) == 0u) { if (xb_ld(&bar[XB_TMO])) break; if (sp > XB_SPIN_CAP) { atomicAdd(&bar[XB_TMO], 1u); break; } }
    }
    nloc = mine > 0u ? mine : 1u; nx = cnt > 0u ? cnt : 1u;
}

__device__ __forceinline__ void xcd_barrier(const XcdBarrier& b) {
    asm volatile("s_waitcnt vmcnt(0)" ::: "memory");
    __syncthreads();
    if (threadIdx.x == 0) {
        unsigned* bar = b.bar;
        __builtin_amdgcn_s_waitcnt(0);
        unsigned nloc = b.st[0], nx = b.st[1];
        if (nloc == 0u) { xcd_barrier_complete(bar, b.x, nloc, nx); b.st[0] = nloc; b.st[1] = nx; }
        const unsigned old = xb_add(&bar[XB_XSUB(b.x)], 1u);
        const unsigned gen = old / nloc;
        if (old + 1u == (gen + 1u) * nloc) {
            __builtin_amdgcn_fence(__ATOMIC_RELEASE, "agent");
            asm volatile("s_waitcnt vmcnt(0)" ::: "memory");
            const unsigned og = xb_add(&bar[XB_TOP], 1u);
            const unsigned tg = og / nx;
            if (og + 1u == (tg + 1u) * nx) xb_add(&bar[XB_TOPGEN], 1u);
            else XB_SPIN(xb_ld(&bar[XB_TOPGEN]) == tg, bar);
            __builtin_amdgcn_fence(__ATOMIC_ACQUIRE, "agent");
            xb_add(&bar[XB_XGEN(b.x)], 1u);
            asm volatile("s_waitcnt vmcnt(0)" ::: "memory");
        } else {
            XB_SPIN(xb_ld(&bar[XB_XGEN(b.x)]) == gen, bar);
            __builtin_amdgcn_fence(__ATOMIC_ACQUIRE, "agent");
            asm volatile("s_waitcnt vmcnt(0)" ::: "memory");
        }
    }
    __syncthreads();
}


constexpr int N_PHASES = 15;
__global__ void __launch_bounds__(256, 2) mega(Params p) {
  __shared__ __attribute__((aligned(16))) unsigned char smem[75 * 1024];
  volatile LAS unsigned* xst = (volatile LAS unsigned*)(smem + 75 * 1024 - 16);
  if (threadIdx.x == 0) { xst[0] = 0u; xst[1] = 0u; }
  __syncthreads();
  XcdBarrier xb = xcd_barrier_post((unsigned*)(p.ws + WS_BAR), xst);
  if (p.ph_hi > 1000) cg::this_grid().sync();
#ifndef PROBE_D
#define PROBE_D 0
#endif
#ifndef REPEAT_MASK
#define REPEAT_MASK 0
#endif
#define PHASE(n, ...) if (p.ph_lo <= n && n < p.ph_hi) { __VA_ARGS__; if ((REPEAT_MASK >> n) & 1) { __VA_ARGS__; } if (n + 1 < p.ph_hi) xcd_barrier(xb); }
  PHASE(1, phase0(p, smem); for (int t = blockIdx.x; t < N_WT; t += gridDim.x) wt_item(p, t, smem + 24576); phase_modnorm(p, 0, smem))
  PHASE(2, phase_ab_in(p, smem))
  PHASE(3, phase_conv(p, smem); for (int it = 384 + blockIdx.x; it < 768; it += gridDim.x) p0_mod_item(p, it, smem))
  PHASE(4, phase_ssd_states(p, smem))
#if PROBE_D == 1
  if (p.ph_lo <= 5 && 5 < p.ph_hi) phase_scan_attn_a(p, smem, p.ph_hi > 100);
#endif
  PHASE(5, phase_scan_attn_a(p, smem))
#if PROBE_D == 2
  if (p.ph_lo <= 6 && 6 < p.ph_hi) phase_ssd_out(p, smem, p.ph_hi > 100);
#endif
  PHASE(6, phase_ssd_out(p, smem))
  PHASE(7, phase_ab_out(p, smem))
  PHASE(8, phase_modnorm(p, 1, smem); mla_cache_convert(p))
  PHASE(9, phase_mla_in(p, smem))
  PHASE(11, phase_mla_up(p, smem))
  PHASE(12, phase_mla_attn(p, smem))
  PHASE(13, phase_mla_out(p, smem))
  PHASE(14, phase_final_norm(p))
}

extern "C" void kernel_launch(void* const* d_in, const int* in_sizes, int n_in, void* d_out, int out_size, void* d_ws, size_t ws_size, hipStream_t stream) {
  static int grid = 0;
  if (grid == 0) {
    int dev = 0, cus = 0, per_cu = 0;
    hipGetDevice(&dev);
    hipDeviceGetAttribute(&cus, hipDeviceAttributeMultiprocessorCount, dev);
    hipOccupancyMaxActiveBlocksPerMultiprocessor(&per_cu, (const void*)mega, 256, 0);
    if (per_cu < 1) per_cu = 1;
    if (per_cu > 2) per_cu = 2;
    grid = cus * per_cu;
  }
  Params p{};
  for (int i = 0; i < 29; ++i) p.in[i] = (const float*)d_in[i];
  p.out = (float*)d_out; p.ws = (unsigned char*)d_ws;
  hipMemsetAsync((unsigned char*)d_ws + WS_BAR, 0, WS_ZERO_BYTES, stream);
#if MULTI_LAUNCH
  for (int ph = 0; ph < N_PHASES; ++ph) {
    p.ph_lo = ph; p.ph_hi = ph + 1;
    hipLaunchKernelGGL(mega, dim3(grid), dim3(256), 0, stream, p);
  }
#else
  p.ph_lo = 0; p.ph_hi = N_PHASES;
  void* args[] = {&p};
  hipError_t e = hipLaunchCooperativeKernel((const void*)mega, dim3(grid), dim3(256), args, 0, stream);
  if (e != hipSuccess) fprintf(stderr, "cooperative launch failed: %s (grid %d)\n", hipGetErrorString(e), grid);
#endif
}
```

```cpp
#include <hip/hip_runtime.h>
#include <hip/hip_cooperative_groups.h>
#include <cstdio>
namespace cg = cooperative_groups;

#ifndef MULTI_LAUNCH
#define MULTI_LAUNCH 0
#endif

typedef unsigned short bf16_t;
using bf16x8 = __attribute__((ext_vector_type(8))) short;
using f32x4  = __attribute__((ext_vector_type(4))) float;
typedef __bf16 bf2v __attribute__((ext_vector_type(2)));
typedef float  fl2v __attribute__((ext_vector_type(2)));
#define DI __device__ __forceinline__
#define MFMA16(a, b, c) __builtin_amdgcn_mfma_f32_16x16x32_bf16((a), (b), (c), 0, 0, 0)

constexpr int NTOK = 16384;
constexpr int NCTX = 8192;
constexpr int NROWK = 16896;
constexpr int ABIN_N = 3712;
constexpr int MIN_N = 1536;
constexpr float EPS = 1e-6f;
constexpr float LOG2E = 1.4426950408889634f;

constexpr size_t O_Y = 0;
constexpr size_t O_CAK = 16777216;
constexpr size_t O_CAV = 17825792;
constexpr size_t O_SF = 18874368;
constexpr size_t O_SB = 20971520;
constexpr size_t O_CKV = 23068672;
constexpr size_t O_KPE = 24117248;

constexpr size_t KB = 1024, MB = 1024 * 1024;
constexpr size_t W_ABIN = 0;
constexpr size_t W_ABOUT = W_ABIN + (size_t)ABIN_N * 1024 * 2;
constexpr size_t W_MIN = W_ABOUT + 1024 * 1536 * 2;
constexpr size_t W_UQ = W_MIN + 1536 * 1024 * 2;
constexpr size_t W_UKV = W_UQ + 1536 * 256 * 2;
constexpr size_t W_MOUT = W_UKV + 2048 * 128 * 2;
constexpr size_t W_END = W_MOUT + 1024 * 1024 * 2;
constexpr size_t WS_ROWSQ = 17 * MB + 768 * KB + 96 * KB;
constexpr size_t WS_ROWSQ_Q = WS_ROWSQ + 64 * KB;
constexpr size_t WS_ZERO_BYTES = 96 * KB + 128 * KB;
constexpr size_t WS_X2B = 50 * MB;
constexpr size_t WS_GCNT = 17 * MB + 768 * KB + 15 * KB;
constexpr size_t WS_MODP = 17 * MB + 768 * KB + 16 * KB;
constexpr size_t WS_CDEC = 17 * MB + 512 * KB;
constexpr size_t WS_BAR = 17 * MB + 768 * KB;
constexpr size_t WS_H = 18 * MB;
constexpr size_t WS_XT = 18 * MB;
constexpr size_t WS_XBCR = 50 * MB;
constexpr size_t WS_HIN = 50 * MB;
constexpr size_t WS_QA = 90 * MB;
constexpr size_t WS_KA = 106 * MB;
constexpr size_t WS_VTA = WS_KA + 4352 * KB;
constexpr size_t WS_GA = WS_VTA + 4352 * KB;
constexpr size_t WS_ZS = WS_GA + 16 * MB;
constexpr size_t WS_DTP = WS_ZS + 32 * MB;
constexpr size_t WS_BT = WS_DTP + 2 * MB;
constexpr size_t WS_BCM = WS_BT + 4 * MB;
constexpr size_t WS_SSQ = WS_BCM + 8 * MB;
constexpr size_t WS_STATES = WS_SSQ + 1 * MB;
constexpr size_t WS_L0_END = WS_STATES + 64 * MB;
constexpr size_t WS_AOM = 18 * MB;
constexpr size_t WS_GM = 50 * MB;
constexpr size_t WS_CQN = 82 * MB;
constexpr size_t WS_CKVN = 90 * MB;
constexpr size_t WS_KPEB = WS_CKVN + 4352 * KB;
constexpr size_t WS_QM = WS_KPEB + 1280 * KB;
constexpr size_t WS_KNOPE = WS_QM + 48 * MB;
constexpr size_t WS_VTM = WS_KNOPE + 33 * MB;
constexpr size_t WS_CQ = WS_VTM;
constexpr size_t WS_CKV = WS_CQ + 16 * MB;
constexpr size_t WS_KPE = WS_CKV + 8 * MB;
constexpr size_t WS_X1B = WS_VTM + 33 * MB;
constexpr size_t WS_L1_END = WS_X1B + 32 * MB;
static_assert(W_END <= 17 * MB, "weights");
static_assert(WS_L0_END <= 256 * MB && WS_L1_END <= 256 * MB && WS_X1B >= WS_STATES && WS_X1B >= WS_SSQ + 1 * MB, "workspace");

struct Params {
  const float* in[29];
  float* out;
  unsigned char* ws;
  int ph_lo, ph_hi;
};
enum { I_XP = 0, I_XS, I_CAK, I_CAV, I_SF, I_SB, I_CCKV, I_CKPE, I_C, I_CCTX, I_ADAW, I_ADAB, I_NORMW, I_ABWIN, I_SINK, I_CONVW, I_CONVB,
       I_DTB, I_ALOG, I_DSKIP, I_GNW, I_ABWOUT, I_MWIN, I_QNW, I_KVNW, I_WUQ, I_WUKV, I_MWOUT, I_FNW };

DI unsigned pack2(float a, float b) { fl2v v = {a, b}; bf2v r = __builtin_convertvector(v, bf2v); return __builtin_bit_cast(unsigned, r); }
DI bf16_t f2bf(float a) { return (bf16_t)(pack2(a, 0.f) & 0xffffu); }
DI float bf2f(bf16_t b) { return __uint_as_float(((unsigned)b) << 16); }
DI float bflo(unsigned u) { return __uint_as_float(u << 16); }
DI float bfhi(unsigned u) { return __uint_as_float(u & 0xffff0000u); }
DI float silu_f(float x) { return x * __builtin_amdgcn_rcpf(1.f + __builtin_amdgcn_exp2f(-x * 1.4426950408889634f)); }
DI float softplus_f(float x) { return x > 20.f ? x : log1pf(__expf(x)); }
DI float ex2(float x) { return __builtin_amdgcn_exp2f(x); }
DI bf16x8 mk8(unsigned a, unsigned b, unsigned c, unsigned d) { uint4 u = make_uint4(a, b, c, d); return __builtin_bit_cast(bf16x8, u); }
DI int cond_of(int row) { return row < NCTX ? 0 : 1 + ((row - NCTX) >> 12); }
DI float wave_sum(float v) {
#pragma unroll
  for (int o = 32; o > 0; o >>= 1) v += __shfl_xor(v, o);
  return v;
}
DI float mod_val(const Params& p, int layer, int cond, int which, int c) {
  return ((const float*)(p.ws + WS_MODP))[(layer * 3 + cond) * 3072 + which * 1024 + c];
}
DI void chunk_rows(int gc, int& row0, int& s0, int& s1) {
  if (gc < 64) { int seq = gc >> 1; s0 = seq * 256; s1 = s0 + 256; row0 = s0 + (gc & 1) * 128; }
  else { int g2 = gc - 64; int seq = g2 >> 5; s0 = NCTX + seq * 4096; s1 = s0 + 4096; row0 = s0 + (g2 & 31) * 128; }
}

DI void p0_mod_item(const Params& p, int item, unsigned char* smem) {
  const int tid = threadIdx.x;
  const int kc = item & 31, cgp = (item >> 5) % 12, layer = item / 384;
  float* sl = (float*)smem;
  __syncthreads();
  if (tid < 96) {
    int j = tid >> 5, k = kc * 32 + (tid & 31);
    const float* cv = j == 0 ? p.in[I_CCTX] : p.in[I_C] + (j - 1) * 1024;
    sl[tid] = silu_f(cv[k]);
  }
  __syncthreads();
  const int col = cgp * 256 + tid;
  const float* W = p.in[I_ADAW] + (size_t)layer * 1024 * 3072 + (size_t)(kc * 32) * 3072 + col;
  float wv[32];
#pragma unroll
  for (int kk = 0; kk < 32; ++kk) wv[kk] = W[(size_t)kk * 3072];
  float a0 = 0.f, a1 = 0.f, a2 = 0.f;
#pragma unroll
  for (int kk = 0; kk < 32; ++kk) { a0 += sl[kk] * wv[kk]; a1 += sl[32 + kk] * wv[kk]; a2 += sl[64 + kk] * wv[kk]; }
  if (kc == 0) { float bb = p.in[I_ADAB][layer * 3072 + col]; a0 += bb; a1 += bb; a2 += bb; }
  float* mp = (float*)(p.ws + WS_MODP) + (size_t)layer * 3 * 3072 + col;
  atomicAdd(mp, a0); atomicAdd(mp + 3072, a1); atomicAdd(mp + 6144, a2);
  if (layer == 0) {
    asm volatile("s_waitcnt vmcnt(0)" ::: "memory");
    __syncthreads();
    if (tid == 0) __hip_atomic_fetch_add((unsigned*)(p.ws + WS_GCNT), 1u, __ATOMIC_RELAXED, __HIP_MEMORY_SCOPE_AGENT);
  }
}
DI void p0_wt_tile(const float* src, int ldsrc, bf16_t* dst, int K, int k0, int n0, int nvalid, int mode, const float* rowscale, int rs_off, unsigned char* smem) {
  const int tid = threadIdx.x;
  float* tile = (float*)smem;
  const int c4 = (tid & 15) * 4, r0 = tid >> 4;
  const int n = n0 + c4;
  int sc;
  if (mode == 0) sc = n < nvalid ? n : -1;
  else sc = n < 384 ? n : (n < 1408 ? n + 32 : (n < 1440 ? n - 1024 : -1));
  __syncthreads();
  float4 vv[4];
#pragma unroll
  for (int i = 0; i < 4; ++i) { const int k = k0 + r0 + 16 * i; vv[i] = sc >= 0 ? *(const float4*)(src + (size_t)k * ldsrc + sc) : make_float4(0.f, 0.f, 0.f, 0.f); }
#pragma unroll
  for (int i = 0; i < 4; ++i) {
    const int k = k0 + r0 + 16 * i; float4 v = vv[i];
    if (rowscale && k >= rs_off) { const float f = rowscale[k - rs_off]; v.x *= f; v.y *= f; v.z *= f; v.w *= f; }
    float* tp = tile + (r0 + 16 * i) * 65 + c4;
    tp[0] = v.x; tp[1] = v.y; tp[2] = v.z; tp[3] = v.w;
  }
  __syncthreads();
  const int nn = tid >> 2, kk0 = (tid & 3) * 16;
  unsigned u[8];
#pragma unroll
  for (int e = 0; e < 8; ++e) u[e] = pack2(tile[(kk0 + 2 * e) * 65 + nn], tile[(kk0 + 2 * e + 1) * 65 + nn]);
  uint4* d = (uint4*)(dst + (size_t)(n0 + nn) * K + k0 + kk0);
  d[0] = make_uint4(u[0], u[1], u[2], u[3]); d[1] = make_uint4(u[4], u[5], u[6], u[7]);
}
constexpr int T_ABIN = 16 * 58, T_ABOUT = 24 * 16, T_MIN = 16 * 24, T_UQ = 4 * 24, T_UKV = 2 * 32, T_MOUT = 16 * 16;
constexpr int N_WT = T_ABIN + T_ABOUT + T_MIN + T_UQ + T_UKV + T_MOUT;
DI void wt_item(const Params& p, int t, unsigned char* smem) {
  if (t < T_ABIN) { int nt = t % 58, kt = t / 58; p0_wt_tile(p.in[I_ABWIN], 3616, (bf16_t*)(p.ws + W_ABIN), 1024, kt * 64, nt * 64, 3616, 0, nullptr, 0, smem); return; }
  t -= T_ABIN;
  if (t < T_ABOUT) { int nt = t % 16, kt = t / 16; p0_wt_tile(p.in[I_ABWOUT], 1024, (bf16_t*)(p.ws + W_ABOUT), 1536, kt * 64, nt * 64, 1024, 0, p.in[I_GNW], 512, smem); return; }
  t -= T_ABOUT;
  if (t < T_MIN) { int nt = t % 24, kt = t / 24; p0_wt_tile(p.in[I_MWIN], 1440, (bf16_t*)(p.ws + W_MIN), 1024, kt * 64, nt * 64, 1440, 1, nullptr, 0, smem); return; }
  t -= T_MIN;
  if (t < T_UQ) { int nt = t % 24, kt = t / 24; p0_wt_tile(p.in[I_WUQ], 1536, (bf16_t*)(p.ws + W_UQ), 256, kt * 64, nt * 64, 1536, 0, p.in[I_QNW], 0, smem); return; }
  t -= T_UQ;
  if (t < T_UKV) { int nt = t % 32, kt = t / 32; p0_wt_tile(p.in[I_WUKV], 2048, (bf16_t*)(p.ws + W_UKV), 128, kt * 64, nt * 64, 2048, 0, nullptr, 0, smem); return; }
  t -= T_UKV;
  { int nt = t % 16, kt = t / 16; p0_wt_tile(p.in[I_MWOUT], 1024, (bf16_t*)(p.ws + W_MOUT), 1024, kt * 64, nt * 64, 1024, 0, nullptr, 0, smem); }
}
DI void phase0(const Params& p, unsigned char* smem) {
  constexpr int N_MOD = 384;
  constexpr int N_CACHE = 64;
  constexpr int N_ALL = N_MOD + N_CACHE;
  for (int item = blockIdx.x; item < N_ALL; item += gridDim.x) {
    if (item < N_MOD) { p0_mod_item(p, item, smem); continue; }
    int t = item - N_MOD;
    const int tid = threadIdx.x;
    if (t < 32) {
      int e0 = t * 2048 + tid * 8;
      const float4* s = (const float4*)(p.in[I_CAK] + e0);
      float4 a = s[0], b = s[1];
      *(uint4*)((bf16_t*)(p.ws + WS_KA) + (size_t)NTOK * 128 + e0) = make_uint4(pack2(a.x, a.y), pack2(a.z, a.w), pack2(b.x, b.y), pack2(b.z, b.w));
    } else {
      int e0 = (t - 32) * 2048 + tid * 8;
      bf16_t* vt = (bf16_t*)(p.ws + WS_VTA);
#pragma unroll
      for (int e = 0; e < 8; ++e) {
        int idx = e0 + e;
        int d = idx & 63, kvh = (idx >> 6) & 1, rj = idx >> 7;
        int row = NTOK + rj;
        vt[((size_t)(row >> 6) * 2 + kvh) * 4096 + d * 64 + (row & 63)] = f2bf(p.in[I_CAV][idx]);
      }
    }
  }
}

DI void phase_modnorm(const Params& p, int layer, unsigned char* smem) {
  const int tid = threadIdx.x, lane = tid & 63, w = tid >> 6;
  float* em = (float*)smem;
  float* ea = em + 3072;
  if (layer == 0 && tid == 0) {
    unsigned spins = 0;
    while (__hip_atomic_load((unsigned*)(p.ws + WS_GCNT), __ATOMIC_RELAXED, __HIP_MEMORY_SCOPE_AGENT) < 384u && ++spins < (1u << 22)) __builtin_amdgcn_s_sleep(2);
  }
  __syncthreads();
  for (int i = tid; i < 3072; i += 256) {
    int cond = i >> 10, c = i & 1023;
    float* mpa = (float*)(p.ws + WS_MODP) + (layer * 3 + cond) * 3072;
    float sh = __hip_atomic_load(mpa + c, __ATOMIC_RELAXED, __HIP_MEMORY_SCOPE_AGENT), sc = __hip_atomic_load(mpa + 1024 + c, __ATOMIC_RELAXED, __HIP_MEMORY_SCOPE_AGENT);
    em[i] = p.in[I_NORMW][layer * 1024 + c] * (1.f + sc); ea[i] = sh;
  }
  __syncthreads();
  bf16_t* H = (bf16_t*)(p.ws + WS_H);
  for (int item = blockIdx.x; item < NTOK / 4; item += gridDim.x) {
    int row = item * 4 + w;
    float4 v[4]; float ss = 0.f;
    if (layer == 0) {
      const float* xr = row < NCTX ? p.in[I_XP] + (size_t)row * 1024 : p.in[I_XS] + (size_t)(row - NCTX) * 1024;
#pragma unroll
      for (int i = 0; i < 4; ++i) v[i] = ((const float4*)xr)[lane + 64 * i];
    } else {
      const uint2* xr = (const uint2*)((const bf16_t*)(p.ws + WS_X1B) + (size_t)row * 1024);
#pragma unroll
      for (int i = 0; i < 4; ++i) { uint2 u = xr[lane + 64 * i]; v[i] = make_float4(bflo(u.x), bfhi(u.x), bflo(u.y), bfhi(u.y)); }
    }
#pragma unroll
    for (int i = 0; i < 4; ++i) ss += v[i].x * v[i].x + v[i].y * v[i].y + v[i].z * v[i].z + v[i].w * v[i].w;
    ss = wave_sum(ss);
    float rstd = rsqrtf(ss * (1.f / 1024.f) + EPS);
    int cond = cond_of(row);
#pragma unroll
    for (int i = 0; i < 4; ++i) {
      int col = (lane + 64 * i) * 4;
      float4 m = *(const float4*)(em + cond * 1024 + col), a = *(const float4*)(ea + cond * 1024 + col);
      uint2 o = make_uint2(pack2(v[i].x * rstd * m.x + a.x, v[i].y * rstd * m.y + a.y), pack2(v[i].z * rstd * m.z + a.z, v[i].w * rstd * m.w + a.w));
      *(uint2*)(H + (size_t)row * 1024 + col) = o;
    }
  }
}

template <bool NARROW = false>
DI void gemm_mainloop(f32x4 (&acc)[4][4], const bf16_t* __restrict__ A, int lda, const bf16_t* __restrict__ B, int ldb, int K, int m0, int n0, unsigned char* smem) {
  const int tid = threadIdx.x, lane = tid & 63, w = tid >> 6, wm = w >> 1, wn = w & 1, lc = lane & 15, g = lane >> 4;
  const int rr = w * 8 + (lane >> 3);
  const int q = (lane & 7) ^ (((w & 1) * 4 + (lane >> 4)) & 7);
  const bf16_t* ga = A + (size_t)(m0 + rr) * lda + q * 8;
  const bf16_t* gb = B + (size_t)(n0 + rr) * ldb + q * 8;
  const int sw = (lc >> 1) & 7;
  const int nk = K >> 6;
#define GSTAGE(s, kt) do { _Pragma("unroll") for (int i = 0; i < 4; ++i) { \
    __builtin_amdgcn_global_load_lds((const unsigned*)(ga + (size_t)(i * 32) * lda + (kt) * 64), (unsigned*)(smem + (s) * 32768 + w * 1024 + i * 4096), 16, 0, 0); \
    if (!NARROW || i == 0) __builtin_amdgcn_global_load_lds((const unsigned*)(gb + (size_t)(i * 32) * ldb + (kt) * 64), (unsigned*)(smem + (s) * 32768 + 16384 + w * 1024 + i * 4096), 16, 0, 0); } } while (0)
  __syncthreads();
  GSTAGE(0, 0);
  asm volatile("s_waitcnt vmcnt(0)" ::: "memory");
  __syncthreads();
  for (int kt = 0; kt < nk; ++kt) {
    const int cur = kt & 1;
    if (kt + 1 < nk) GSTAGE(cur ^ 1, kt + 1);
    const unsigned char* sa = smem + cur * 32768 + (wm * 64 + lc) * 128;
    const unsigned char* sb = smem + cur * 32768 + 16384 + (wn * 64 + lc) * 128;
#pragma unroll
    for (int ks = 0; ks < 2; ++ks) {
      const int co = ((ks * 4 + g) ^ sw) * 16;
      bf16x8 af[4], bfr[4];
      if (NARROW) {
        if (wn == 0) {
#pragma unroll
          for (int i = 0; i < 4; ++i) af[i] = *(const bf16x8*)(sa + i * 2048 + co);
#pragma unroll
          for (int j = 0; j < 2; ++j) bfr[j] = *(const bf16x8*)(sb + j * 2048 + co);
#pragma unroll
          for (int i = 0; i < 4; ++i)
#pragma unroll
            for (int j = 0; j < 2; ++j) acc[i][j] = MFMA16(af[i], bfr[j], acc[i][j]);
        }
      } else {
#pragma unroll
        for (int i = 0; i < 4; ++i) af[i] = *(const bf16x8*)(sa + i * 2048 + co);
#pragma unroll
        for (int j = 0; j < 4; ++j) bfr[j] = *(const bf16x8*)(sb + j * 2048 + co);
#pragma unroll
        for (int i = 0; i < 4; ++i)
#pragma unroll
          for (int j = 0; j < 4; ++j) acc[i][j] = MFMA16(af[i], bfr[j], acc[i][j]);
      }
    }
    asm volatile("s_waitcnt vmcnt(0)" ::: "memory");
    __syncthreads();
  }
#undef GSTAGE
}
DI void acc_zero(f32x4 (&acc)[4][4]) {
#pragma unroll
  for (int i = 0; i < 4; ++i)
#pragma unroll
    for (int j = 0; j < 4; ++j) acc[i][j] = f32x4{0.f, 0.f, 0.f, 0.f};
}
DI void rope64(f32x4 (&acc)[4][4], int rowbase  , int lc, int g) {
  const float inv = ex2(-(float)lc * (13.287712379549449f / 16.f));
#pragma unroll
  for (int i = 0; i < 4; ++i)
#pragma unroll
    for (int r = 0; r < 4; ++r) {
      int l = (rowbase + i * 16 + 4 * g + r - NCTX) & 4095;
      float tr = (float)(l >> 6) * inv, tc = (float)(l & 63) * inv;
      float cr = __cosf(tr), sr = __sinf(tr), cc = __cosf(tc), sc = __sinf(tc);
      float a = acc[i][0][r], b = acc[i][1][r];
      acc[i][0][r] = a * cr - b * sr; acc[i][1][r] = b * cr + a * sr;
      a = acc[i][2][r]; b = acc[i][3][r];
      acc[i][2][r] = a * cc - b * sc; acc[i][3][r] = b * cc + a * sc;
    }
}

DI float* stage_wave_tile(const f32x4 (&acc)[4][4], unsigned char* smem) {
  const int lane = threadIdx.x & 63, w = threadIdx.x >> 6, lc = lane & 15, g = lane >> 4;
  float* wb = (float*)smem + w * (64 * 68);
#pragma unroll
  for (int i = 0; i < 4; ++i)
#pragma unroll
    for (int j = 0; j < 4; ++j)
#pragma unroll
      for (int r = 0; r < 4; ++r) wb[(i * 16 + 4 * g + r) * 68 + j * 16 + lc] = acc[i][j][r];
  __builtin_amdgcn_wave_barrier();
  return wb;
}
DI uint2 pk4(float4 v) { return make_uint2(pack2(v.x, v.y), pack2(v.z, v.w)); }
DI float4 silu4(float4 v) { return make_float4(silu_f(v.x), silu_f(v.y), silu_f(v.z), silu_f(v.w)); }
DI void xcd_tile(int v, int NT, int& mt, int& nt) { const int x = v & 7, j = v >> 3; mt = (j / NT) * 8 + x; nt = j % NT; }

DI void phase_ab_in(const Params& p, unsigned char* smem) {
  const int tid = threadIdx.x, lane = tid & 63, w = tid >> 6, wm = w >> 1, wn = w & 1, lc = lane & 15, g = lane >> 4;
  const bf16_t* H = (const bf16_t*)(p.ws + WS_H);
  const bf16_t* W = (const bf16_t*)(p.ws + W_ABIN);
  bf16_t* QA = (bf16_t*)(p.ws + WS_QA); bf16_t* KA = (bf16_t*)(p.ws + WS_KA); bf16_t* VTA = (bf16_t*)(p.ws + WS_VTA);
  bf16_t* GA = (bf16_t*)(p.ws + WS_GA); bf16_t* ZS = (bf16_t*)(p.ws + WS_ZS); bf16_t* XB = (bf16_t*)(p.ws + WS_XBCR);
  float* DTP = (float*)(p.ws + WS_DTP);
  constexpr int NT = ABIN_N / 128;
  for (int tile = blockIdx.x; tile < 128 * NT; tile += gridDim.x) {
    int mt, nt; if (tile < 128 * (NT - 1)) xcd_tile(tile, NT - 1, mt, nt); else { mt = tile - 128 * (NT - 1); nt = NT - 1; }
    const int m0 = mt * 128, n0 = nt * 128;
    f32x4 acc[4][4]; acc_zero(acc);
    if (n0 >= 3584) gemm_mainloop<true>(acc, H, 1024, W, 1024, 1024, m0, n0, smem); else gemm_mainloop<false>(acc, H, 1024, W, 1024, 1024, m0, n0, smem);
    const int rb = m0 + wm * 64, cb = n0 + wn * 64;
    const bool lat = m0 >= NCTX;
    if (n0 < 640 && lat) rope64(acc, rb, lc, g);
    if (n0 >= 640 && n0 < 768) {
#pragma unroll
      for (int i = 0; i < 4; ++i)
#pragma unroll
        for (int j = 0; j < 4; ++j) {
          int row = rb + i * 16 + 4 * g, d = j * 16 + lc;
          *(uint2*)(VTA + ((size_t)(row >> 6) * 2 + wn) * 4096 + d * 64 + (row & 63)) = make_uint2(pack2(acc[i][j][0], acc[i][j][1]), pack2(acc[i][j][2], acc[i][j][3]));
        }
    }
    if (n0 < 3584) {
      const float* wb = stage_wave_tile(acc, smem);
      const int c4 = (lane & 15) * 4, col = cb + c4;
#pragma unroll 4
      for (int it = 0; it < 16; ++it) {
        const int rl = it * 4 + (lane >> 4); const size_t row = (size_t)(rb + rl);
        float4 v = *(const float4*)(wb + rl * 68 + c4);
        if (n0 < 512) { const float qs = 0.125f * LOG2E; *(uint2*)(QA + row * 512 + col) = pk4(make_float4(v.x * qs, v.y * qs, v.z * qs, v.w * qs)); }
        else if (n0 < 640) { *(uint2*)(KA + row * 128 + col - 512) = pk4(v); if (!lat) *(float4*)(p.out + O_CAK + row * 128 + col - 512) = v; }
        else if (n0 < 768) { if (!lat) *(float4*)(p.out + O_CAV + row * 128 + col - 640) = v; }
        else if (n0 < 1280) *(uint2*)(GA + row * 512 + col - 768) = pk4(silu4(v));
        else if (n0 < 2304) *(uint2*)(ZS + row * 1024 + col - 1280) = pk4(silu4(v));
        else *(uint2*)(XB + row * 1280 + col - 2304) = pk4(v);
      }
    } else if (wn == 0) {
#pragma unroll
      for (int i = 0; i < 4; ++i)
#pragma unroll
        for (int j = 0; j < 2; ++j)
#pragma unroll
          for (int r = 0; r < 4; ++r) {
            int row = rb + i * 16 + 4 * g + r, col = j * 16 + lc;
            DTP[(size_t)row * 32 + col] = softplus_f(acc[i][j][r] + p.in[I_DTB][col]);
          }
    }
  }
}

DI void phase_conv(const Params& p, unsigned char* smem) {
  const int tid = threadIdx.x;
  bf16_t* raw = (bf16_t*)smem;
  bf16_t* outl = raw + 132 * 64;
  const bf16_t* XB = (const bf16_t*)(p.ws + WS_XBCR);
  bf16_t* XT = (bf16_t*)(p.ws + WS_XT); bf16_t* BT = (bf16_t*)(p.ws + WS_BT); bf16_t* BCM = (bf16_t*)(p.ws + WS_BCM);
  for (int item = blockIdx.x; item < 128 * 20; item += gridDim.x) {
    const int gc = item / 20, cgp = item % 20;
    int row0, s0, s1; chunk_rows(gc, row0, s0, s1);
    __syncthreads();
    for (int c = tid; c < 132 * 8; c += 256) {
      int t = c >> 3, c8 = c & 7, row = row0 - 2 + t;
      uint4 v = make_uint4(0, 0, 0, 0);
      if (row >= s0 && row < s1) v = *(const uint4*)(XB + (size_t)row * 1280 + cgp * 64 + c8 * 8);
      *(uint4*)(raw + t * 64 + c8 * 8) = v;
    }
    __syncthreads();
    {
      const int c = tid & 63, tg = tid >> 6, ch = cgp * 64 + c;
      float wv[5];
#pragma unroll
      for (int j = 0; j < 5; ++j) wv[j] = p.in[I_CONVW][j * 1280 + ch];
      const float bias = p.in[I_CONVB][ch];
      float x0 = bf2f(raw[(tg * 32 + 0) * 64 + c]), x1 = bf2f(raw[(tg * 32 + 1) * 64 + c]), x2 = bf2f(raw[(tg * 32 + 2) * 64 + c]), x3 = bf2f(raw[(tg * 32 + 3) * 64 + c]);
#pragma unroll 8
      for (int t = 0; t < 32; ++t) {
        int tt = tg * 32 + t;
        float x4 = bf2f(raw[(tt + 4) * 64 + c]);
        float o = bias + wv[0] * x0 + wv[1] * x1 + wv[2] * x2 + wv[3] * x3 + wv[4] * x4;
        outl[tt * 66 + c] = f2bf(silu_f(o));
        x0 = x1; x1 = x2; x2 = x3; x3 = x4;
      }
    }
    __syncthreads();
    if (cgp >= 16) {
      for (int c = tid; c < 1024; c += 256) {
        int tt = c >> 3, c8 = c & 7;
        const unsigned* s = (const unsigned*)(outl + tt * 66 + c8 * 8);
        *(uint4*)(BCM + (size_t)(row0 + tt) * 256 + (cgp - 16) * 64 + c8 * 8) = make_uint4(s[0], s[1], s[2], s[3]);
      }
    }
    if (cgp < 18) {
      for (int c = tid; c < 1024; c += 256) {
        int ch = c >> 4, t8 = c & 15;
        unsigned u[4];
#pragma unroll
        for (int e = 0; e < 4; ++e) u[e] = (unsigned)outl[(t8 * 8 + 2 * e) * 66 + ch] | ((unsigned)outl[(t8 * 8 + 2 * e + 1) * 66 + ch] << 16);
        bf16_t* dst = cgp < 16 ? XT + ((size_t)gc * 1024 + cgp * 64 + ch) * 128 + t8 * 8 : BT + ((size_t)gc * 128 + (cgp - 16) * 64 + ch) * 128 + t8 * 8;
        *(uint4*)dst = make_uint4(u[0], u[1], u[2], u[3]);
      }
    }
  }
}

DI float chunk_cums(const Params& p, int row0, int head, int dir, int lane, float* dtv, float* cumv, float* facv) {
  const float* DTP = (const float*)(p.ws + WS_DTP);
  const float a = -__expf(p.in[I_ALOG][dir * 16 + head]);
  float d0 = DTP[(size_t)(row0 + 2 * lane) * 32 + dir * 16 + head], d1 = DTP[(size_t)(row0 + 2 * lane + 1) * 32 + dir * 16 + head];
  float v0 = d0 * a, v1 = d1 * a, s = v0 + v1, sc = s;
#pragma unroll
  for (int o = 1; o < 64; o <<= 1) { float t = __shfl_up(sc, o); if (lane >= o) sc += t; }
  float total = __shfl(sc, 63);
  float e = sc - s, c0 = e + v0, c1 = e + s;
  if (facv) {
    dtv[dir * 128 + 2 * lane] = d0; dtv[dir * 128 + 2 * lane + 1] = d1;
    if (dir == 0) {
      cumv[2 * lane] = c0; cumv[2 * lane + 1] = c1;
      facv[2 * lane] = d0 * __expf(total - c0); facv[2 * lane + 1] = d1 * __expf(total - c1);
    } else {
      cumv[128 + 2 * lane] = total - c0 + v0; cumv[128 + 2 * lane + 1] = total - c1 + v1;
      facv[128 + 2 * lane] = d0 * __expf(c0 - v0); facv[128 + 2 * lane + 1] = d1 * __expf(c1 - v1);
    }
  } else {
    const float q0 = dir == 0 ? c0 : total - c0 + v0, q1 = dir == 0 ? c1 : total - c1 + v1;
    cumv[dir * 128 + 2 * lane] = q0 * LOG2E; cumv[dir * 128 + 2 * lane + 1] = q1 * LOG2E;
    dtv[dir * 128 + 2 * lane] = q0 * LOG2E - __log2f(d0); dtv[dir * 128 + 2 * lane + 1] = q1 * LOG2E - __log2f(d1);
  }
  return total;
}

DI void phase_ssd_states(const Params& p, unsigned char* smem) {
  const int tid = threadIdx.x, lane = tid & 63, w = tid >> 6, lc = lane & 15, g = lane >> 4;
  bf16_t* xf = (bf16_t*)smem;
  bf16_t* xb = xf + 64 * 136;
  bf16_t* bt = xb + 64 * 136;
  float* dtv = (float*)(bt + 64 * 136);
  float* cumv = dtv + 256;
  float* facv = cumv + 256;
  const bf16_t* XT = (const bf16_t*)(p.ws + WS_XT); const bf16_t* BT = (const bf16_t*)(p.ws + WS_BT);
  float* ST = (float*)(p.ws + WS_STATES); float* CD = (float*)(p.ws + WS_CDEC);
  for (int item = blockIdx.x; item < 2048; item += gridDim.x) {
    const int gc = item >> 4, head = item & 15, grp = head >> 3;
    int row0, s0, s1; chunk_rows(gc, row0, s0, s1);
    __syncthreads();
    if (w < 2) {
      float total = chunk_cums(p, row0, head, w, lane, dtv, cumv, facv);
      if (lane == 0) CD[(gc * 2 + w) * 16 + head] = __expf(total);
    }
    __syncthreads();
#pragma unroll
    for (int i = 0; i < 4; ++i) {
      int id = tid + 256 * i, r = id >> 4, c16 = id & 15;
      uint4 xv = *(const uint4*)(XT + ((size_t)gc * 1024 + head * 64 + r) * 128 + c16 * 8);
      uint4 bv = *(const uint4*)(BT + ((size_t)gc * 128 + grp * 64 + r) * 128 + c16 * 8);
      *(uint4*)(bt + r * 136 + c16 * 8) = bv;
      const float* ff = facv + c16 * 8; const float* fb = facv + 128 + c16 * 8;
      unsigned xs[4] = {xv.x, xv.y, xv.z, xv.w}, of[4], ob[4];
#pragma unroll
      for (int e = 0; e < 4; ++e) {
        float lo = bflo(xs[e]), hi = bfhi(xs[e]);
        of[e] = pack2(lo * ff[2 * e], hi * ff[2 * e + 1]); ob[e] = pack2(lo * fb[2 * e], hi * fb[2 * e + 1]);
      }
      *(uint4*)(xf + r * 136 + c16 * 8) = make_uint4(of[0], of[1], of[2], of[3]);
      *(uint4*)(xb + r * 136 + c16 * 8) = make_uint4(ob[0], ob[1], ob[2], ob[3]);
    }
    __syncthreads();
    f32x4 af[4], ab[4];
#pragma unroll
    for (int j = 0; j < 4; ++j) { af[j] = f32x4{0, 0, 0, 0}; ab[j] = f32x4{0, 0, 0, 0}; }
#pragma unroll
    for (int ks = 0; ks < 4; ++ks) {
      bf16x8 a_f = *(const bf16x8*)(xf + (w * 16 + lc) * 136 + ks * 32 + g * 8);
      bf16x8 a_b = *(const bf16x8*)(xb + (w * 16 + lc) * 136 + ks * 32 + g * 8);
#pragma unroll
      for (int j = 0; j < 4; ++j) {
        bf16x8 b = *(const bf16x8*)(bt + (j * 16 + lc) * 136 + ks * 32 + g * 8);
        af[j] = MFMA16(a_f, b, af[j]); ab[j] = MFMA16(a_b, b, ab[j]);
      }
    }
    bf16_t* o0 = (bf16_t*)ST + ((size_t)(gc * 2 + 0) * 16 + head) * 4096; bf16_t* o1 = (bf16_t*)ST + ((size_t)(gc * 2 + 1) * 16 + head) * 4096;
    const bool odd = lc & 1;
#pragma unroll
    for (int j = 0; j < 4; ++j) {
      const int n2 = j * 16 + (lc & ~1), pb = w * 16 + 4 * g + (odd ? 2 : 0);
      {
        const float y0 = __shfl_xor(odd ? af[j][0] : af[j][2], 1), y1 = __shfl_xor(odd ? af[j][1] : af[j][3], 1);
        const unsigned u0 = odd ? pack2(y0, af[j][2]) : pack2(af[j][0], y0), u1 = odd ? pack2(y1, af[j][3]) : pack2(af[j][1], y1);
        *(unsigned*)(o0 + (pb + 0) * 64 + n2) = u0; *(unsigned*)(o0 + (pb + 1) * 64 + n2) = u1;
      }
      {
        const float y0 = __shfl_xor(odd ? ab[j][0] : ab[j][2], 1), y1 = __shfl_xor(odd ? ab[j][1] : ab[j][3], 1);
        const unsigned u0 = odd ? pack2(y0, ab[j][2]) : pack2(ab[j][0], y0), u1 = odd ? pack2(y1, ab[j][3]) : pack2(ab[j][1], y1);
        *(unsigned*)(o1 + (pb + 0) * 64 + n2) = u0; *(unsigned*)(o1 + (pb + 1) * 64 + n2) = u1;
      }
    }
  }
}

struct AttnArgs {
  const bf16_t* q; int ldq;
  const bf16_t* k; int ldk;
  const bf16_t* kpe;
  const bf16_t* vt; int vt_heads, vhead;
  const bf16_t* gate; int ldg;
  bf16_t* out; int ldo;
  int qrow0, qpos0;
  int seg0_row, seg0_n, seg0_pos, band;
  int seg1_row, seg1_n;
  float sink2; int has_sink; float scale2;
};
using f32x16 = __attribute__((ext_vector_type(16))) float;
#define MFMA32(a, b, c) __builtin_amdgcn_mfma_f32_32x32x16_bf16((a), (b), (c), 0, 0, 0)
template <int DK, bool MLA>
DI void attn_item(const AttnArgs& a, unsigned char* smem, bool dost = true) {
  constexpr int KS = DK / 16, KSTR = DK + 8, KCH = DK / 8, VSTR = 68;
  const int tid = threadIdx.x, lane = tid & 63, w = tid >> 6, r32 = lane & 31, h = lane >> 5;
  bf16_t* sK = (bf16_t*)smem;
  bf16_t* sV = sK + 64 * KSTR;
  bf16x8 qf[KS];
#pragma unroll
  for (int ks = 0; ks < KS; ++ks) qf[ks] = *(const bf16x8*)(a.q + (size_t)(a.qrow0 + w * 32 + r32) * a.ldq + ks * 16 + h * 8);
  f32x16 O[2], L;
#pragma unroll
  for (int i = 0; i < 16; ++i) { O[0][i] = 0.f; O[1][i] = 0.f; L[i] = a.has_sink ? 1.f : 0.f; }
  float mrow = a.has_sink ? a.sink2 : -1e30f;
  const bf16x8 ones = mk8(0x3F803F80u, 0x3F803F80u, 0x3F803F80u, 0x3F803F80u);
  const int ntiles = (a.seg0_n + a.seg1_n) >> 6;
  const int qpos = a.qpos0 + w * 32 + r32;
  uint4 pk0, pk1, pk2, pv0, pv1;
#define KR(i) ((tid + 256 * (i)) / KCH)
#define KQ(i) ((tid + 256 * (i)) % KCH)
#define KSRC(i, krow) ((!MLA || KQ(i) < 8) ? a.k + (size_t)((krow) + KR(i)) * a.ldk + KQ(i) * 8 : a.kpe + (size_t)((krow) + KR(i)) * 32 + (KQ(i) - 8) * 8)
  const int vr = tid >> 3, vq = tid & 7;
#define ATT_LOAD(t_) do { const int kk0_ = (t_) * 64; const int krow_ = kk0_ < a.seg0_n ? a.seg0_row + kk0_ : a.seg1_row + kk0_ - a.seg0_n; \
    pk0 = *(const uint4*)KSRC(0, krow_); pk1 = *(const uint4*)KSRC(1, krow_); if (MLA) pk2 = *(const uint4*)KSRC(2, krow_); \
    const bf16_t* vsrc_ = a.vt + ((size_t)(krow_ >> 6) * a.vt_heads + a.vhead) * 4096; \
    pv0 = *(const uint4*)(vsrc_ + vr * 64 + vq * 8); pv1 = *(const uint4*)(vsrc_ + (vr + 32) * 64 + vq * 8); } while (0)
  ATT_LOAD(0);
  for (int t = 0; t < ntiles; ++t) {
    const int kk0 = t * 64; const bool loc = kk0 < a.seg0_n;
    __syncthreads();
    *(uint4*)(sK + KR(0) * KSTR + KQ(0) * 8) = pk0; *(uint4*)(sK + KR(1) * KSTR + KQ(1) * 8) = pk1; if (MLA) *(uint4*)(sK + KR(2) * KSTR + KQ(2) * 8) = pk2;
    *(uint2*)(sV + vr * VSTR + vq * 8) = make_uint2(pv0.x, pv0.y); *(uint2*)(sV + vr * VSTR + vq * 8 + 4) = make_uint2(pv0.z, pv0.w);
    *(uint2*)(sV + (vr + 32) * VSTR + vq * 8) = make_uint2(pv1.x, pv1.y); *(uint2*)(sV + (vr + 32) * VSTR + vq * 8 + 4) = make_uint2(pv1.z, pv1.w);
    __syncthreads();
    if (t + 1 < ntiles) ATT_LOAD(t + 1);
    f32x16 S[2];
#pragma unroll
    for (int i = 0; i < 16; ++i) { S[0][i] = 0.f; S[1][i] = 0.f; }
#pragma unroll
    for (int ks = 0; ks < KS; ++ks)
#pragma unroll
      for (int kt = 0; kt < 2; ++kt) {
        bf16x8 kf = *(const bf16x8*)(sK + (kt * 32 + r32) * KSTR + ks * 16 + h * 8);
        S[kt] = MFMA32(kf, qf[ks], S[kt]);
      }
    const bool msk = a.band && loc;
    float m = -1e30f;
#pragma unroll
    for (int kt = 0; kt < 2; ++kt)
#pragma unroll
      for (int ri = 0; ri < 16; ++ri) {
        float v = S[kt][ri];
        if (msk) { int dlt = a.seg0_pos + kk0 + kt * 32 + (ri & 3) + 8 * (ri >> 2) + 4 * h - qpos; if (dlt > 128 || dlt < -128) v = -1e30f; S[kt][ri] = v; }
        m = fmaxf(m, v);
      }
    m = fmaxf(m, __shfl_xor(m, 32));
    if (__builtin_amdgcn_ballot_w64(m > mrow + 8.f) != 0ull) {
      const float mnew = fmaxf(mrow, m), alpha = ex2(mrow - mnew);
      mrow = mnew;
#pragma unroll
      for (int i = 0; i < 16; ++i) { O[0][i] *= alpha; O[1][i] *= alpha; L[i] *= alpha; }
    }
#pragma unroll
    for (int kt = 0; kt < 2; ++kt)
#pragma unroll
      for (int s2 = 0; s2 < 2; ++s2) {
        const bf16x8 pf = mk8(pack2(ex2(S[kt][8 * s2 + 0] - mrow), ex2(S[kt][8 * s2 + 1] - mrow)), pack2(ex2(S[kt][8 * s2 + 2] - mrow), ex2(S[kt][8 * s2 + 3] - mrow)),
                              pack2(ex2(S[kt][8 * s2 + 4] - mrow), ex2(S[kt][8 * s2 + 5] - mrow)), pack2(ex2(S[kt][8 * s2 + 6] - mrow), ex2(S[kt][8 * s2 + 7] - mrow)));
        L = MFMA32(ones, pf, L);
#pragma unroll
        for (int dt = 0; dt < 2; ++dt) {
          const bf16_t* vp = sV + (dt * 32 + r32) * VSTR + kt * 32 + 16 * s2 + 4 * h;
          const uint2 lo = *(const uint2*)vp, hi = *(const uint2*)(vp + 8);
          O[dt] = MFMA32(mk8(lo.x, lo.y, hi.x, hi.y), pf, O[dt]);
        }
      }
  }
#undef KR
#undef KQ
#undef KSRC
#undef ATT_LOAD
  {
    const float inv = 1.f / L[0];
    const size_t row = (size_t)(a.qrow0 + w * 32 + r32);
#pragma unroll
    for (int dt = 0; dt < 2; ++dt)
#pragma unroll
      for (int gq = 0; gq < 4; ++gq) {
        const int d0 = dt * 32 + 8 * gq + 4 * h;
        const uint2 gt = *(const uint2*)(a.gate + row * a.ldg + d0);
        const float o0 = O[dt][4 * gq + 0] * inv * bflo(gt.x), o1 = O[dt][4 * gq + 1] * inv * bfhi(gt.x), o2 = O[dt][4 * gq + 2] * inv * bflo(gt.y), o3 = O[dt][4 * gq + 3] * inv * bfhi(gt.y);
        if (dost) *(uint2*)(a.out + row * a.ldo + d0) = make_uint2(pack2(o0, o1), pack2(o2, o3));
      }
  }
}

template <int DK, bool MLA>
DI void attn_item2(const AttnArgs& a, unsigned char* smem) {
  constexpr int KS = DK / 16, KSTR = DK + 8, KCH = DK / 8, VSTR = 68;
  const int tid = threadIdx.x, lane = tid & 63, w = tid >> 6, r32 = lane & 31, h = lane >> 5;
  bf16_t* sK = (bf16_t*)smem;
  bf16_t* sV = sK + 64 * KSTR;
  bf16_t* sQ = sV + 64 * VSTR;
  __syncthreads();
  for (int c = tid; c < 256 * KCH; c += 256) { const int r = c / KCH, cc = c % KCH; *(uint4*)(sQ + r * KSTR + cc * 8) = *(const uint4*)(a.q + (size_t)(a.qrow0 + r) * a.ldq + cc * 8); }
  const bf16_t* sQw = sQ + (w * 64 + r32) * KSTR + h * 8;
  f32x16 O[2][2];
#pragma unroll
  for (int i = 0; i < 16; ++i) { O[0][0][i] = 0.f; O[0][1][i] = 0.f; O[1][0][i] = 0.f; O[1][1][i] = 0.f; }
  float mrow[2], lsum[2];
  mrow[0] = mrow[1] = a.has_sink ? a.sink2 : -1e30f;
  lsum[0] = lsum[1] = (a.has_sink && h == 0) ? 1.f : 0.f;
  const int ntiles = (a.seg0_n + a.seg1_n) >> 6;
  uint4 pk0, pk1, pk2, pv0, pv1;
#define KR(i) ((tid + 256 * (i)) / KCH)
#define KQ(i) ((tid + 256 * (i)) % KCH)
#define KSRC(i, krow) ((!MLA || KQ(i) < 8) ? a.k + (size_t)((krow) + KR(i)) * a.ldk + KQ(i) * 8 : a.kpe + (size_t)((krow) + KR(i)) * 32 + (KQ(i) - 8) * 8)
  const int vr = tid >> 3, vq = tid & 7;
#define ATT_LOAD(t_) do { const int kk0_ = (t_) * 64; const int krow_ = kk0_ < a.seg0_n ? a.seg0_row + kk0_ : a.seg1_row + kk0_ - a.seg0_n; \
    pk0 = *(const uint4*)KSRC(0, krow_); pk1 = *(const uint4*)KSRC(1, krow_); if (MLA) pk2 = *(const uint4*)KSRC(2, krow_); \
    const bf16_t* vsrc_ = a.vt + ((size_t)(krow_ >> 6) * a.vt_heads + a.vhead) * 4096; \
    pv0 = *(const uint4*)(vsrc_ + vr * 64 + vq * 8); pv1 = *(const uint4*)(vsrc_ + (vr + 32) * 64 + vq * 8); } while (0)
  ATT_LOAD(0);
  for (int t = 0; t < ntiles; ++t) {
    __syncthreads();
    *(uint4*)(sK + KR(0) * KSTR + KQ(0) * 8) = pk0; *(uint4*)(sK + KR(1) * KSTR + KQ(1) * 8) = pk1; if (MLA) *(uint4*)(sK + KR(2) * KSTR + KQ(2) * 8) = pk2;
    *(uint2*)(sV + vr * VSTR + vq * 8) = make_uint2(pv0.x, pv0.y); *(uint2*)(sV + vr * VSTR + vq * 8 + 4) = make_uint2(pv0.z, pv0.w);
    *(uint2*)(sV + (vr + 32) * VSTR + vq * 8) = make_uint2(pv1.x, pv1.y); *(uint2*)(sV + (vr + 32) * VSTR + vq * 8 + 4) = make_uint2(pv1.z, pv1.w);
    __syncthreads();
    if (t + 1 < ntiles) ATT_LOAD(t + 1);
    f32x16 S[2][2];
#pragma unroll
    for (int i = 0; i < 16; ++i) { S[0][0][i] = 0.f; S[0][1][i] = 0.f; S[1][0][i] = 0.f; S[1][1][i] = 0.f; }
#pragma unroll
    for (int ks = 0; ks < KS; ++ks)
#pragma unroll
      for (int kt = 0; kt < 2; ++kt) {
        bf16x8 kf = *(const bf16x8*)(sK + (kt * 32 + r32) * KSTR + ks * 16 + h * 8);
        const bf16x8 q0 = *(const bf16x8*)(sQw + ks * 16), q1 = *(const bf16x8*)(sQw + 32 * KSTR + ks * 16);
        S[0][kt] = MFMA32(kf, q0, S[0][kt]); S[1][kt] = MFMA32(kf, q1, S[1][kt]);
      }
    float mx[2];
#pragma unroll
    for (int gq = 0; gq < 2; ++gq) {
      float m = -1e30f;
#pragma unroll
      for (int kt = 0; kt < 2; ++kt)
#pragma unroll
        for (int ri = 0; ri < 16; ++ri) m = fmaxf(m, S[gq][kt][ri]);
      mx[gq] = fmaxf(m, __shfl_xor(m, 32));
    }
    if (__builtin_amdgcn_ballot_w64((mx[0] > mrow[0] + 8.f) || (mx[1] > mrow[1] + 8.f)) != 0ull) {
#pragma unroll
      for (int gq = 0; gq < 2; ++gq) {
        const float mnew = fmaxf(mrow[gq], mx[gq]), alpha = ex2(mrow[gq] - mnew);
        mrow[gq] = mnew; lsum[gq] *= alpha;
#pragma unroll
        for (int i = 0; i < 16; ++i) { O[gq][0][i] *= alpha; O[gq][1][i] *= alpha; }
      }
    }
#pragma unroll
    for (int kt = 0; kt < 2; ++kt)
#pragma unroll
      for (int s2 = 0; s2 < 2; ++s2) {
        bf16x8 pf[2];
#pragma unroll
        for (int gq = 0; gq < 2; ++gq) {
          float e[8];
#pragma unroll
          for (int j = 0; j < 8; ++j) e[j] = ex2(S[gq][kt][8 * s2 + j] - mrow[gq]);
          lsum[gq] += ((e[0] + e[1]) + (e[2] + e[3])) + ((e[4] + e[5]) + (e[6] + e[7]));
          pf[gq] = mk8(pack2(e[0], e[1]), pack2(e[2], e[3]), pack2(e[4], e[5]), pack2(e[6], e[7]));
        }
#pragma unroll
        for (int dt = 0; dt < 2; ++dt) {
          const bf16_t* vp = sV + (dt * 32 + r32) * VSTR + kt * 32 + 16 * s2 + 4 * h;
          const uint2 lo = *(const uint2*)vp, hi = *(const uint2*)(vp + 8);
          const bf16x8 vf = mk8(lo.x, lo.y, hi.x, hi.y);
          O[0][dt] = MFMA32(vf, pf[0], O[0][dt]); O[1][dt] = MFMA32(vf, pf[1], O[1][dt]);
        }
      }
  }
#undef KR
#undef KQ
#undef KSRC
#undef ATT_LOAD
#pragma unroll
  for (int gq = 0; gq < 2; ++gq) {
    const float l = lsum[gq] + __shfl_xor(lsum[gq], 32);
    const float inv = 1.f / l;
    const size_t row = (size_t)(a.qrow0 + w * 64 + gq * 32 + r32);
#pragma unroll
    for (int dt = 0; dt < 2; ++dt)
#pragma unroll
      for (int g4 = 0; g4 < 4; ++g4) {
        const int d0 = dt * 32 + 8 * g4 + 4 * h;
        const uint2 gt = *(const uint2*)(a.gate + row * a.ldg + d0);
        const float o0 = O[gq][dt][4 * g4 + 0] * inv * bflo(gt.x), o1 = O[gq][dt][4 * g4 + 1] * inv * bfhi(gt.x), o2 = O[gq][dt][4 * g4 + 2] * inv * bflo(gt.y), o3 = O[gq][dt][4 * g4 + 3] * inv * bfhi(gt.y);
        *(uint2*)(a.out + row * a.ldo + d0) = make_uint2(pack2(o0, o1), pack2(o2, o3));
      }
  }
}

DI void scan_item(const Params& p, int it, bool latent, bool dost = true) {
  const int tid = threadIdx.x;
  const int quarter = it & 3, head = (it >> 2) & 15, dir = (it >> 6) & 1, b = it >> 7;
  const int e = quarter * 1024 + tid * 4;
  const float* ST = (const float*)(p.ws + WS_STATES); const float* CD = (const float*)(p.ws + WS_CDEC);
  bf16_t* HIN = (bf16_t*)(p.ws + WS_HIN);
  float4 h = make_float4(0.f, 0.f, 0.f, 0.f);
  const int nc = latent ? 32 : 2, gc0 = latent ? 64 + b * 32 : b * 2;
  if (latent) h = *(const float4*)((dir == 0 ? p.in[I_SF] : p.in[I_SB]) + ((size_t)b * 16 + head) * 4096 + e);
  if (latent) {
    for (int s0 = 0; s0 < 32; s0 += 8) {
      float4 st[8]; float dec[8];
#pragma unroll
      for (int u = 0; u < 8; ++u) {
        const int c = dir == 0 ? s0 + u : 31 - s0 - u;
        const size_t base = ((size_t)((gc0 + c) * 2 + dir) * 16 + head);
        dec[u] = CD[base]; { const uint2 q2 = *(const uint2*)((const bf16_t*)ST + base * 4096 + e); st[u] = make_float4(bflo(q2.x), bfhi(q2.x), bflo(q2.y), bfhi(q2.y)); }
      }
#pragma unroll
      for (int u = 0; u < 8; ++u) {
        const int c = dir == 0 ? s0 + u : 31 - s0 - u;
        const size_t base = ((size_t)((gc0 + c) * 2 + dir) * 16 + head);
        if (dost) *(uint2*)(HIN + base * 4096 + e) = make_uint2(pack2(h.x, h.y), pack2(h.z, h.w));
        h.x = h.x * dec[u] + st[u].x; h.y = h.y * dec[u] + st[u].y; h.z = h.z * dec[u] + st[u].z; h.w = h.w * dec[u] + st[u].w;
      }
    }
  }
}
DI void scan_ctx_item(const Params& p, int it, bool dost = true) {
  const int tid = threadIdx.x;
  const int head = it & 15, dir = (it >> 4) & 1, b = it >> 5;
  const float* ST = (const float*)(p.ws + WS_STATES); const float* CD = (const float*)(p.ws + WS_CDEC);
  bf16_t* HIN = (bf16_t*)(p.ws + WS_HIN);
  const int c0 = dir == 0 ? 0 : 1, c1 = 1 - c0;
  const size_t b0 = ((size_t)((b * 2 + c0) * 2 + dir) * 16 + head), b1 = ((size_t)((b * 2 + c1) * 2 + dir) * 16 + head);
  const float dec1 = CD[b1];
  float4 s0[4], s1[4];
#pragma unroll
  for (int qq = 0; qq < 4; ++qq) { const int e = qq * 1024 + tid * 4; const uint2 q0 = *(const uint2*)((const bf16_t*)ST + b0 * 4096 + e), q1 = *(const uint2*)((const bf16_t*)ST + b1 * 4096 + e);
    s0[qq] = make_float4(bflo(q0.x), bfhi(q0.x), bflo(q0.y), bfhi(q0.y)); s1[qq] = make_float4(bflo(q1.x), bfhi(q1.x), bflo(q1.y), bfhi(q1.y)); }
#pragma unroll
  for (int qq = 0; qq < 4; ++qq) {
    const int e = qq * 1024 + tid * 4;
    if (dost) {
      *(uint2*)(HIN + b0 * 4096 + e) = make_uint2(0u, 0u);
      *(uint2*)(HIN + b1 * 4096 + e) = make_uint2(pack2(s0[qq].x, s0[qq].y), pack2(s0[qq].z, s0[qq].w));
    }
    *(float4*)(p.out + (dir == 0 ? O_SF : O_SB) + ((size_t)b * 16 + head) * 4096 + e) =
        make_float4(s0[qq].x * dec1 + s1[qq].x, s0[qq].y * dec1 + s1[qq].y, s0[qq].z * dec1 + s1[qq].z, s0[qq].w * dec1 + s1[qq].w);
  }
}
DI void attn_a_item(const Params& p, int it, bool latent, unsigned char* smem, bool dost = true) {
  AttnArgs a;
  const int qb = latent ? (it & 31) : (it & 1), head = latent ? ((it >> 5) & 7) : ((it >> 1) & 7), b = latent ? (it >> 8) : (it >> 4);
  const int kvh = head >> 2;
  const int seqrow = latent ? NCTX + b * 4096 : b * 256;
  a.q = (const bf16_t*)(p.ws + WS_QA) + head * 64; a.ldq = 512;
  a.k = (const bf16_t*)(p.ws + WS_KA) + kvh * 64; a.ldk = 128; a.kpe = nullptr;
  a.vt = (const bf16_t*)(p.ws + WS_VTA); a.vt_heads = 2; a.vhead = kvh;
  a.gate = (const bf16_t*)(p.ws + WS_GA) + head * 64; a.ldg = 512;
  a.out = (bf16_t*)(p.ws + WS_QA) + head * 64; a.ldo = 512;
  a.qrow0 = seqrow + qb * 128; a.qpos0 = qb * 128;
  if (latent) {
    int klo = qb * 128 - 128; if (klo < 0) klo = 0; int khi = qb * 128 + 256; if (khi > 4096) khi = 4096;
    a.seg0_row = seqrow + klo; a.seg0_n = khi - klo; a.seg0_pos = klo; a.band = 1;
    a.seg1_row = NTOK + b * 256; a.seg1_n = 256;
  } else {
    a.seg0_row = seqrow; a.seg0_n = 256; a.seg0_pos = 0; a.band = 0; a.seg1_row = 0; a.seg1_n = 0;
  }
  a.sink2 = p.in[I_SINK][head] * LOG2E; a.has_sink = 1; a.scale2 = 0.125f * LOG2E;
  attn_item<64, false>(a, smem, dost);
}
DI void phase_scan_attn_a(const Params& p, unsigned char* smem, bool dost = true) {
  for (int item = blockIdx.x; item < 2304; item += gridDim.x) {
    if (item < 512) attn_a_item(p, item, true, smem, dost);
    else if (item < 768) scan_item(p, item - 512, true, dost);
    else if (item < 1280) attn_a_item(p, item - 768, false, smem, dost);
    else scan_ctx_item(p, item - 1280, dost);
  }
}

DI void phase_ssd_out(const Params& p, unsigned char* smem, bool dost = true) {
  const int tid = threadIdx.x, lane = tid & 63, w = tid >> 6, lc = lane & 15, g = lane >> 4;
  bf16_t* sB = (bf16_t*)smem;
  bf16_t* sC = sB + 128 * 72;
  bf16_t* sX = sC + 128 * 72;
  bf16_t* sHf = sX + 64 * 136;
  bf16_t* sHb = sHf + 64 * 72;
  float* dtv = (float*)(sHb + 64 * 72);
  float* cumv = dtv + 256;
  const bf16_t* XT = (const bf16_t*)(p.ws + WS_XT); const bf16_t* BCM = (const bf16_t*)(p.ws + WS_BCM); const bf16_t* HIN = (const bf16_t*)(p.ws + WS_HIN);
  bf16_t* ZS = (bf16_t*)(p.ws + WS_ZS); float* SSQ = (float*)(p.ws + WS_SSQ);
  for (int item = blockIdx.x; item < 2048; item += gridDim.x) {
    const int gc = item >> 4, head = item & 15, grp = head >> 3;
    int row0, s0, s1; chunk_rows(gc, row0, s0, s1);
    __syncthreads();
    if (w < 2) chunk_cums(p, row0, head, w, lane, dtv, cumv, nullptr);
#pragma unroll
    for (int i = 0; i < 4; ++i) {
      int id = tid + 256 * i;
      { int r = id >> 3, c8 = id & 7;
        *(uint4*)(sB + r * 72 + c8 * 8) = *(const uint4*)(BCM + (size_t)(row0 + r) * 256 + grp * 64 + c8 * 8);
        *(uint4*)(sC + r * 72 + c8 * 8) = *(const uint4*)(BCM + (size_t)(row0 + r) * 256 + 128 + grp * 64 + c8 * 8); }
      { int r = id >> 4, c16 = id & 15; *(uint4*)(sX + r * 136 + c16 * 8) = *(const uint4*)(XT + ((size_t)gc * 1024 + head * 64 + r) * 128 + c16 * 8); }
    }
#pragma unroll
    for (int i = 0; i < 2; ++i) {
      int id = tid + 256 * i, r = id >> 3, c8 = id & 7;
      *(uint4*)(sHf + r * 72 + c8 * 8) = *(const uint4*)(HIN + ((size_t)(gc * 2 + 0) * 16 + head) * 4096 + r * 64 + c8 * 8);
      *(uint4*)(sHb + r * 72 + c8 * 8) = *(const uint4*)(HIN + ((size_t)(gc * 2 + 1) * 16 + head) * 4096 + r * 64 + c8 * 8);
    }
    __syncthreads();
    bf16x8 cf[2][2];
#pragma unroll
    for (int lt = 0; lt < 2; ++lt)
#pragma unroll
      for (int ks = 0; ks < 2; ++ks) cf[lt][ks] = *(const bf16x8*)(sC + (w * 32 + lt * 16 + lc) * 72 + ks * 32 + g * 8);
    float cfl[2], crl[2];
#pragma unroll
    for (int lt = 0; lt < 2; ++lt) { cfl[lt] = cumv[w * 32 + lt * 16 + lc]; crl[lt] = cumv[128 + w * 32 + lt * 16 + lc]; }
    f32x4 Y[4][2], T[4][2];
#pragma unroll
    for (int pt = 0; pt < 4; ++pt) { T[pt][0] = f32x4{0, 0, 0, 0}; T[pt][1] = f32x4{0, 0, 0, 0}; }
#pragma unroll
    for (int ks = 0; ks < 2; ++ks)
#pragma unroll
      for (int pt = 0; pt < 4; ++pt) {
        bf16x8 hf = *(const bf16x8*)(sHf + (pt * 16 + lc) * 72 + ks * 32 + g * 8);
        T[pt][0] = MFMA16(hf, cf[0][ks], T[pt][0]); T[pt][1] = MFMA16(hf, cf[1][ks], T[pt][1]);
      }
    {
      float e0 = ex2(cfl[0]), e1 = ex2(cfl[1]);
#pragma unroll
      for (int pt = 0; pt < 4; ++pt) { Y[pt][0] = T[pt][0] * e0; Y[pt][1] = T[pt][1] * e1; }
    }
#pragma unroll
    for (int pt = 0; pt < 4; ++pt) { T[pt][0] = f32x4{0, 0, 0, 0}; T[pt][1] = f32x4{0, 0, 0, 0}; }
#pragma unroll
    for (int ks = 0; ks < 2; ++ks)
#pragma unroll
      for (int pt = 0; pt < 4; ++pt) {
        bf16x8 hb = *(const bf16x8*)(sHb + (pt * 16 + lc) * 72 + ks * 32 + g * 8);
        T[pt][0] = MFMA16(hb, cf[0][ks], T[pt][0]); T[pt][1] = MFMA16(hb, cf[1][ks], T[pt][1]);
      }
    {
      float e0 = ex2(crl[0]), e1 = ex2(crl[1]);
#pragma unroll
      for (int pt = 0; pt < 4; ++pt) { Y[pt][0] += T[pt][0] * e0; Y[pt][1] += T[pt][1] * e1; }
    }
    const float dskip = p.in[I_DSKIP][head];
#pragma unroll
    for (int sb = 0; sb < 2; ++sb) {
      f32x4 S[4][2];
#pragma unroll
      for (int st = 0; st < 4; ++st) { S[st][0] = f32x4{0, 0, 0, 0}; S[st][1] = f32x4{0, 0, 0, 0}; }
#pragma unroll
      for (int ks = 0; ks < 2; ++ks)
#pragma unroll
        for (int st = 0; st < 4; ++st) {
          bf16x8 bf = *(const bf16x8*)(sB + (sb * 64 + st * 16 + lc) * 72 + ks * 32 + g * 8);
          S[st][0] = MFMA16(bf, cf[0][ks], S[st][0]); S[st][1] = MFMA16(bf, cf[1][ks], S[st][1]);
        }
#pragma unroll
      for (int st = 0; st < 4; ++st) {
        const int sbase = sb * 64 + st * 16 + 4 * g;
        const f32x4 rfs = *(const f32x4*)(dtv + sbase), rbs = *(const f32x4*)(dtv + 128 + sbase);
#pragma unroll
        for (int lt = 0; lt < 2; ++lt) {
          const int l = w * 32 + lt * 16 + lc;
#pragma unroll
          for (int r = 0; r < 4; ++r) {
            const int s = sbase + r;
            const float af = s <= l ? cfl[lt] - rfs[r] : -1e30f, ab = s >= l ? crl[lt] - rbs[r] : -1e30f;
            S[st][lt][r] = S[st][lt][r] * (ex2(af) + ex2(ab)) + (s == l ? dskip : 0.f);
          }
        }
      }
      bf16x8 pf[2][2];
#pragma unroll
      for (int lt = 0; lt < 2; ++lt)
#pragma unroll
        for (int k2 = 0; k2 < 2; ++k2)
          pf[lt][k2] = mk8(pack2(S[2 * k2][lt][0], S[2 * k2][lt][1]), pack2(S[2 * k2][lt][2], S[2 * k2][lt][3]),
                           pack2(S[2 * k2 + 1][lt][0], S[2 * k2 + 1][lt][1]), pack2(S[2 * k2 + 1][lt][2], S[2 * k2 + 1][lt][3]));
#pragma unroll
      for (int pt = 0; pt < 4; ++pt)
#pragma unroll
        for (int k2 = 0; k2 < 2; ++k2) {
          uint2 lo = *(const uint2*)(sX + (pt * 16 + lc) * 136 + sb * 64 + k2 * 32 + 4 * g);
          uint2 hi = *(const uint2*)(sX + (pt * 16 + lc) * 136 + sb * 64 + k2 * 32 + 16 + 4 * g);
          bf16x8 xf = mk8(lo.x, lo.y, hi.x, hi.y);
          Y[pt][0] = MFMA16(xf, pf[0][k2], Y[pt][0]); Y[pt][1] = MFMA16(xf, pf[1][k2], Y[pt][1]);
        }
    }
#pragma unroll
    for (int lt = 0; lt < 2; ++lt) {
      const size_t row = (size_t)(row0 + w * 32 + lt * 16 + lc);
      float ss = 0.f;
#pragma unroll
      for (int pt = 0; pt < 4; ++pt) {
        bf16_t* zp = ZS + row * 1024 + head * 64 + pt * 16 + 4 * g;
        uint2 z = *(const uint2*)zp;
        float o0 = Y[pt][lt][0] * bflo(z.x), o1 = Y[pt][lt][1] * bfhi(z.x), o2 = Y[pt][lt][2] * bflo(z.y), o3 = Y[pt][lt][3] * bfhi(z.y);
        ss += o0 * o0 + o1 * o1 + o2 * o2 + o3 * o3;
        if (dost) *(uint2*)zp = make_uint2(pack2(o0, o1), pack2(o2, o3));
      }
      ss += __shfl_xor(ss, 16); ss += __shfl_xor(ss, 32);
      if (g == 0 && dost) SSQ[row * 16 + head] = ss;
    }
  }
}

DI void resid_epilogue(const Params& p, f32x4 (&acc)[4][4], int layer, int m0, int n0, unsigned char* smem) {
  const int tid = threadIdx.x, lane = tid & 63, w = tid >> 6, wm = w >> 1, wn = w & 1;
  const int cond = cond_of(m0);
  const float* wb = stage_wave_tile(acc, smem);
  const int c4 = (lane & 15) * 4, colb = n0 + wn * 64 + c4;
  const float4 gt = *(const float4*)((const float*)(p.ws + WS_MODP) + (layer * 3 + cond) * 3072 + 2048 + colb);
  bf16_t* X1B = (bf16_t*)(p.ws + WS_X1B);
#pragma unroll 4
  for (int it = 0; it < 16; ++it) {
    const int rl = it * 4 + (lane >> 4), row = m0 + wm * 64 + rl;
    const float4 av = *(const float4*)(wb + rl * 68 + c4);
    if (layer == 0) {
      const float* xr = row < NCTX ? p.in[I_XP] + (size_t)row * 1024 : p.in[I_XS] + (size_t)(row - NCTX) * 1024;
      const float4 xv = *(const float4*)(xr + colb);
      *(uint2*)(X1B + (size_t)row * 1024 + colb) = pk4(make_float4(xv.x + gt.x * av.x, xv.y + gt.y * av.y, xv.z + gt.z * av.z, xv.w + gt.w * av.w));
    } else {
      const uint2 xb = *(const uint2*)(X1B + (size_t)row * 1024 + colb);
      const float4 v = make_float4(bflo(xb.x) + gt.x * av.x, bfhi(xb.x) + gt.y * av.y, bflo(xb.y) + gt.z * av.z, bfhi(xb.y) + gt.w * av.w);
      *(uint2*)((bf16_t*)(p.ws + WS_X2B) + (size_t)row * 1024 + colb) = pk4(v);
      float ss = v.x * v.x + v.y * v.y + v.z * v.z + v.w * v.w;
      ss += __shfl_xor(ss, 8); ss += __shfl_xor(ss, 4); ss += __shfl_xor(ss, 2); ss += __shfl_xor(ss, 1);
      if ((lane & 15) == 0) __hip_atomic_fetch_add((float*)(p.ws + WS_ROWSQ) + row, ss, __ATOMIC_RELAXED, __HIP_MEMORY_SCOPE_AGENT);
    }
  }
}
DI void phase_ab_out(const Params& p, unsigned char* smem) {
  const int tid = threadIdx.x, lane = tid & 63, w = tid >> 6, wm = w >> 1, g = lane >> 4;
  float* srs = (float*)(smem + 65536);
  const float* SSQ = (const float*)(p.ws + WS_SSQ);
  const bf16_t* W = (const bf16_t*)(p.ws + W_ABOUT);
  for (int tile = blockIdx.x; tile < 128 * 8; tile += gridDim.x) {
    int mt, nt; xcd_tile(tile, 8, mt, nt); const int m0 = mt * 128, n0 = nt * 128;
    __syncthreads();
    if (tid < 128) {
      const float4* s = (const float4*)(SSQ + (size_t)(m0 + tid) * 16);
      float4 a = s[0], b = s[1], c = s[2], d = s[3];
      float t = a.x + a.y + a.z + a.w + b.x + b.y + b.z + b.w + c.x + c.y + c.z + c.w + d.x + d.y + d.z + d.w;
      srs[tid] = rsqrtf(t * (1.f / 1024.f) + EPS);
    }
    f32x4 acc[4][4]; acc_zero(acc);
    gemm_mainloop(acc, (const bf16_t*)(p.ws + WS_ZS), 1024, W + 512, 1536, 1024, m0, n0, smem);
#pragma unroll
    for (int i = 0; i < 4; ++i)
#pragma unroll
      for (int r = 0; r < 4; ++r) {
        float rs = srs[wm * 64 + i * 16 + 4 * g + r];
#pragma unroll
        for (int j = 0; j < 4; ++j) acc[i][j][r] *= rs;
      }
    gemm_mainloop(acc, (const bf16_t*)(p.ws + WS_QA), 512, W, 1536, 512, m0, n0, smem);
    resid_epilogue(p, acc, 0, m0, n0, smem);
  }
}
DI void phase_mla_out(const Params& p, unsigned char* smem) {
  for (int tile = blockIdx.x; tile < 128 * 8; tile += gridDim.x) {
    int mt, nt; xcd_tile(tile, 8, mt, nt); const int m0 = mt * 128, n0 = nt * 128;
    f32x4 acc[4][4]; acc_zero(acc);
    gemm_mainloop(acc, (const bf16_t*)(p.ws + WS_AOM), 1024, (const bf16_t*)(p.ws + W_MOUT), 1024, 1024, m0, n0, smem);
    resid_epilogue(p, acc, 1, m0, n0, smem);
  }
}

DI void phase_mla_in(const Params& p, unsigned char* smem) {
  const int tid = threadIdx.x, lane = tid & 63, w = tid >> 6, wm = w >> 1, wn = w & 1, lc = lane & 15, g = lane >> 4;
  bf16_t* GM = (bf16_t*)(p.ws + WS_GM);
  constexpr int NT = MIN_N / 128;
  for (int tile = blockIdx.x; tile < 128 * NT; tile += gridDim.x) {
    int mt, nt; xcd_tile(tile, NT, mt, nt); const int m0 = mt * 128, n0 = nt * 128;
    f32x4 acc[4][4]; acc_zero(acc);
    gemm_mainloop(acc, (const bf16_t*)(p.ws + WS_H), 1024, (const bf16_t*)(p.ws + W_MIN), 1024, 1024, m0, n0, smem);
    const int rb = m0 + wm * 64, cb = n0 + wn * 64;
    const float* wb = stage_wave_tile(acc, smem);
    const int c4 = (lane & 15) * 4, col = cb + c4;
    if (n0 < 256) {
      bf16_t* CQB = (bf16_t*)(p.ws + WS_CQN); float* rsq = (float*)(p.ws + WS_ROWSQ_Q);
#pragma unroll 4
      for (int it = 0; it < 16; ++it) {
        const int rl = it * 4 + (lane >> 4); const size_t row = (size_t)(rb + rl);
        const float4 v = *(const float4*)(wb + rl * 68 + c4);
        *(uint2*)(CQB + row * 256 + col) = pk4(v);
        float ss = v.x * v.x + v.y * v.y + v.z * v.z + v.w * v.w;
        ss += __shfl_xor(ss, 8); ss += __shfl_xor(ss, 4); ss += __shfl_xor(ss, 2); ss += __shfl_xor(ss, 1);
        if ((lane & 15) == 0) __hip_atomic_fetch_add(rsq + row, ss, __ATOMIC_RELAXED, __HIP_MEMORY_SCOPE_AGENT);
      }
    } else if (n0 < 384) {
      float* ex = (float*)(smem + 69632);
#pragma unroll 4
      for (int it = 0; it < 16; ++it) {
        const int rl = it * 4 + (lane >> 4);
        const float4 v = *(const float4*)(wb + rl * 68 + c4);
        float ss = v.x * v.x + v.y * v.y + v.z * v.z + v.w * v.w;
        ss += __shfl_xor(ss, 8); ss += __shfl_xor(ss, 4); ss += __shfl_xor(ss, 2); ss += __shfl_xor(ss, 1);
        if ((lane & 15) == 0) ex[(wm * 2 + wn) * 64 + rl] = ss;
      }
      __syncthreads();
      bf16_t* CKVN = (bf16_t*)(p.ws + WS_CKVN);
      const float4 nw = *(const float4*)(p.in[I_KVNW] + col - 256);
#pragma unroll 4
      for (int it = 0; it < 16; ++it) {
        const int rl = it * 4 + (lane >> 4); const size_t row = (size_t)(rb + rl);
        const float rs = rsqrtf((ex[(wm * 2 + 0) * 64 + rl] + ex[(wm * 2 + 1) * 64 + rl]) * (1.f / 128.f) + EPS);
        const float4 v = *(const float4*)(wb + rl * 68 + c4);
        const float4 o = make_float4(v.x * rs * nw.x, v.y * rs * nw.y, v.z * rs * nw.z, v.w * rs * nw.w);
        *(uint2*)(CKVN + row * 128 + col - 256) = pk4(o);
        if (m0 < NCTX) *(float4*)(p.out + O_CKV + row * 128 + col - 256) = o;
      }
    } else if (n0 < 1408) {
#pragma unroll 4
      for (int it = 0; it < 16; ++it) {
        const int rl = it * 4 + (lane >> 4); const size_t row = (size_t)(rb + rl);
        *(uint2*)(GM + row * 1024 + col - 384) = pk4(silu4(*(const float4*)(wb + rl * 68 + c4)));
      }
    } else if (wn == 0) {
      bf16_t* KPEB = (bf16_t*)(p.ws + WS_KPEB);
      const bool lat = m0 >= NCTX;
#pragma unroll 4
      for (int it = 0; it < 16; ++it) {
        const int rl = it * 4 + (lane >> 4); const size_t row = (size_t)(rb + rl);
        const float4 v = *(const float4*)(wb + rl * 68 + c4);
        const float4 pr = make_float4(__shfl_xor(v.x, 2), __shfl_xor(v.y, 2), __shfl_xor(v.z, 2), __shfl_xor(v.w, 2));
        float4 o = v;
        if (lat) {
          const int l = (int)(row - NCTX) & 4095;
          const float pos = (c4 & 16) ? (float)(l & 63) : (float)(l >> 6);
          const float vv[4] = {v.x, v.y, v.z, v.w}, pp[4] = {pr.x, pr.y, pr.z, pr.w}; float oo[4];
#pragma unroll
          for (int e = 0; e < 4; ++e) {
            const float th = pos * ex2(-(float)((c4 + e) & 7) * (13.287712379549449f / 8.f)), c = __cosf(th), sn = __sinf(th);
            oo[e] = (c4 & 8) ? vv[e] * c + pp[e] * sn : vv[e] * c - pp[e] * sn;
          }
          o = make_float4(oo[0], oo[1], oo[2], oo[3]);
        }
        if (c4 < 32) {
          *(uint2*)(KPEB + row * 32 + c4) = pk4(o);
          if (!lat) *(float4*)(p.out + O_KPE + row * 32 + c4) = v;
        }
      }
    }
  }
}

DI void mla_cache_convert(const Params& p) {
  bf16_t* CKVN = (bf16_t*)(p.ws + WS_CKVN) + (size_t)NTOK * 128; bf16_t* KPEB = (bf16_t*)(p.ws + WS_KPEB) + (size_t)NTOK * 32;
  for (int i = blockIdx.x * 256 + threadIdx.x; i < (65536 + 16384) / 4; i += gridDim.x * 256) {
    if (i < 16384) { float4 v = ((const float4*)p.in[I_CCKV])[i]; *(uint2*)(CKVN + i * 4) = make_uint2(pack2(v.x, v.y), pack2(v.z, v.w)); }
    else { int k = i - 16384; float4 v = ((const float4*)p.in[I_CKPE])[k]; *(uint2*)(KPEB + k * 4) = make_uint2(pack2(v.x, v.y), pack2(v.z, v.w)); }
  }
}
DI void phase_mla_prep(const Params& p) {
  const int tid = threadIdx.x, lane = tid & 63, w = tid >> 6;
  const float* CQ = (const float*)(p.ws + WS_CQ); const float* CKV = (const float*)(p.ws + WS_CKV); const float* KPE = (const float*)(p.ws + WS_KPE);
  bf16_t* CQN = (bf16_t*)(p.ws + WS_CQN); bf16_t* CKVN = (bf16_t*)(p.ws + WS_CKVN); bf16_t* KPEB = (bf16_t*)(p.ws + WS_KPEB);
  for (int item = blockIdx.x; item < NTOK / 4; item += gridDim.x) {
    const size_t row = (size_t)item * 4 + w;
    {
      float4 v = *(const float4*)(CQ + row * 256 + lane * 4);
      float ss = wave_sum(v.x * v.x + v.y * v.y + v.z * v.z + v.w * v.w);
      float rs = rsqrtf(ss * (1.f / 256.f) + EPS);
      float4 nw = *(const float4*)(p.in[I_QNW] + lane * 4);
      *(uint2*)(CQN + row * 256 + lane * 4) = make_uint2(pack2(v.x * rs * nw.x, v.y * rs * nw.y), pack2(v.z * rs * nw.z, v.w * rs * nw.w));
    }
    {
      float2 v = *(const float2*)(CKV + row * 128 + lane * 2);
      float ss = wave_sum(v.x * v.x + v.y * v.y);
      float rs = rsqrtf(ss * (1.f / 128.f) + EPS);
      float2 nw = *(const float2*)(p.in[I_KVNW] + lane * 2);
      float a = v.x * rs * nw.x, b = v.y * rs * nw.y;
      *(unsigned*)(CKVN + row * 128 + lane * 2) = pack2(a, b);
      if (row < NCTX) *(float2*)(p.out + O_CKV + row * 128 + lane * 2) = make_float2(a, b);
    }
    {
      float v = lane < 32 ? KPE[row * 32 + lane] : 0.f;
      float pr = __shfl_xor(v, 8);
      float o = v;
      if (row >= NCTX) {
        int l = (int)(row - NCTX) & 4095;
        float pos = (lane & 16) ? (float)(l & 63) : (float)(l >> 6);
        float th = pos * ex2(-(float)(lane & 7) * (13.287712379549449f / 8.f));
        float c = __cosf(th), s = __sinf(th);
        o = (lane & 8) ? v * c + pr * s : v * c - pr * s;
      } else if (lane < 32) p.out[O_KPE + row * 32 + lane] = v;
      if (lane < 32) KPEB[row * 32 + lane] = f2bf(o);
    }
  }
}

DI void phase_mla_up(const Params& p, unsigned char* smem) {
  const int tid = threadIdx.x, lane = tid & 63, w = tid >> 6, wm = w >> 1, wn = w & 1, lc = lane & 15, g = lane >> 4;
  bf16_t* QM = (bf16_t*)(p.ws + WS_QM); bf16_t* KN = (bf16_t*)(p.ws + WS_KNOPE); bf16_t* VTM = (bf16_t*)(p.ws + WS_VTM);
  constexpr int NQ = 128 * 12, NKV = 132 * 16;
  for (int tile = blockIdx.x; tile < NQ + NKV; tile += gridDim.x) {
    f32x4 acc[4][4]; acc_zero(acc);
    if (tile < NQ) {
      int mt, nt; xcd_tile(tile, 12, mt, nt); const int m0 = mt * 128, n0 = nt * 128;
      gemm_mainloop(acc, (const bf16_t*)(p.ws + WS_CQN), 256, (const bf16_t*)(p.ws + W_UQ), 256, 256, m0, n0, smem);
      const int rb = m0 + wm * 64, cb = n0 + wn * 64; const bool lat = m0 >= NCTX;
      const float inv = ex2(-(float)(lc & 7) * (13.287712379549449f / 8.f));
      if (lat) {
#pragma unroll
        for (int j = 0; j < 4; ++j) {
          const int col0 = cb + j * 16, d0 = col0 % 96;
          if (d0 >= 64) {
#pragma unroll
            for (int i = 0; i < 4; ++i)
#pragma unroll
              for (int r = 0; r < 4; ++r) {
                const int row = rb + i * 16 + 4 * g + r;
                float v = acc[i][j][r];
                float pr = __shfl_xor(v, 8);
                int l = (row - NCTX) & 4095;
                float pos = d0 >= 80 ? (float)(l & 63) : (float)(l >> 6);
                float th = pos * inv, c = __cosf(th), sn = __sinf(th);
                acc[i][j][r] = (lc & 8) ? v * c + pr * sn : v * c - pr * sn;
              }
          }
        }
      }
      {
        const float* wb = stage_wave_tile(acc, smem);
        const int c4 = (lane & 15) * 4; const float qs = 0.10206207261596575f * LOG2E;
#pragma unroll 4
        for (int it = 0; it < 16; ++it) {
          const int rl = it * 4 + (lane >> 4); const size_t row = (size_t)(rb + rl);
          const float4 v = *(const float4*)(wb + rl * 68 + c4);
          const float qr = qs * rsqrtf(((const float*)(p.ws + WS_ROWSQ_Q))[row] * (1.f / 256.f) + EPS);
          *(uint2*)(QM + row * 1536 + cb + c4) = pk4(make_float4(v.x * qr, v.y * qr, v.z * qr, v.w * qr));
        }
      }
    } else {
      const int t2 = tile - NQ; int mt, head; if (t2 < 128 * 16) xcd_tile(t2, 16, mt, head); else { mt = t2 >> 4; head = t2 & 15; } const int m0 = mt * 128, n0 = head * 128;
      gemm_mainloop(acc, (const bf16_t*)(p.ws + WS_CKVN), 128, (const bf16_t*)(p.ws + W_UKV), 128, 128, m0, n0, smem);
      const int rb = m0 + wm * 64;
      if (wn == 0) {
        const float* wb = stage_wave_tile(acc, smem);
        const int c4 = (lane & 15) * 4;
#pragma unroll 4
        for (int it = 0; it < 16; ++it) {
          const int rl = it * 4 + (lane >> 4);
          *(uint2*)(KN + (size_t)(rb + rl) * 1024 + head * 64 + c4) = pk4(*(const float4*)(wb + rl * 68 + c4));
        }
      } else {
#pragma unroll
        for (int i = 0; i < 4; ++i)
#pragma unroll
          for (int j = 0; j < 4; ++j) {
            int row = rb + i * 16 + 4 * g, d = j * 16 + lc;
            *(uint2*)(VTM + ((size_t)(row >> 6) * 16 + head) * 4096 + d * 64 + (row & 63)) = make_uint2(pack2(acc[i][j][0], acc[i][j][1]), pack2(acc[i][j][2], acc[i][j][3]));
          }
      }
    }
  }
}

DI void phase_mla_attn(const Params& p, unsigned char* smem) {
  for (int item = blockIdx.x; item < 1024; item += gridDim.x) {
    AttnArgs a;
    const bool latent = item < 512;
    const int it = latent ? item : item - 512;
    int qb, head, b;
    if (latent) { const int x = it & 7, j = it >> 3, pair = x * 4 + (j >> 4); qb = j & 15; head = pair & 15; b = pair >> 4; }
    else { qb = 0; head = it & 15; b = it >> 4; }
    const int seqrow = latent ? NCTX + b * 4096 : b * 256;
    a.q = (const bf16_t*)(p.ws + WS_QM) + head * 96; a.ldq = 1536;
    a.k = (const bf16_t*)(p.ws + WS_KNOPE) + head * 64; a.ldk = 1024; a.kpe = (const bf16_t*)(p.ws + WS_KPEB);
    a.vt = (const bf16_t*)(p.ws + WS_VTM); a.vt_heads = 16; a.vhead = head;
    a.gate = (const bf16_t*)(p.ws + WS_GM) + head * 64; a.ldg = 1024;
    a.out = (bf16_t*)(p.ws + WS_AOM) + head * 64; a.ldo = 1024;
    a.qrow0 = seqrow + qb * 256; a.qpos0 = qb * 256;
    a.seg0_row = seqrow; a.seg0_n = latent ? 4096 : 256; a.seg0_pos = 0; a.band = 0;
    a.seg1_row = NTOK + b * 256; a.seg1_n = latent ? 256 : 0;
    a.sink2 = 0.f; a.has_sink = 0; a.scale2 = 1.f;
    attn_item2<96, true>(a, smem);
  }
}

DI void phase_final_norm(const Params& p) {
  const int tid = threadIdx.x;
  const bf16_t* X2B = (const bf16_t*)(p.ws + WS_X2B); const float* rowsq = (const float*)(p.ws + WS_ROWSQ);
  const int c8 = (tid & 127) * 8;
  const float4 w0 = *(const float4*)(p.in[I_FNW] + c8), w1 = *(const float4*)(p.in[I_FNW] + c8 + 4);
  for (int item = blockIdx.x; item < NTOK / 2; item += gridDim.x) {
    const size_t row = (size_t)item * 2 + (tid >> 7);
    const float rs = rsqrtf(rowsq[row] * (1.f / 1024.f) + EPS);
    const uint4 u = *(const uint4*)(X2B + row * 1024 + c8);
    float* o = p.out + O_Y + row * 1024 + c8;
    *(float4*)o = make_float4(bflo(u.x) * rs * w0.x, bfhi(u.x) * rs * w0.y, bflo(u.y) * rs * w0.z, bfhi(u.y) * rs * w0.w);
    *(float4*)(o + 4) = make_float4(bflo(u.z) * rs * w1.x, bfhi(u.z) * rs * w1.y, bflo(u.w) * rs * w1.z, bfhi(u.w) * rs * w1.w);
  }
}

#define XB_TMO      128
#define XB_XCNT(j)  (256  + 64 * (j))
#define XB_XSUB(j)  (1280 + 64 * (j))
#define XB_XGEN(j)  (2304 + 64 * (j))
#define XB_TOP      3328
#define XB_TOPGEN   3392
#define XCD_BAR_WORDS 3456
#define XB_SPIN_CAP (1u << 18)
#define LAS __attribute__((address_space(3)))

__device__ __forceinline__ unsigned xb_ld(unsigned* p)              { return __hip_atomic_load(p, __ATOMIC_RELAXED, __HIP_MEMORY_SCOPE_AGENT); }
__device__ __forceinline__ unsigned xb_add(unsigned* p, unsigned v) { return __hip_atomic_fetch_add(p, v, __ATOMIC_RELAXED, __HIP_MEMORY_SCOPE_AGENT); }
__device__ __forceinline__ unsigned xb_xcc_id() { return (unsigned)__builtin_amdgcn_s_getreg((3 << 11) | 20) & 0xFu; }
#define XB_SPIN(cond, bar) do { unsigned _sp = 0; while (cond) { __builtin_amdgcn_s_sleep(1); \
    if ((++_sp & 255u) == 0u) { if (xb_ld(&(bar)[XB_TMO])) break; if (_sp > XB_SPIN_CAP) { atomicAdd(&(bar)[XB_TMO], 1u); break; } } } } while (0)

struct XcdBarrier {
    unsigned* bar; unsigned x;
    volatile LAS unsigned* st;
};

__device__ __forceinline__ XcdBarrier xcd_barrier_post(unsigned* bar, volatile LAS unsigned* st) {
    XcdBarrier b; b.bar = bar; b.x = xb_xcc_id(); b.st = st;
    if (threadIdx.x == 0) (void)xb_add(&bar[XB_XCNT(b.x)], 1u);
    return b;
}
__device__ __forceinline__ void xcd_barrier_complete(unsigned* bar, unsigned x, unsigned& nloc, unsigned& nx) {
    const unsigned G = gridDim.x * gridDim.y * gridDim.z;
    unsigned sum, cnt, mine, sp = 0u;
    for (;;) {
        sum = 0u; cnt = 0u; mine = 0u;
#pragma unroll
        for (unsigned j = 0; j < 16; ++j) { const unsigned c = xb_ld(&bar[XB_XCNT(j)]); sum += c; cnt += (c > 0u) ? 1u : 0u; mine = (j == x) ? c : mine; }
        if (sum == G) break;
        __builtin_amdgcn_s_sleep(1);
        if ((++sp & 255u) == 0u) { if (xb_ld(&bar[XB_TMO])) break; if (sp > XB_SPIN_CAP) { atomicAdd(&bar[XB_TMO], 1u); break; } }
    }
    nloc = mine > 0u ? mine : 1u; nx = cnt > 0u ? cnt : 1u;
}

__device__ __forceinline__ void xcd_barrier(const XcdBarrier& b) {
    asm volatile("s_waitcnt vmcnt(0)" ::: "memory");
    __syncthreads();
    if (threadIdx.x == 0) {
        unsigned* bar = b.bar;
        __builtin_amdgcn_s_waitcnt(0);
        unsigned nloc = b.st[0], nx = b.st[1];
        if (nloc == 0u) { xcd_barrier_complete(bar, b.x, nloc, nx); b.st[0] = nloc; b.st[1] = nx; }
        const unsigned old = xb_add(&bar[XB_XSUB(b.x)], 1u);
        const unsigned gen = old / nloc;
        if (old + 1u == (gen + 1u) * nloc) {
            __builtin_amdgcn_fence(__ATOMIC_RELEASE, "agent");
            asm volatile("s_waitcnt vmcnt(0)" ::: "memory");
            const unsigned og = xb_add(&bar[XB_TOP], 1u);
            const unsigned tg = og / nx;
            if (og + 1u == (tg + 1u) * nx) xb_add(&bar[XB_TOPGEN], 1u);
            else XB_SPIN(xb_ld(&bar[XB_TOPGEN]) == tg, bar);
            __builtin_amdgcn_fence(__ATOMIC_ACQUIRE, "agent");
            xb_add(&bar[XB_XGEN(b.x)], 1u);
            asm volatile("s_waitcnt vmcnt(0)" ::: "memory");
        } else {
            XB_SPIN(xb_ld(&bar[XB_XGEN(b.x)]) == gen, bar);
            __builtin_amdgcn_fence(__ATOMIC_ACQUIRE, "agent");
            asm volatile("s_waitcnt vmcnt(0)" ::: "memory");
        }
    }
    __syncthreads();
}


constexpr int N_PHASES = 15;
__global__ void __launch_bounds__(256, 2) mega(Params p) {
  __shared__ __attribute__((aligned(16))) unsigned char smem[75 * 1024];
  volatile LAS unsigned* xst = (volatile LAS unsigned*)(smem + 75 * 1024 - 16);
  if (threadIdx.x == 0) { xst[0] = 0u; xst[1] = 0u; }
  __syncthreads();
  XcdBarrier xb = xcd_barrier_post((unsigned*)(p.ws + WS_BAR), xst);
  if (p.ph_hi > 1000) cg::this_grid().sync();
#ifndef PROBE_D
#define PROBE_D 0
#endif
#ifndef REPEAT_MASK
#define REPEAT_MASK 0
#endif
#define PHASE(n, ...) if (p.ph_lo <= n && n < p.ph_hi) { __VA_ARGS__; if ((REPEAT_MASK >> n) & 1) { __VA_ARGS__; } if (n + 1 < p.ph_hi) xcd_barrier(xb); }
  PHASE(1, phase0(p, smem); for (int t = blockIdx.x; t < N_WT; t += gridDim.x) wt_item(p, t, smem + 24576); phase_modnorm(p, 0, smem))
  PHASE(2, phase_ab_in(p, smem))
  PHASE(3, phase_conv(p, smem); for (int it = 384 + blockIdx.x; it < 768; it += gridDim.x) p0_mod_item(p, it, smem))
  PHASE(4, phase_ssd_states(p, smem))
#if PROBE_D == 1
  if (p.ph_lo <= 5 && 5 < p.ph_hi) phase_scan_attn_a(p, smem, p.ph_hi > 100);
#endif
  PHASE(5, phase_scan_attn_a(p, smem))
#if PROBE_D == 2
  if (p.ph_lo <= 6 && 6 < p.ph_hi) phase_ssd_out(p, smem, p.ph_hi > 100);
#endif
  PHASE(6, phase_ssd_out(p, smem))
  PHASE(7, phase_ab_out(p, smem))
  PHASE(8, phase_modnorm(p, 1, smem); mla_cache_convert(p))
  PHASE(9, phase_mla_in(p, smem))
  PHASE(11, phase_mla_up(p, smem))
  PHASE(12, phase_mla_attn(p, smem))
  PHASE(13, phase_mla_out(p, smem))
  PHASE(14, phase_final_norm(p))
}

extern "C" void kernel_launch(void* const* d_in, const int* in_sizes, int n_in, void* d_out, int out_size, void* d_ws, size_t ws_size, hipStream_t stream) {
  static int grid = 0;
  if (grid == 0) {
    int dev = 0, cus = 0, per_cu = 0;
    hipGetDevice(&dev);
    hipDeviceGetAttribute(&cus, hipDeviceAttributeMultiprocessorCount, dev);
    hipOccupancyMaxActiveBlocksPerMultiprocessor(&per_cu, (const void*)mega, 256, 0);
    if (per_cu < 1) per_cu = 1;
    if (per_cu > 2) per_cu = 2;
    grid = cus * per_cu;
  }
  Params p{};
  for (int i = 0; i < 29; ++i) p.in[i] = (const float*)d_in[i];
  p.out = (float*)d_out; p.ws = (unsigned char*)d_ws;
  hipMemsetAsync((unsigned char*)d_ws + WS_BAR, 0, WS_ZERO_BYTES, stream);
#if MULTI_LAUNCH
  for (int ph = 0; ph < N_PHASES; ++ph) {
    p.ph_lo = ph; p.ph_hi = ph + 1;
    hipLaunchKernelGGL(mega, dim3(grid), dim3(256), 0, stream, p);
  }
#else
  p.ph_lo = 0; p.ph_hi = N_PHASES;
  void* args[] = {&p};
  hipError_t e = hipLaunchCooperativeKernel((const void*)mega, dim3(grid), dim3(256), args, 0, stream);
  if (e != hipSuccess) fprintf(stderr, "cooperative launch failed: %s (grid %d)\n", hipGetErrorString(e), grid);
#endif
}
```

```cpp
#include <hip/hip_runtime.h>
#include <hip/hip_cooperative_groups.h>
#include <cstdio>
namespace cg = cooperative_groups;

#ifndef MULTI_LAUNCH
#define MULTI_LAUNCH 0
#endif

typedef unsigned short bf16_t;
using bf16x8 = __attribute__((ext_vector_type(8))) short;
using f32x4  = __attribute__((ext_vector_type(4))) float;
typedef __bf16 bf2v __attribute__((ext_vector_type(2)));
typedef float  fl2v __attribute__((ext_vector_type(2)));
#define DI __device__ __forceinline__
#define MFMA16(a, b, c) __builtin_amdgcn_mfma_f32_16x16x32_bf16((a), (b), (c), 0, 0, 0)

constexpr int NTOK = 16384;
constexpr int NCTX = 8192;
constexpr int NROWK = 16896;
constexpr int ABIN_N = 3712;
constexpr int MIN_N = 1536;
constexpr float EPS = 1e-6f;
constexpr float LOG2E = 1.4426950408889634f;

constexpr size_t O_Y = 0;
constexpr size_t O_CAK = 16777216;
constexpr size_t O_CAV = 17825792;
constexpr size_t O_SF = 18874368;
constexpr size_t O_SB = 20971520;
constexpr size_t O_CKV = 23068672;
constexpr size_t O_KPE = 24117248;

constexpr size_t KB = 1024, MB = 1024 * 1024;
constexpr size_t W_ABIN = 0;
constexpr size_t W_ABOUT = W_ABIN + (size_t)ABIN_N * 1024 * 2;
constexpr size_t W_MIN = W_ABOUT + 1024 * 1536 * 2;
constexpr size_t W_UQ = W_MIN + 1536 * 1024 * 2;
constexpr size_t W_UKV = W_UQ + 1536 * 256 * 2;
constexpr size_t W_MOUT = W_UKV + 2048 * 128 * 2;
constexpr size_t W_END = W_MOUT + 1024 * 1024 * 2;
constexpr size_t WS_ROWSQ = 17 * MB + 768 * KB + 96 * KB;
constexpr size_t WS_ROWSQ_Q = WS_ROWSQ + 64 * KB;
constexpr size_t WS_ZERO_BYTES = 96 * KB + 128 * KB;
constexpr size_t WS_X2B = 50 * MB;
constexpr size_t WS_GCNT = 17 * MB + 768 * KB + 15 * KB;
constexpr size_t WS_MODP = 17 * MB + 768 * KB + 16 * KB;
constexpr size_t WS_CDEC = 17 * MB + 512 * KB;
constexpr size_t WS_BAR = 17 * MB + 768 * KB;
constexpr size_t WS_H = 18 * MB;
constexpr size_t WS_XT = 18 * MB;
constexpr size_t WS_XBCR = 50 * MB;
constexpr size_t WS_HIN = 50 * MB;
constexpr size_t WS_QA = 90 * MB;
constexpr size_t WS_KA = 106 * MB;
constexpr size_t WS_VTA = WS_KA + 4352 * KB;
constexpr size_t WS_GA = WS_VTA + 4352 * KB;
constexpr size_t WS_ZS = WS_GA + 16 * MB;
constexpr size_t WS_DTP = WS_ZS + 32 * MB;
constexpr size_t WS_BT = WS_DTP + 2 * MB;
constexpr size_t WS_BCM = WS_BT + 4 * MB;
constexpr size_t WS_SSQ = WS_BCM + 8 * MB;
constexpr size_t WS_STATES = WS_SSQ + 1 * MB;
constexpr size_t WS_L0_END = WS_STATES + 64 * MB;
constexpr size_t WS_AOM = 18 * MB;
constexpr size_t WS_GM = 50 * MB;
constexpr size_t WS_CQN = 82 * MB;
constexpr size_t WS_CKVN = 90 * MB;
constexpr size_t WS_KPEB = WS_CKVN + 4352 * KB;
constexpr size_t WS_QM = WS_KPEB + 1280 * KB;
constexpr size_t WS_KNOPE = WS_QM + 48 * MB;
constexpr size_t WS_VTM = WS_KNOPE + 33 * MB;
constexpr size_t WS_CQ = WS_VTM;
constexpr size_t WS_CKV = WS_CQ + 16 * MB;
constexpr size_t WS_KPE = WS_CKV + 8 * MB;
constexpr size_t WS_X1B = WS_VTM + 33 * MB;
constexpr size_t WS_L1_END = WS_X1B + 32 * MB;
static_assert(W_END <= 17 * MB, "weights");
static_assert(WS_L0_END <= 256 * MB && WS_L1_END <= 256 * MB && WS_X1B >= WS_STATES && WS_X1B >= WS_SSQ + 1 * MB, "workspace");

struct Params {
  const float* in[29];
  float* out;
  unsigned char* ws;
  int ph_lo, ph_hi;
};
enum { I_XP = 0, I_XS, I_CAK, I_CAV, I_SF, I_SB, I_CCKV, I_CKPE, I_C, I_CCTX, I_ADAW, I_ADAB, I_NORMW, I_ABWIN, I_SINK, I_CONVW, I_CONVB,
       I_DTB, I_ALOG, I_DSKIP, I_GNW, I_ABWOUT, I_MWIN, I_QNW, I_KVNW, I_WUQ, I_WUKV, I_MWOUT, I_FNW };

DI unsigned pack2(float a, float b) { fl2v v = {a, b}; bf2v r = __builtin_convertvector(v, bf2v); return __builtin_bit_cast(unsigned, r); }
DI bf16_t f2bf(float a) { return (bf16_t)(pack2(a, 0.f) & 0xffffu); }
DI float bf2f(bf16_t b) { return __uint_as_float(((unsigned)b) << 16); }
DI float bflo(unsigned u) { return __uint_as_float(u << 16); }
DI float bfhi(unsigned u) { return __uint_as_float(u & 0xffff0000u); }
DI float silu_f(float x) { return x * __builtin_amdgcn_rcpf(1.f + __builtin_amdgcn_exp2f(-x * 1.4426950408889634f)); }
DI float softplus_f(float x) { return x > 20.f ? x : log1pf(__expf(x)); }
DI float ex2(float x) { return __builtin_amdgcn_exp2f(x); }
DI bf16x8 mk8(unsigned a, unsigned b, unsigned c, unsigned d) { uint4 u = make_uint4(a, b, c, d); return __builtin_bit_cast(bf16x8, u); }
DI int cond_of(int row) { return row < NCTX ? 0 : 1 + ((row - NCTX) >> 12); }
DI float wave_sum(float v) {
#pragma unroll
  for (int o = 32; o > 0; o >>= 1) v += __shfl_xor(v, o);
  return v;
}
DI float mod_val(const Params& p, int layer, int cond, int which, int c) {
  return ((const float*)(p.ws + WS_MODP))[(layer * 3 + cond) * 3072 + which * 1024 + c];
}
DI void chunk_rows(int gc, int& row0, int& s0, int& s1) {
  if (gc < 64) { int seq = gc >> 1; s0 = seq * 256; s1 = s0 + 256; row0 = s0 + (gc & 1) * 128; }
  else { int g2 = gc - 64; int seq = g2 >> 5; s0 = NCTX + seq * 4096; s1 = s0 + 4096; row0 = s0 + (g2 & 31) * 128; }
}

DI void p0_mod_item(const Params& p, int item, unsigned char* smem) {
  const int tid = threadIdx.x;
  const int kc = item & 31, cgp = (item >> 5) % 12, layer = item / 384;
  float* sl = (float*)smem;
  __syncthreads();
  if (tid < 96) {
    int j = tid >> 5, k = kc * 32 + (tid & 31);
    const float* cv = j == 0 ? p.in[I_CCTX] : p.in[I_C] + (j - 1) * 1024;
    sl[tid] = silu_f(cv[k]);
  }
  __syncthreads();
  const int col = cgp * 256 + tid;
  const float* W = p.in[I_ADAW] + (size_t)layer * 1024 * 3072 + (size_t)(kc * 32) * 3072 + col;
  float wv[32];
#pragma unroll
  for (int kk = 0; kk < 32; ++kk) wv[kk] = W[(size_t)kk * 3072];
  float a0 = 0.f, a1 = 0.f, a2 = 0.f;
#pragma unroll
  for (int kk = 0; kk < 32; ++kk) { a0 += sl[kk] * wv[kk]; a1 += sl[32 + kk] * wv[kk]; a2 += sl[64 + kk] * wv[kk]; }
  if (kc == 0) { float bb = p.in[I_ADAB][layer * 3072 + col]; a0 += bb; a1 += bb; a2 += bb; }
  float* mp = (float*)(p.ws + WS_MODP) + (size_t)layer * 3 * 3072 + col;
  atomicAdd(mp, a0); atomicAdd(mp + 3072, a1); atomicAdd(mp + 6144, a2);
  if (layer == 0) {
    asm volatile("s_waitcnt vmcnt(0)" ::: "memory");
    __syncthreads();
    if (tid == 0) __hip_atomic_fetch_add((unsigned*)(p.ws + WS_GCNT), 1u, __ATOMIC_RELAXED, __HIP_MEMORY_SCOPE_AGENT);
  }
}
DI void p0_wt_tile(const float* src, int ldsrc, bf16_t* dst, int K, int k0, int n0, int nvalid, int mode, const float* rowscale, int rs_off, unsigned char* smem) {
  const int tid = threadIdx.x;
  float* tile = (float*)smem;
  const int c4 = (tid & 15) * 4, r0 = tid >> 4;
  const int n = n0 + c4;
  int sc;
  if (mode == 0) sc = n < nvalid ? n : -1;
  else sc = n < 384 ? n : (n < 1408 ? n + 32 : (n < 1440 ? n - 1024 : -1));
  __syncthreads();
  float4 vv[4];
#pragma unroll
  for (int i = 0; i < 4; ++i) { const int k = k0 + r0 + 16 * i; vv[i] = sc >= 0 ? *(const float4*)(src + (size_t)k * ldsrc + sc) : make_float4(0.f, 0.f, 0.f, 0.f); }
#pragma unroll
  for (int i = 0; i < 4; ++i) {
    const int k = k0 + r0 + 16 * i; float4 v = vv[i];
    if (rowscale && k >= rs_off) { const float f = rowscale[k - rs_off]; v.x *= f; v.y *= f; v.z *= f; v.w *= f; }
    float* tp = tile + (r0 + 16 * i) * 65 + c4;
    tp[0] = v.x; tp[1] = v.y; tp[2] = v.z; tp[3] = v.w;
  }
  __syncthreads();
  const int nn = tid >> 2, kk0 = (tid & 3) * 16;
  unsigned u[8];
#pragma unroll
  for (int e = 0; e < 8; ++e) u[e] = pack2(tile[(kk0 + 2 * e) * 65 + nn], tile[(kk0 + 2 * e + 1) * 65 + nn]);
  uint4* d = (uint4*)(dst + (size_t)(n0 + nn) * K + k0 + kk0);
  d[0] = make_uint4(u[0], u[1], u[2], u[3]); d[1] = make_uint4(u[4], u[5], u[6], u[7]);
}
constexpr int T_ABIN = 16 * 58, T_ABOUT = 24 * 16, T_MIN = 16 * 24, T_UQ = 4 * 24, T_UKV = 2 * 32, T_MOUT = 16 * 16;
constexpr int N_WT = T_ABIN + T_ABOUT + T_MIN + T_UQ + T_UKV + T_MOUT;
DI void wt_item(const Params& p, int t, unsigned char* smem) {
  if (t < T_ABIN) { int nt = t % 58, kt = t / 58; p0_wt_tile(p.in[I_ABWIN], 3616, (bf16_t*)(p.ws + W_ABIN), 1024, kt * 64, nt * 64, 3616, 0, nullptr, 0, smem); return; }
  t -= T_ABIN;
  if (t < T_ABOUT) { int nt = t % 16, kt = t / 16; p0_wt_tile(p.in[I_ABWOUT], 1024, (bf16_t*)(p.ws + W_ABOUT), 1536, kt * 64, nt * 64, 1024, 0, p.in[I_GNW], 512, smem); return; }
  t -= T_ABOUT;
  if (t < T_MIN) { int nt = t % 24, kt = t / 24; p0_wt_tile(p.in[I_MWIN], 1440, (bf16_t*)(p.ws + W_MIN), 1024, kt * 64, nt * 64, 1440, 1, nullptr, 0, smem); return; }
  t -= T_MIN;
  if (t < T_UQ) { int nt = t % 24, kt = t / 24; p0_wt_tile(p.in[I_WUQ], 1536, (bf16_t*)(p.ws + W_UQ), 256, kt * 64, nt * 64, 1536, 0, p.in[I_QNW], 0, smem); return; }
  t -= T_UQ;
  if (t < T_UKV) { int nt = t % 32, kt = t / 32; p0_wt_tile(p.in[I_WUKV], 2048, (bf16_t*)(p.ws + W_UKV), 128, kt * 64, nt * 64, 2048, 0, nullptr, 0, smem); return; }
  t -= T_UKV;
  { int nt = t % 16, kt = t / 16; p0_wt_tile(p.in[I_MWOUT], 1024, (bf16_t*)(p.ws + W_MOUT), 1024, kt * 64, nt * 64, 1024, 0, nullptr, 0, smem); }
}
DI void phase0(const Params& p, unsigned char* smem) {
  constexpr int N_MOD = 384;
  constexpr int N_CACHE = 64;
  constexpr int N_ALL = N_MOD + N_CACHE;
  for (int item = blockIdx.x; item < N_ALL; item += gridDim.x) {
    if (item < N_MOD) { p0_mod_item(p, item, smem); continue; }
    int t = item - N_MOD;
    const int tid = threadIdx.x;
    if (t < 32) {
      int e0 = t * 2048 + tid * 8;
      const float4* s = (const float4*)(p.in[I_CAK] + e0);
      float4 a = s[0], b = s[1];
      *(uint4*)((bf16_t*)(p.ws + WS_KA) + (size_t)NTOK * 128 + e0) = make_uint4(pack2(a.x, a.y), pack2(a.z, a.w), pack2(b.x, b.y), pack2(b.z, b.w));
    } else {
      int e0 = (t - 32) * 2048 + tid * 8;
      bf16_t* vt = (bf16_t*)(p.ws + WS_VTA);
#pragma unroll
      for (int e = 0; e < 8; ++e) {
        int idx = e0 + e;
        int d = idx & 63, kvh = (idx >> 6) & 1, rj = idx >> 7;
        int row = NTOK + rj;
        vt[((size_t)(row >> 6) * 2 + kvh) * 4096 + d * 64 + (row & 63)] = f2bf(p.in[I_CAV][idx]);
      }
    }
  }
}

DI void phase_modnorm(const Params& p, int layer, unsigned char* smem) {
  const int tid = threadIdx.x, lane = tid & 63, w = tid >> 6;
  float* em = (float*)smem;
  float* ea = em + 3072;
  if (layer == 0 && tid == 0) {
    unsigned spins = 0;
    while (__hip_atomic_load((unsigned*)(p.ws + WS_GCNT), __ATOMIC_RELAXED, __HIP_MEMORY_SCOPE_AGENT) < 384u && ++spins < (1u << 22)) __builtin_amdgcn_s_sleep(2);
  }
  __syncthreads();
  for (int i = tid; i < 3072; i += 256) {
    int cond = i >> 10, c = i & 1023;
    float* mpa = (float*)(p.ws + WS_MODP) + (layer * 3 + cond) * 3072;
    float sh = __hip_atomic_load(mpa + c, __ATOMIC_RELAXED, __HIP_MEMORY_SCOPE_AGENT), sc = __hip_atomic_load(mpa + 1024 + c, __ATOMIC_RELAXED, __HIP_MEMORY_SCOPE_AGENT);
    em[i] = p.in[I_NORMW][layer * 1024 + c] * (1.f + sc); ea[i] = sh;
  }
  __syncthreads();
  bf16_t* H = (bf16_t*)(p.ws + WS_H);
  for (int item = blockIdx.x; item < NTOK / 4; item += gridDim.x) {
    int row = item * 4 + w;
    float4 v[4]; float ss = 0.f;
    if (layer == 0) {
      const float* xr = row < NCTX ? p.in[I_XP] + (size_t)row * 1024 : p.in[I_XS] + (size_t)(row - NCTX) * 1024;
#pragma unroll
      for (int i = 0; i < 4; ++i) v[i] = ((const float4*)xr)[lane + 64 * i];
    } else {
      const uint2* xr = (const uint2*)((const bf16_t*)(p.ws + WS_X1B) + (size_t)row * 1024);
#pragma unroll
      for (int i = 0; i < 4; ++i) { uint2 u = xr[lane + 64 * i]; v[i] = make_float4(bflo(u.x), bfhi(u.x), bflo(u.y), bfhi(u.y)); }
    }
#pragma unroll
    for (int i = 0; i < 4; ++i) ss += v[i].x * v[i].x + v[i].y * v[i].y + v[i].z * v[i].z + v[i].w * v[i].w;
    ss = wave_sum(ss);
    float rstd = rsqrtf(ss * (1.f / 1024.f) + EPS);
    int cond = cond_of(row);
#pragma unroll
    for (int i = 0; i < 4; ++i) {
      int col = (lane + 64 * i) * 4;
      float4 m = *(const float4*)(em + cond * 1024 + col), a = *(const float4*)(ea + cond * 1024 + col);
      uint2 o = make_uint2(pack2(v[i].x * rstd * m.x + a.x, v[i].y * rstd * m.y + a.y), pack2(v[i].z * rstd * m.z + a.z, v[i].w * rstd * m.w + a.w));
      *(uint2*)(H + (size_t)row * 1024 + col) = o;
    }
  }
}

template <bool NARROW = false>
DI void gemm_mainloop(f32x4 (&acc)[4][4], const bf16_t* __restrict__ A, int lda, const bf16_t* __restrict__ B, int ldb, int K, int m0, int n0, unsigned char* smem) {
  const int tid = threadIdx.x, lane = tid & 63, w = tid >> 6, wm = w >> 1, wn = w & 1, lc = lane & 15, g = lane >> 4;
  const int rr = w * 8 + (lane >> 3);
  const int q = (lane & 7) ^ (((w & 1) * 4 + (lane >> 4)) & 7);
  const bf16_t* ga = A + (size_t)(m0 + rr) * lda + q * 8;
  const bf16_t* gb = B + (size_t)(n0 + rr) * ldb + q * 8;
  const int sw = (lc >> 1) & 7;
  const int nk = K >> 6;
#define GSTAGE(s, kt) do { _Pragma("unroll") for (int i = 0; i < 4; ++i) { \
    __builtin_amdgcn_global_load_lds((const unsigned*)(ga + (size_t)(i * 32) * lda + (kt) * 64), (unsigned*)(smem + (s) * 32768 + w * 1024 + i * 4096), 16, 0, 0); \
    if (!NARROW || i == 0) __builtin_amdgcn_global_load_lds((const unsigned*)(gb + (size_t)(i * 32) * ldb + (kt) * 64), (unsigned*)(smem + (s) * 32768 + 16384 + w * 1024 + i * 4096), 16, 0, 0); } } while (0)
  __syncthreads();
  GSTAGE(0, 0);
  asm volatile("s_waitcnt vmcnt(0)" ::: "memory");
  __syncthreads();
  for (int kt = 0; kt < nk; ++kt) {
    const int cur = kt & 1;
    if (kt + 1 < nk) GSTAGE(cur ^ 1, kt + 1);
    const unsigned char* sa = smem + cur * 32768 + (wm * 64 + lc) * 128;
    const unsigned char* sb = smem + cur * 32768 + 16384 + (wn * 64 + lc) * 128;
#pragma unroll
    for (int ks = 0; ks < 2; ++ks) {
      const int co = ((ks * 4 + g) ^ sw) * 16;
      bf16x8 af[4], bfr[4];
      if (NARROW) {
        if (wn == 0) {
#pragma unroll
          for (int i = 0; i < 4; ++i) af[i] = *(const bf16x8*)(sa + i * 2048 + co);
#pragma unroll
          for (int j = 0; j < 2; ++j) bfr[j] = *(const bf16x8*)(sb + j * 2048 + co);
#pragma unroll
          for (int i = 0; i < 4; ++i)
#pragma unroll
            for (int j = 0; j < 2; ++j) acc[i][j] = MFMA16(af[i], bfr[j], acc[i][j]);
        }
      } else {
#pragma unroll
        for (int i = 0; i < 4; ++i) af[i] = *(const bf16x8*)(sa + i * 2048 + co);
#pragma unroll
        for (int j = 0; j < 4; ++j) bfr[j] = *(const bf16x8*)(sb + j * 2048 + co);
#pragma unroll
        for (int i = 0; i < 4; ++i)
#pragma unroll
          for (int j = 0; j < 4; ++j) acc[i][j] = MFMA16(af[i], bfr[j], acc[i][j]);
      }
    }
    asm volatile("s_waitcnt vmcnt(0)" ::: "memory");
    __syncthreads();
  }
#undef GSTAGE
}
DI void acc_zero(f32x4 (&acc)[4][4]) {
#pragma unroll
  for (int i = 0; i < 4; ++i)
#pragma unroll
    for (int j = 0; j < 4; ++j) acc[i][j] = f32x4{0.f, 0.f, 0.f, 0.f};
}
DI void rope64(f32x4 (&acc)[4][4], int rowbase  , int lc, int g) {
  const float inv = ex2(-(float)lc * (13.287712379549449f / 16.f));
#pragma unroll
  for (int i = 0; i < 4; ++i)
#pragma unroll
    for (int r = 0; r < 4; ++r) {
      int l = (rowbase + i * 16 + 4 * g + r - NCTX) & 4095;
      float tr = (float)(l >> 6) * inv, tc = (float)(l & 63) * inv;
      float cr = __cosf(tr), sr = __sinf(tr), cc = __cosf(tc), sc = __sinf(tc);
      float a = acc[i][0][r], b = acc[i][1][r];
      acc[i][0][r] = a * cr - b * sr; acc[i][1][r] = b * cr + a * sr;
      a = acc[i][2][r]; b = acc[i][3][r];
      acc[i][2][r] = a * cc - b * sc; acc[i][3][r] = b * cc + a * sc;
    }
}

DI float* stage_wave_tile(const f32x4 (&acc)[4][4], unsigned char* smem) {
  const int lane = threadIdx.x & 63, w = threadIdx.x >> 6, lc = lane & 15, g = lane >> 4;
  float* wb = (float*)smem + w * (64 * 68);
#pragma unroll
  for (int i = 0; i < 4; ++i)
#pragma unroll
    for (int j = 0; j < 4; ++j)
#pragma unroll
      for (int r = 0; r < 4; ++r) wb[(i * 16 + 4 * g + r) * 68 + j * 16 + lc] = acc[i][j][r];
  __builtin_amdgcn_wave_barrier();
  return wb;
}
DI uint2 pk4(float4 v) { return make_uint2(pack2(v.x, v.y), pack2(v.z, v.w)); }
DI float4 silu4(float4 v) { return make_float4(silu_f(v.x), silu_f(v.y), silu_f(v.z), silu_f(v.w)); }
DI void xcd_tile(int v, int NT, int& mt, int& nt) { const int x = v & 7, j = v >> 3; mt = (j / NT) * 8 + x; nt = j % NT; }

DI void phase_ab_in(const Params& p, unsigned char* smem) {
  const int tid = threadIdx.x, lane = tid & 63, w = tid >> 6, wm = w >> 1, wn = w & 1, lc = lane & 15, g = lane >> 4;
  const bf16_t* H = (const bf16_t*)(p.ws + WS_H);
  const bf16_t* W = (const bf16_t*)(p.ws + W_ABIN);
  bf16_t* QA = (bf16_t*)(p.ws + WS_QA); bf16_t* KA = (bf16_t*)(p.ws + WS_KA); bf16_t* VTA = (bf16_t*)(p.ws + WS_VTA);
  bf16_t* GA = (bf16_t*)(p.ws + WS_GA); bf16_t* ZS = (bf16_t*)(p.ws + WS_ZS); bf16_t* XB = (bf16_t*)(p.ws + WS_XBCR);
  float* DTP = (float*)(p.ws + WS_DTP);
  constexpr int NT = ABIN_N / 128;
  for (int tile = blockIdx.x; tile < 128 * NT; tile += gridDim.x) {
    int mt, nt; if (tile < 128 * (NT - 1)) xcd_tile(tile, NT - 1, mt, nt); else { mt = tile - 128 * (NT - 1); nt = NT - 1; }
    const int m0 = mt * 128, n0 = nt * 128;
    f32x4 acc[4][4]; acc_zero(acc);
    if (n0 >= 3584) gemm_mainloop<true>(acc, H, 1024, W, 1024, 1024, m0, n0, smem); else gemm_mainloop<false>(acc, H, 1024, W, 1024, 1024, m0, n0, smem);
    const int rb = m0 + wm * 64, cb = n0 + wn * 64;
    const bool lat = m0 >= NCTX;
    if (n0 < 640 && lat) rope64(acc, rb, lc, g);
    if (n0 >= 640 && n0 < 768) {
#pragma unroll
      for (int i = 0; i < 4; ++i)
#pragma unroll
        for (int j = 0; j < 4; ++j) {
          int row = rb + i * 16 + 4 * g, d = j * 16 + lc;
          *(uint2*)(VTA + ((size_t)(row >> 6) * 2 + wn) * 4096 + d * 64 + (row & 63)) = make_uint2(pack2(acc[i][j][0], acc[i][j][1]), pack2(acc[i][j][2], acc[i][j][3]));
        }
    }
    if (n0 < 3584) {
      const float* wb = stage_wave_tile(acc, smem);
      const int c4 = (lane & 15) * 4, col = cb + c4;
#pragma unroll 4
      for (int it = 0; it < 16; ++it) {
        const int rl = it * 4 + (lane >> 4); const size_t row = (size_t)(rb + rl);
        float4 v = *(const float4*)(wb + rl * 68 + c4);
        if (n0 < 512) { const float qs = 0.125f * LOG2E; *(uint2*)(QA + row * 512 + col) = pk4(make_float4(v.x * qs, v.y * qs, v.z * qs, v.w * qs)); }
        else if (n0 < 640) { *(uint2*)(KA + row * 128 + col - 512) = pk4(v); if (!lat) *(float4*)(p.out + O_CAK + row * 128 + col - 512) = v; }
        else if (n0 < 768) { if (!lat) *(float4*)(p.out + O_CAV + row * 128 + col - 640) = v; }
        else if (n0 < 1280) *(uint2*)(GA + row * 512 + col - 768) = pk4(silu4(v));
        else if (n0 < 2304) *(uint2*)(ZS + row * 1024 + col - 1280) = pk4(silu4(v));
        else *(uint2*)(XB + row * 1280 + col - 2304) = pk4(v);
      }
    } else if (wn == 0) {
#pragma unroll
      for (int i = 0; i < 4; ++i)
#pragma unroll
        for (int j = 0; j < 2; ++j)
#pragma unroll
          for (int r = 0; r < 4; ++r) {
            int row = rb + i * 16 + 4 * g + r, col = j * 16 + lc;
            DTP[(size_t)row * 32 + col] = softplus_f(acc[i][j][r] + p.in[I_DTB][col]);
          }
    }
  }
}

DI void phase_conv(const Params& p, unsigned char* smem) {
  const int tid = threadIdx.x;
  bf16_t* raw = (bf16_t*)smem;
  bf16_t* outl = raw + 132 * 64;
  const bf16_t* XB = (const bf16_t*)(p.ws + WS_XBCR);
  bf16_t* XT = (bf16_t*)(p.ws + WS_XT); bf16_t* BT = (bf16_t*)(p.ws + WS_BT); bf16_t* BCM = (bf16_t*)(p.ws + WS_BCM);
  for (int item = blockIdx.x; item < 128 * 20; item += gridDim.x) {
    const int gc = item / 20, cgp = item % 20;
    int row0, s0, s1; chunk_rows(gc, row0, s0, s1);
    __syncthreads();
    for (int c = tid; c < 132 * 8; c += 256) {
      int t = c >> 3, c8 = c & 7, row = row0 - 2 + t;
      uint4 v = make_uint4(0, 0, 0, 0);
      if (row >= s0 && row < s1) v = *(const uint4*)(XB + (size_t)row * 1280 + cgp * 64 + c8 * 8);
      *(uint4*)(raw + t * 64 + c8 * 8) = v;
    }
    __syncthreads();
    {
      const int c = tid & 63, tg = tid >> 6, ch = cgp * 64 + c;
      float wv[5];
#pragma unroll
      for (int j = 0; j < 5; ++j) wv[j] = p.in[I_CONVW][j * 1280 + ch];
      const float bias = p.in[I_CONVB][ch];
      float x0 = bf2f(raw[(tg * 32 + 0) * 64 + c]), x1 = bf2f(raw[(tg * 32 + 1) * 64 + c]), x2 = bf2f(raw[(tg * 32 + 2) * 64 + c]), x3 = bf2f(raw[(tg * 32 + 3) * 64 + c]);
#pragma unroll 8
      for (int t = 0; t < 32; ++t) {
        int tt = tg * 32 + t;
        float x4 = bf2f(raw[(tt + 4) * 64 + c]);
        float o = bias + wv[0] * x0 + wv[1] * x1 + wv[2] * x2 + wv[3] * x3 + wv[4] * x4;
        outl[tt * 66 + c] = f2bf(silu_f(o));
        x0 = x1; x1 = x2; x2 = x3; x3 = x4;
      }
    }
    __syncthreads();
    if (cgp >= 16) {
      for (int c = tid; c < 1024; c += 256) {
        int tt = c >> 3, c8 = c & 7;
        const unsigned* s = (const unsigned*)(outl + tt * 66 + c8 * 8);
        *(uint4*)(BCM + (size_t)(row0 + tt) * 256 + (cgp - 16) * 64 + c8 * 8) = make_uint4(s[0], s[1], s[2], s[3]);
      }
    }
    if (cgp < 18) {
      for (int c = tid; c < 1024; c += 256) {
        int ch = c >> 4, t8 = c & 15;
        unsigned u[4];
#pragma unroll
        for (int e = 0; e < 4; ++e) u[e] = (unsigned)outl[(t8 * 8 + 2 * e) * 66 + ch] | ((unsigned)outl[(t8 * 8 + 2 * e + 1) * 66 + ch] << 16);
        bf16_t* dst = cgp < 16 ? XT + ((size_t)gc * 1024 + cgp * 64 + ch) * 128 + t8 * 8 : BT + ((size_t)gc * 128 + (cgp - 16) * 64 + ch) * 128 + t8 * 8;
        *(uint4*)dst = make_uint4(u[0], u[1], u[2], u[3]);
      }
    }
  }
}

DI float chunk_cums(const Params& p, int row0, int head, int dir, int lane, float* dtv, float* cumv, float* facv) {
  const float* DTP = (const float*)(p.ws + WS_DTP);
  const float a = -__expf(p.in[I_ALOG][dir * 16 + head]);
  float d0 = DTP[(size_t)(row0 + 2 * lane) * 32 + dir * 16 + head], d1 = DTP[(size_t)(row0 + 2 * lane + 1) * 32 + dir * 16 + head];
  float v0 = d0 * a, v1 = d1 * a, s = v0 + v1, sc = s;
#pragma unroll
  for (int o = 1; o < 64; o <<= 1) { float t = __shfl_up(sc, o); if (lane >= o) sc += t; }
  float total = __shfl(sc, 63);
  float e = sc - s, c0 = e + v0, c1 = e + s;
  if (facv) {
    dtv[dir * 128 + 2 * lane] = d0; dtv[dir * 128 + 2 * lane + 1] = d1;
    if (dir == 0) {
      cumv[2 * lane] = c0; cumv[2 * lane + 1] = c1;
      facv[2 * lane] = d0 * __expf(total - c0); facv[2 * lane + 1] = d1 * __expf(total - c1);
    } else {
      cumv[128 + 2 * lane] = total - c0 + v0; cumv[128 + 2 * lane + 1] = total - c1 + v1;
      facv[128 + 2 * lane] = d0 * __expf(c0 - v0); facv[128 + 2 * lane + 1] = d1 * __expf(c1 - v1);
    }
  } else {
    const float q0 = dir == 0 ? c0 : total - c0 + v0, q1 = dir == 0 ? c1 : total - c1 + v1;
    cumv[dir * 128 + 2 * lane] = q0 * LOG2E; cumv[dir * 128 + 2 * lane + 1] = q1 * LOG2E;
    dtv[dir * 128 + 2 * lane] = q0 * LOG2E - __log2f(d0); dtv[dir * 128 + 2 * lane + 1] = q1 * LOG2E - __log2f(d1);
  }
  return total;
}

DI void phase_ssd_states(const Params& p, unsigned char* smem) {
  const int tid = threadIdx.x, lane = tid & 63, w = tid >> 6, lc = lane & 15, g = lane >> 4;
  bf16_t* xf = (bf16_t*)smem;
  bf16_t* xb = xf + 64 * 136;
  bf16_t* bt = xb + 64 * 136;
  float* dtv = (float*)(bt + 64 * 136);
  float* cumv = dtv + 256;
  float* facv = cumv + 256;
  const bf16_t* XT = (const bf16_t*)(p.ws + WS_XT); const bf16_t* BT = (const bf16_t*)(p.ws + WS_BT);
  float* ST = (float*)(p.ws + WS_STATES); float* CD = (float*)(p.ws + WS_CDEC);
  for (int item = blockIdx.x; item < 2048; item += gridDim.x) {
    const int gc = item >> 4, head = item & 15, grp = head >> 3;
    int row0, s0, s1; chunk_rows(gc, row0, s0, s1);
    __syncthreads();
    if (w < 2) {
      float total = chunk_cums(p, row0, head, w, lane, dtv, cumv, facv);
      if (lane == 0) CD[(gc * 2 + w) * 16 + head] = __expf(total);
    }
    __syncthreads();
#pragma unroll
    for (int i = 0; i < 4; ++i) {
      int id = tid + 256 * i, r = id >> 4, c16 = id & 15;
      uint4 xv = *(const uint4*)(XT + ((size_t)gc * 1024 + head * 64 + r) * 128 + c16 * 8);
      uint4 bv = *(const uint4*)(BT + ((size_t)gc * 128 + grp * 64 + r) * 128 + c16 * 8);
      *(uint4*)(bt + r * 136 + c16 * 8) = bv;
      const float* ff = facv + c16 * 8; const float* fb = facv + 128 + c16 * 8;
      unsigned xs[4] = {xv.x, xv.y, xv.z, xv.w}, of[4], ob[4];
#pragma unroll
      for (int e = 0; e < 4; ++e) {
        float lo = bflo(xs[e]), hi = bfhi(xs[e]);
        of[e] = pack2(lo * ff[2 * e], hi * ff[2 * e + 1]); ob[e] = pack2(lo * fb[2 * e], hi * fb[2 * e + 1]);
      }
      *(uint4*)(xf + r * 136 + c16 * 8) = make_uint4(of[0], of[1], of[2], of[3]);
      *(uint4*)(xb + r * 136 + c16 * 8) = make_uint4(ob[0], ob[1], ob[2], ob[3]);
    }
    __syncthreads();
    f32x4 af[4], ab[4];
#pragma unroll
    for (int j = 0; j < 4; ++j) { af[j] = f32x4{0, 0, 0, 0}; ab[j] = f32x4{0, 0, 0, 0}; }
#pragma unroll
    for (int ks = 0; ks < 4; ++ks) {
      bf16x8 a_f = *(const bf16x8*)(xf + (w * 16 + lc) * 136 + ks * 32 + g * 8);
      bf16x8 a_b = *(const bf16x8*)(xb + (w * 16 + lc) * 136 + ks * 32 + g * 8);
#pragma unroll
      for (int j = 0; j < 4; ++j) {
        bf16x8 b = *(const bf16x8*)(bt + (j * 16 + lc) * 136 + ks * 32 + g * 8);
        af[j] = MFMA16(a_f, b, af[j]); ab[j] = MFMA16(a_b, b, ab[j]);
      }
    }
    bf16_t* o0 = (bf16_t*)ST + ((size_t)(gc * 2 + 0) * 16 + head) * 4096; bf16_t* o1 = (bf16_t*)ST + ((size_t)(gc * 2 + 1) * 16 + head) * 4096;
    const bool odd = lc & 1;
#pragma unroll
    for (int j = 0; j < 4; ++j) {
      const int n2 = j * 16 + (lc & ~1), pb = w * 16 + 4 * g + (odd ? 2 : 0);
      {
        const float y0 = __shfl_xor(odd ? af[j][0] : af[j][2], 1), y1 = __shfl_xor(odd ? af[j][1] : af[j][3], 1);
        const unsigned u0 = odd ? pack2(y0, af[j][2]) : pack2(af[j][0], y0), u1 = odd ? pack2(y1, af[j][3]) : pack2(af[j][1], y1);
        *(unsigned*)(o0 + (pb + 0) * 64 + n2) = u0; *(unsigned*)(o0 + (pb + 1) * 64 + n2) = u1;
      }
      {
        const float y0 = __shfl_xor(odd ? ab[j][0] : ab[j][2], 1), y1 = __shfl_xor(odd ? ab[j][1] : ab[j][3], 1);
        const unsigned u0 = odd ? pack2(y0, ab[j][2]) : pack2(ab[j][0], y0), u1 = odd ? pack2(y1, ab[j][3]) : pack2(ab[j][1], y1);
        *(unsigned*)(o1 + (pb + 0) * 64 + n2) = u0; *(unsigned*)(o1 + (pb + 1) * 64 + n2) = u1;
      }
    }
  }
}

struct AttnArgs {
  const bf16_t* q; int ldq;
  const bf16_t* k; int ldk;
  const bf16_t* kpe;
  const bf16_t* vt; int vt_heads, vhead;
  const bf16_t* gate; int ldg;
  bf16_t* out; int ldo;
  int qrow0, qpos0;
  int seg0_row, seg0_n, seg0_pos, band;
  int seg1_row, seg1_n;
  float sink2; int has_sink; float scale2;
};
using f32x16 = __attribute__((ext_vector_type(16))) float;
#define MFMA32(a, b, c) __builtin_amdgcn_mfma_f32_32x32x16_bf16((a), (b), (c), 0, 0, 0)
template <int DK, bool MLA>
DI void attn_item(const AttnArgs& a, unsigned char* smem, bool dost = true) {
  constexpr int KS = DK / 16, KSTR = DK + 8, KCH = DK / 8, VSTR = 68;
  const int tid = threadIdx.x, lane = tid & 63, w = tid >> 6, r32 = lane & 31, h = lane >> 5;
  bf16_t* sK = (bf16_t*)smem;
  bf16_t* sV = sK + 64 * KSTR;
  bf16x8 qf[KS];
#pragma unroll
  for (int ks = 0; ks < KS; ++ks) qf[ks] = *(const bf16x8*)(a.q + (size_t)(a.qrow0 + w * 32 + r32) * a.ldq + ks * 16 + h * 8);
  f32x16 O[2], L;
#pragma unroll
  for (int i = 0; i < 16; ++i) { O[0][i] = 0.f; O[1][i] = 0.f; L[i] = a.has_sink ? 1.f : 0.f; }
  float mrow = a.has_sink ? a.sink2 : -1e30f;
  const bf16x8 ones = mk8(0x3F803F80u, 0x3F803F80u, 0x3F803F80u, 0x3F803F80u);
  const int ntiles = (a.seg0_n + a.seg1_n) >> 6;
  const int qpos = a.qpos0 + w * 32 + r32;
  uint4 pk0, pk1, pk2, pv0, pv1;
#define KR(i) ((tid + 256 * (i)) / KCH)
#define KQ(i) ((tid + 256 * (i)) % KCH)
#define KSRC(i, krow) ((!MLA || KQ(i) < 8) ? a.k + (size_t)((krow) + KR(i)) * a.ldk + KQ(i) * 8 : a.kpe + (size_t)((krow) + KR(i)) * 32 + (KQ(i) - 8) * 8)
  const int vr = tid >> 3, vq = tid & 7;
#define ATT_LOAD(t_) do { const int kk0_ = (t_) * 64; const int krow_ = kk0_ < a.seg0_n ? a.seg0_row + kk0_ : a.seg1_row + kk0_ - a.seg0_n; \
    pk0 = *(const uint4*)KSRC(0, krow_); pk1 = *(const uint4*)KSRC(1, krow_); if (MLA) pk2 = *(const uint4*)KSRC(2, krow_); \
    const bf16_t* vsrc_ = a.vt + ((size_t)(krow_ >> 6) * a.vt_heads + a.vhead) * 4096; \
    pv0 = *(const uint4*)(vsrc_ + vr * 64 + vq * 8); pv1 = *(const uint4*)(vsrc_ + (vr + 32) * 64 + vq * 8); } while (0)
  ATT_LOAD(0);
  for (int t = 0; t < ntiles; ++t) {
    const int kk0 = t * 64; const bool loc = kk0 < a.seg0_n;
    __syncthreads();
    *(uint4*)(sK + KR(0) * KSTR + KQ(0) * 8) = pk0; *(uint4*)(sK + KR(1) * KSTR + KQ(1) * 8) = pk1; if (MLA) *(uint4*)(sK + KR(2) * KSTR + KQ(2) * 8) = pk2;
    *(uint2*)(sV + vr * VSTR + vq * 8) = make_uint2(pv0.x, pv0.y); *(uint2*)(sV + vr * VSTR + vq * 8 + 4) = make_uint2(pv0.z, pv0.w);
    *(uint2*)(sV + (vr + 32) * VSTR + vq * 8) = make_uint2(pv1.x, pv1.y); *(uint2*)(sV + (vr + 32) * VSTR + vq * 8 + 4) = make_uint2(pv1.z, pv1.w);
    __syncthreads();
    if (t + 1 < ntiles) ATT_LOAD(t + 1);
    f32x16 S[2];
#pragma unroll
    for (int i = 0; i < 16; ++i) { S[0][i] = 0.f; S[1][i] = 0.f; }
#pragma unroll
    for (int ks = 0; ks < KS; ++ks)
#pragma unroll
      for (int kt = 0; kt < 2; ++kt) {
        bf16x8 kf = *(const bf16x8*)(sK + (kt * 32 + r32) * KSTR + ks * 16 + h * 8);
        S[kt] = MFMA32(kf, qf[ks], S[kt]);
      }
    const bool msk = a.band && loc;
    float m = -1e30f;
#pragma unroll
    for (int kt = 0; kt < 2; ++kt)
#pragma unroll
      for (int ri = 0; ri < 16; ++ri) {
        float v = S[kt][ri];
        if (msk) { int dlt = a.seg0_pos + kk0 + kt * 32 + (ri & 3) + 8 * (ri >> 2) + 4 * h - qpos; if (dlt > 128 || dlt < -128) v = -1e30f; S[kt][ri] = v; }
        m = fmaxf(m, v);
      }
    m = fmaxf(m, __shfl_xor(m, 32));
    if (__builtin_amdgcn_ballot_w64(m > mrow + 8.f) != 0ull) {
      const float mnew = fmaxf(mrow, m), alpha = ex2(mrow - mnew);
      mrow = mnew;
#pragma unroll
      for (int i = 0; i < 16; ++i) { O[0][i] *= alpha; O[1][i] *= alpha; L[i] *= alpha; }
    }
#pragma unroll
    for (int kt = 0; kt < 2; ++kt)
#pragma unroll
      for (int s2 = 0; s2 < 2; ++s2) {
        const bf16x8 pf = mk8(pack2(ex2(S[kt][8 * s2 + 0] - mrow), ex2(S[kt][8 * s2 + 1] - mrow)), pack2(ex2(S[kt][8 * s2 + 2] - mrow), ex2(S[kt][8 * s2 + 3] - mrow)),
                              pack2(ex2(S[kt][8 * s2 + 4] - mrow), ex2(S[kt][8 * s2 + 5] - mrow)), pack2(ex2(S[kt][8 * s2 + 6] - mrow), ex2(S[kt][8 * s2 + 7] - mrow)));
        L = MFMA32(ones, pf, L);
#pragma unroll
        for (int dt = 0; dt < 2; ++dt) {
          const bf16_t* vp = sV + (dt * 32 + r32) * VSTR + kt * 32 + 16 * s2 + 4 * h;
          const uint2 lo = *(const uint2*)vp, hi = *(const uint2*)(vp + 8);
          O[dt] = MFMA32(mk8(lo.x, lo.y, hi.x, hi.y), pf, O[dt]);
        }
      }
  }
#undef KR
#undef KQ
#undef KSRC
#undef ATT_LOAD
  {
    const float inv = 1.f / L[0];
    const size_t row = (size_t)(a.qrow0 + w * 32 + r32);
#pragma unroll
    for (int dt = 0; dt < 2; ++dt)
#pragma unroll
      for (int gq = 0; gq < 4; ++gq) {
        const int d0 = dt * 32 + 8 * gq + 4 * h;
        const uint2 gt = *(const uint2*)(a.gate + row * a.ldg + d0);
        const float o0 = O[dt][4 * gq + 0] * inv * bflo(gt.x), o1 = O[dt][4 * gq + 1] * inv * bfhi(gt.x), o2 = O[dt][4 * gq + 2] * inv * bflo(gt.y), o3 = O[dt][4 * gq + 3] * inv * bfhi(gt.y);
        if (dost) *(uint2*)(a.out + row * a.ldo + d0) = make_uint2(pack2(o0, o1), pack2(o2, o3));
      }
  }
}

template <int DK, bool MLA>
DI void attn_item2(const AttnArgs& a, unsigned char* smem) {
  constexpr int KS = DK / 16, KSTR = DK + 8, KCH = DK / 8, VSTR = 68;
  const int tid = threadIdx.x, lane = tid & 63, w = tid >> 6, r32 = lane & 31, h = lane >> 5;
  bf16_t* sK = (bf16_t*)smem;
  bf16_t* sV = sK + 64 * KSTR;
  bf16_t* sQ = sV + 64 * VSTR;
  __syncthreads();
  for (int c = tid; c < 256 * KCH; c += 256) { const int r = c / KCH, cc = c % KCH; *(uint4*)(sQ + r * KSTR + cc * 8) = *(const uint4*)(a.q + (size_t)(a.qrow0 + r) * a.ldq + cc * 8); }
  const bf16_t* sQw = sQ + (w * 64 + r32) * KSTR + h * 8;
  f32x16 O[2][2];
#pragma unroll
  for (int i = 0; i < 16; ++i) { O[0][0][i] = 0.f; O[0][1][i] = 0.f; O[1][0][i] = 0.f; O[1][1][i] = 0.f; }
  float mrow[2], lsum[2];
  mrow[0] = mrow[1] = a.has_sink ? a.sink2 : -1e30f;
  lsum[0] = lsum[1] = (a.has_sink && h == 0) ? 1.f : 0.f;
  const int ntiles = (a.seg0_n + a.seg1_n) >> 6;
  uint4 pk0, pk1, pk2, pv0, pv1;
#define KR(i) ((tid + 256 * (i)) / KCH)
#define KQ(i) ((tid + 256 * (i)) % KCH)
#define KSRC(i, krow) ((!MLA || KQ(i) < 8) ? a.k + (size_t)((krow) + KR(i)) * a.ldk + KQ(i) * 8 : a.kpe + (size_t)((krow) + KR(i)) * 32 + (KQ(i) - 8) * 8)
  const int vr = tid >> 3, vq = tid & 7;
#define ATT_LOAD(t_) do { const int kk0_ = (t_) * 64; const int krow_ = kk0_ < a.seg0_n ? a.seg0_row + kk0_ : a.seg1_row + kk0_ - a.seg0_n; \
    pk0 = *(const uint4*)KSRC(0, krow_); pk1 = *(const uint4*)KSRC(1, krow_); if (MLA) pk2 = *(const uint4*)KSRC(2, krow_); \
    const bf16_t* vsrc_ = a.vt + ((size_t)(krow_ >> 6) * a.vt_heads + a.vhead) * 4096; \
    pv0 = *(const uint4*)(vsrc_ + vr * 64 + vq * 8); pv1 = *(const uint4*)(vsrc_ + (vr + 32) * 64 + vq * 8); } while (0)
  ATT_LOAD(0);
  for (int t = 0; t < ntiles; ++t) {
    __syncthreads();
    *(uint4*)(sK + KR(0) * KSTR + KQ(0) * 8) = pk0; *(uint4*)(sK + KR(1) * KSTR + KQ(1) * 8) = pk1; if (MLA) *(uint4*)(sK + KR(2) * KSTR + KQ(2) * 8) = pk2;
    *(uint2*)(sV + vr * VSTR + vq * 8) = make_uint2(pv0.x, pv0.y); *(uint2*)(sV + vr * VSTR + vq * 8 + 4) = make_uint2(pv0.z, pv0.w);
    *(uint2*)(sV + (vr + 32) * VSTR + vq * 8) = make_uint2(pv1.x, pv1.y); *(uint2*)(sV + (vr + 32) * VSTR + vq * 8 + 4) = make_uint2(pv1.z, pv1.w);
    __syncthreads();
    if (t + 1 < ntiles) ATT_LOAD(t + 1);
    f32x16 S[2][2];
#pragma unroll
    for (int i = 0; i < 16; ++i) { S[0][0][i] = 0.f; S[0][1][i] = 0.f; S[1][0][i] = 0.f; S[1][1][i] = 0.f; }
#pragma unroll
    for (int ks = 0; ks < KS; ++ks)
#pragma unroll
      for (int kt = 0; kt < 2; ++kt) {
        bf16x8 kf = *(const bf16x8*)(sK + (kt * 32 + r32) * KSTR + ks * 16 + h * 8);
        const bf16x8 q0 = *(const bf16x8*)(sQw + ks * 16), q1 = *(const bf16x8*)(sQw + 32 * KSTR + ks * 16);
        S[0][kt] = MFMA32(kf, q0, S[0][kt]); S[1][kt] = MFMA32(kf, q1, S[1][kt]);
      }
    float mx[2];
#pragma unroll
    for (int gq = 0; gq < 2; ++gq) {
      float m = -1e30f;
#pragma unroll
      for (int kt = 0; kt < 2; ++kt)
#pragma unroll
        for (int ri = 0; ri < 16; ++ri) m = fmaxf(m, S[gq][kt][ri]);
      mx[gq] = fmaxf(m, __shfl_xor(m, 32));
    }
    if (__builtin_amdgcn_ballot_w64((mx[0] > mrow[0] + 8.f) || (mx[1] > mrow[1] + 8.f)) != 0ull) {
#pragma unroll
      for (int gq = 0; gq < 2; ++gq) {
        const float mnew = fmaxf(mrow[gq], mx[gq]), alpha = ex2(mrow[gq] - mnew);
        mrow[gq] = mnew; lsum[gq] *= alpha;
#pragma unroll
        for (int i = 0; i < 16; ++i) { O[gq][0][i] *= alpha; O[gq][1][i] *= alpha; }
      }
    }
#pragma unroll
    for (int kt = 0; kt < 2; ++kt)
#pragma unroll
      for (int s2 = 0; s2 < 2; ++s2) {
        bf16x8 pf[2];
#pragma unroll
        for (int gq = 0; gq < 2; ++gq) {
          float e[8];
#pragma unroll
          for (int j = 0; j < 8; ++j) e[j] = ex2(S[gq][kt][8 * s2 + j] - mrow[gq]);
          lsum[gq] += ((e[0] + e[1]) + (e[2] + e[3])) + ((e[4] + e[5]) + (e[6] + e[7]));
          pf[gq] = mk8(pack2(e[0], e[1]), pack2(e[2], e[3]), pack2(e[4], e[5]), pack2(e[6], e[7]));
        }
#pragma unroll
        for (int dt = 0; dt < 2; ++dt) {
          const bf16_t* vp = sV + (dt * 32 + r32) * VSTR + kt * 32 + 16 * s2 + 4 * h;
          const uint2 lo = *(const uint2*)vp, hi = *(const uint2*)(vp + 8);
          const bf16x8 vf = mk8(lo.x, lo.y, hi.x, hi.y);
          O[0][dt] = MFMA32(vf, pf[0], O[0][dt]); O[1][dt] = MFMA32(vf, pf[1], O[1][dt]);
        }
      }
  }
#undef KR
#undef KQ
#undef KSRC
#undef ATT_LOAD
#pragma unroll
  for (int gq = 0; gq < 2; ++gq) {
    const float l = lsum[gq] + __shfl_xor(lsum[gq], 32);
    const float inv = 1.f / l;
    const size_t row = (size_t)(a.qrow0 + w * 64 + gq * 32 + r32);
#pragma unroll
    for (int dt = 0; dt < 2; ++dt)
#pragma unroll
      for (int g4 = 0; g4 < 4; ++g4) {
        const int d0 = dt * 32 + 8 * g4 + 4 * h;
        const uint2 gt = *(const uint2*)(a.gate + row * a.ldg + d0);
        const float o0 = O[gq][dt][4 * g4 + 0] * inv * bflo(gt.x), o1 = O[gq][dt][4 * g4 + 1] * inv * bfhi(gt.x), o2 = O[gq][dt][4 * g4 + 2] * inv * bflo(gt.y), o3 = O[gq][dt][4 * g4 + 3] * inv * bfhi(gt.y);
        *(uint2*)(a.out + row * a.ldo + d0) = make_uint2(pack2(o0, o1), pack2(o2, o3));
      }
  }
}

DI void scan_item(const Params& p, int it, bool latent, bool dost = true) {
  const int tid = threadIdx.x;
  const int quarter = it & 3, head = (it >> 2) & 15, dir = (it >> 6) & 1, b = it >> 7;
  const int e = quarter * 1024 + tid * 4;
  const float* ST = (const float*)(p.ws + WS_STATES); const float* CD = (const float*)(p.ws + WS_CDEC);
  bf16_t* HIN = (bf16_t*)(p.ws + WS_HIN);
  float4 h = make_float4(0.f, 0.f, 0.f, 0.f);
  const int nc = latent ? 32 : 2, gc0 = latent ? 64 + b * 32 : b * 2;
  if (latent) h = *(const float4*)((dir == 0 ? p.in[I_SF] : p.in[I_SB]) + ((size_t)b * 16 + head) * 4096 + e);
  if (latent) {
    for (int s0 = 0; s0 < 32; s0 += 8) {
      float4 st[8]; float dec[8];
#pragma unroll
      for (int u = 0; u < 8; ++u) {
        const int c = dir == 0 ? s0 + u : 31 - s0 - u;
        const size_t base = ((size_t)((gc0 + c) * 2 + dir) * 16 + head);
        dec[u] = CD[base]; { const uint2 q2 = *(const uint2*)((const bf16_t*)ST + base * 4096 + e); st[u] = make_float4(bflo(q2.x), bfhi(q2.x), bflo(q2.y), bfhi(q2.y)); }
      }
#pragma unroll
      for (int u = 0; u < 8; ++u) {
        const int c = dir == 0 ? s0 + u : 31 - s0 - u;
        const size_t base = ((size_t)((gc0 + c) * 2 + dir) * 16 + head);
        if (dost) *(uint2*)(HIN + base * 4096 + e) = make_uint2(pack2(h.x, h.y), pack2(h.z, h.w));
        h.x = h.x * dec[u] + st[u].x; h.y = h.y * dec[u] + st[u].y; h.z = h.z * dec[u] + st[u].z; h.w = h.w * dec[u] + st[u].w;
      }
    }
  }
}
DI void scan_ctx_item(const Params& p, int it, bool dost = true) {
  const int tid = threadIdx.x;
  const int head = it & 15, dir = (it >> 4) & 1, b = it >> 5;
  const float* ST = (const float*)(p.ws + WS_STATES); const float* CD = (const float*)(p.ws + WS_CDEC);
  bf16_t* HIN = (bf16_t*)(p.ws + WS_HIN);
  const int c0 = dir == 0 ? 0 : 1, c1 = 1 - c0;
  const size_t b0 = ((size_t)((b * 2 + c0) * 2 + dir) * 16 + head), b1 = ((size_t)((b * 2 + c1) * 2 + dir) * 16 + head);
  const float dec1 = CD[b1];
  float4 s0[4], s1[4];
#pragma unroll
  for (int qq = 0; qq < 4; ++qq) { const int e = qq * 1024 + tid * 4; const uint2 q0 = *(const uint2*)((const bf16_t*)ST + b0 * 4096 + e), q1 = *(const uint2*)((const bf16_t*)ST + b1 * 4096 + e);
    s0[qq] = make_float4(bflo(q0.x), bfhi(q0.x), bflo(q0.y), bfhi(q0.y)); s1[qq] = make_float4(bflo(q1.x), bfhi(q1.x), bflo(q1.y), bfhi(q1.y)); }
#pragma unroll
  for (int qq = 0; qq < 4; ++qq) {
    const int e = qq * 1024 + tid * 4;
    if (dost) {
      *(uint2*)(HIN + b0 * 4096 + e) = make_uint2(0u, 0u);
      *(uint2*)(HIN + b1 * 4096 + e) = make_uint2(pack2(s0[qq].x, s0[qq].y), pack2(s0[qq].z, s0[qq].w));
    }
    *(float4*)(p.out + (dir == 0 ? O_SF : O_SB) + ((size_t)b * 16 + head) * 4096 + e) =
        make_float4(s0[qq].x * dec1 + s1[qq].x, s0[qq].y * dec1 + s1[qq].y, s0[qq].z * dec1 + s1[qq].z, s0[qq].w * dec1 + s1[qq].w);
  }
}
DI void attn_a_item(const Params& p, int it, bool latent, unsigned char* smem, bool dost = true) {
  AttnArgs a;
  const int qb = latent ? (it & 31) : (it & 1), head = latent ? ((it >> 5) & 7) : ((it >> 1) & 7), b = latent ? (it >> 8) : (it >> 4);
  const int kvh = head >> 2;
  const int seqrow = latent ? NCTX + b * 4096 : b * 256;
  a.q = (const bf16_t*)(p.ws + WS_QA) + head * 64; a.ldq = 512;
  a.k = (const bf16_t*)(p.ws + WS_KA) + kvh * 64; a.ldk = 128; a.kpe = nullptr;
  a.vt = (const bf16_t*)(p.ws + WS_VTA); a.vt_heads = 2; a.vhead = kvh;
  a.gate = (const bf16_t*)(p.ws + WS_GA) + head * 64; a.ldg = 512;
  a.out = (bf16_t*)(p.ws + WS_QA) + head * 64; a.ldo = 512;
  a.qrow0 = seqrow + qb * 128; a.qpos0 = qb * 128;
  if (latent) {
    int klo = qb * 128 - 128; if (klo < 0) klo = 0; int khi = qb * 128 + 256; if (khi > 4096) khi = 4096;
    a.seg0_row = seqrow + klo; a.seg0_n = khi - klo; a.seg0_pos = klo; a.band = 1;
    a.seg1_row = NTOK + b * 256; a.seg1_n = 256;
  } else {
    a.seg0_row = seqrow; a.seg0_n = 256; a.seg0_pos = 0; a.band = 0; a.seg1_row = 0; a.seg1_n = 0;
  }
  a.sink2 = p.in[I_SINK][head] * LOG2E; a.has_sink = 1; a.scale2 = 0.125f * LOG2E;
  attn_item<64, false>(a, smem, dost);
}
DI void phase_scan_attn_a(const Params& p, unsigned char* smem, bool dost = true) {
  for (int item = blockIdx.x; item < 2304; item += gridDim.x) {
    if (item < 512) attn_a_item(p, item, true, smem, dost);
    else if (item < 768) scan_item(p, item - 512, true, dost);
    else if (item < 1280) attn_a_item(p, item - 768, false, smem, dost);
    else scan_ctx_item(p, item - 1280, dost);
  }
}

DI void phase_ssd_out(const Params& p, unsigned char* smem, bool dost = true) {
  const int tid = threadIdx.x, lane = tid & 63, w = tid >> 6, lc = lane & 15, g = lane >> 4;
  bf16_t* sB = (bf16_t*)smem;
  bf16_t* sC = sB + 128 * 72;
  bf16_t* sX = sC + 128 * 72;
  bf16_t* sHf = sX + 64 * 136;
  bf16_t* sHb = sHf + 64 * 72;
  float* dtv = (float*)(sHb + 64 * 72);
  float* cumv = dtv + 256;
  const bf16_t* XT = (const bf16_t*)(p.ws + WS_XT); const bf16_t* BCM = (const bf16_t*)(p.ws + WS_BCM); const bf16_t* HIN = (const bf16_t*)(p.ws + WS_HIN);
  bf16_t* ZS = (bf16_t*)(p.ws + WS_ZS); float* SSQ = (float*)(p.ws + WS_SSQ);
  for (int item = blockIdx.x; item < 2048; item += gridDim.x) {
    const int gc = item >> 4, head = item & 15, grp = head >> 3;
    int row0, s0, s1; chunk_rows(gc, row0, s0, s1);
    __syncthreads();
    if (w < 2) chunk_cums(p, row0, head, w, lane, dtv, cumv, nullptr);
#pragma unroll
    for (int i = 0; i < 4; ++i) {
      int id = tid + 256 * i;
      { int r = id >> 3, c8 = id & 7;
        *(uint4*)(sB + r * 72 + c8 * 8) = *(const uint4*)(BCM + (size_t)(row0 + r) * 256 + grp * 64 + c8 * 8);
        *(uint4*)(sC + r * 72 + c8 * 8) = *(const uint4*)(BCM + (size_t)(row0 + r) * 256 + 128 + grp * 64 + c8 * 8); }
      { int r = id >> 4, c16 = id & 15; *(uint4*)(sX + r * 136 + c16 * 8) = *(const uint4*)(XT + ((size_t)gc * 1024 + head * 64 + r) * 128 + c16 * 8); }
    }
#pragma unroll
    for (int i = 0; i < 2; ++i) {
      int id = tid + 256 * i, r = id >> 3, c8 = id & 7;
      *(uint4*)(sHf + r * 72 + c8 * 8) = *(const uint4*)(HIN + ((size_t)(gc * 2 + 0) * 16 + head) * 4096 + r * 64 + c8 * 8);
      *(uint4*)(sHb + r * 72 + c8 * 8) = *(const uint4*)(HIN + ((size_t)(gc * 2 + 1) * 16 + head) * 4096 + r * 64 + c8 * 8);
    }
    __syncthreads();
    bf16x8 cf[2][2];
#pragma unroll
    for (int lt = 0; lt < 2; ++lt)
#pragma unroll
      for (int ks = 0; ks < 2; ++ks) cf[lt][ks] = *(const bf16x8*)(sC + (w * 32 + lt * 16 + lc) * 72 + ks * 32 + g * 8);
    float cfl[2], crl[2];
#pragma unroll
    for (int lt = 0; lt < 2; ++lt) { cfl[lt] = cumv[w * 32 + lt * 16 + lc]; crl[lt] = cumv[128 + w * 32 + lt * 16 + lc]; }
    f32x4 Y[4][2], T[4][2];
#pragma unroll
    for (int pt = 0; pt < 4; ++pt) { T[pt][0] = f32x4{0, 0, 0, 0}; T[pt][1] = f32x4{0, 0, 0, 0}; }
#pragma unroll
    for (int ks = 0; ks < 2; ++ks)
#pragma unroll
      for (int pt = 0; pt < 4; ++pt) {
        bf16x8 hf = *(const bf16x8*)(sHf + (pt * 16 + lc) * 72 + ks * 32 + g * 8);
        T[pt][0] = MFMA16(hf, cf[0][ks], T[pt][0]); T[pt][1] = MFMA16(hf, cf[1][ks], T[pt][1]);
      }
    {
      float e0 = ex2(cfl[0]), e1 = ex2(cfl[1]);
#pragma unroll
      for (int pt = 0; pt < 4; ++pt) { Y[pt][0] = T[pt][0] * e0; Y[pt][1] = T[pt][1] * e1; }
    }
#pragma unroll
    for (int pt = 0; pt < 4; ++pt) { T[pt][0] = f32x4{0, 0, 0, 0}; T[pt][1] = f32x4{0, 0, 0, 0}; }
#pragma unroll
    for (int ks = 0; ks < 2; ++ks)
#pragma unroll
      for (int pt = 0; pt < 4; ++pt) {
        bf16x8 hb = *(const bf16x8*)(sHb + (pt * 16 + lc) * 72 + ks * 32 + g * 8);
        T[pt][0] = MFMA16(hb, cf[0][ks], T[pt][0]); T[pt][1] = MFMA16(hb, cf[1][ks], T[pt][1]);
      }
    {
      float e0 = ex2(crl[0]), e1 = ex2(crl[1]);
#pragma unroll
      for (int pt = 0; pt < 4; ++pt) { Y[pt][0] += T[pt][0] * e0; Y[pt][1] += T[pt][1] * e1; }
    }
    const float dskip = p.in[I_DSKIP][head];
#pragma unroll
    for (int sb = 0; sb < 2; ++sb) {
      f32x4 S[4][2];
#pragma unroll
      for (int st = 0; st < 4; ++st) { S[st][0] = f32x4{0, 0, 0, 0}; S[st][1] = f32x4{0, 0, 0, 0}; }
#pragma unroll
      for (int ks = 0; ks < 2; ++ks)
#pragma unroll
        for (int st = 0; st < 4; ++st) {
          bf16x8 bf = *(const bf16x8*)(sB + (sb * 64 + st * 16 + lc) * 72 + ks * 32 + g * 8);
          S[st][0] = MFMA16(bf, cf[0][ks], S[st][0]); S[st][1] = MFMA16(bf, cf[1][ks], S[st][1]);
        }
#pragma unroll
      for (int st = 0; st < 4; ++st) {
        const int sbase = sb * 64 + st * 16 + 4 * g;
        const f32x4 rfs = *(const f32x4*)(dtv + sbase), rbs = *(const f32x4*)(dtv + 128 + sbase);
#pragma unroll
        for (int lt = 0; lt < 2; ++lt) {
          int l = w * 32 + lt * 16 + lc;
          asm volatile("" : "+v"(l));
#pragma unroll
          for (int r = 0; r < 4; ++r) {
            const int s = sbase + r;
            const float af = s <= l ? cfl[lt] - rfs[r] : -1e30f, ab = s >= l ? crl[lt] - rbs[r] : -1e30f;
            S[st][lt][r] = S[st][lt][r] * (ex2(af) + ex2(ab)) + (s == l ? dskip : 0.f);
          }
        }
      }
      bf16x8 pf[2][2];
#pragma unroll
      for (int lt = 0; lt < 2; ++lt)
#pragma unroll
        for (int k2 = 0; k2 < 2; ++k2)
          pf[lt][k2] = mk8(pack2(S[2 * k2][lt][0], S[2 * k2][lt][1]), pack2(S[2 * k2][lt][2], S[2 * k2][lt][3]),
                           pack2(S[2 * k2 + 1][lt][0], S[2 * k2 + 1][lt][1]), pack2(S[2 * k2 + 1][lt][2], S[2 * k2 + 1][lt][3]));
#pragma unroll
      for (int pt = 0; pt < 4; ++pt)
#pragma unroll
        for (int k2 = 0; k2 < 2; ++k2) {
          uint2 lo = *(const uint2*)(sX + (pt * 16 + lc) * 136 + sb * 64 + k2 * 32 + 4 * g);
          uint2 hi = *(const uint2*)(sX + (pt * 16 + lc) * 136 + sb * 64 + k2 * 32 + 16 + 4 * g);
          bf16x8 xf = mk8(lo.x, lo.y, hi.x, hi.y);
          Y[pt][0] = MFMA16(xf, pf[0][k2], Y[pt][0]); Y[pt][1] = MFMA16(xf, pf[1][k2], Y[pt][1]);
        }
    }
#pragma unroll
    for (int lt = 0; lt < 2; ++lt) {
      const size_t row = (size_t)(row0 + w * 32 + lt * 16 + lc);
      float ss = 0.f;
#pragma unroll
      for (int pt = 0; pt < 4; ++pt) {
        bf16_t* zp = ZS + row * 1024 + head * 64 + pt * 16 + 4 * g;
        uint2 z = *(const uint2*)zp;
        float o0 = Y[pt][lt][0] * bflo(z.x), o1 = Y[pt][lt][1] * bfhi(z.x), o2 = Y[pt][lt][2] * bflo(z.y), o3 = Y[pt][lt][3] * bfhi(z.y);
        ss += o0 * o0 + o1 * o1 + o2 * o2 + o3 * o3;
        if (dost) *(uint2*)zp = make_uint2(pack2(o0, o1), pack2(o2, o3));
      }
      ss += __shfl_xor(ss, 16); ss += __shfl_xor(ss, 32);
      if (g == 0 && dost) SSQ[row * 16 + head] = ss;
    }
  }
}

DI void resid_epilogue(const Params& p, f32x4 (&acc)[4][4], int layer, int m0, int n0, unsigned char* smem) {
  const int tid = threadIdx.x, lane = tid & 63, w = tid >> 6, wm = w >> 1, wn = w & 1;
  const int cond = cond_of(m0);
  const float* wb = stage_wave_tile(acc, smem);
  const int c4 = (lane & 15) * 4, colb = n0 + wn * 64 + c4;
  const float4 gt = *(const float4*)((const float*)(p.ws + WS_MODP) + (layer * 3 + cond) * 3072 + 2048 + colb);
  bf16_t* X1B = (bf16_t*)(p.ws + WS_X1B);
#pragma unroll 4
  for (int it = 0; it < 16; ++it) {
    const int rl = it * 4 + (lane >> 4), row = m0 + wm * 64 + rl;
    const float4 av = *(const float4*)(wb + rl * 68 + c4);
    if (layer == 0) {
      const float* xr = row < NCTX ? p.in[I_XP] + (size_t)row * 1024 : p.in[I_XS] + (size_t)(row - NCTX) * 1024;
      const float4 xv = *(const float4*)(xr + colb);
      *(uint2*)(X1B + (size_t)row * 1024 + colb) = pk4(make_float4(xv.x + gt.x * av.x, xv.y + gt.y * av.y, xv.z + gt.z * av.z, xv.w + gt.w * av.w));
    } else {
      const uint2 xb = *(const uint2*)(X1B + (size_t)row * 1024 + colb);
      const float4 v = make_float4(bflo(xb.x) + gt.x * av.x, bfhi(xb.x) + gt.y * av.y, bflo(xb.y) + gt.z * av.z, bfhi(xb.y) + gt.w * av.w);
      *(uint2*)((bf16_t*)(p.ws + WS_X2B) + (size_t)row * 1024 + colb) = pk4(v);
      float ss = v.x * v.x + v.y * v.y + v.z * v.z + v.w * v.w;
      ss += __shfl_xor(ss, 8); ss += __shfl_xor(ss, 4); ss += __shfl_xor(ss, 2); ss += __shfl_xor(ss, 1);
      if ((lane & 15) == 0) __hip_atomic_fetch_add((float*)(p.ws + WS_ROWSQ) + row, ss, __ATOMIC_RELAXED, __HIP_MEMORY_SCOPE_AGENT);
    }
  }
}
DI void phase_ab_out(const Params& p, unsigned char* smem) {
  const int tid = threadIdx.x, lane = tid & 63, w = tid >> 6, wm = w >> 1, g = lane >> 4;
  float* srs = (float*)(smem + 65536);
  const float* SSQ = (const float*)(p.ws + WS_SSQ);
  const bf16_t* W = (const bf16_t*)(p.ws + W_ABOUT);
  for (int tile = blockIdx.x; tile < 128 * 8; tile += gridDim.x) {
    int mt, nt; xcd_tile(tile, 8, mt, nt); const int m0 = mt * 128, n0 = nt * 128;
    __syncthreads();
    if (tid < 128) {
      const float4* s = (const float4*)(SSQ + (size_t)(m0 + tid) * 16);
      float4 a = s[0], b = s[1], c = s[2], d = s[3];
      float t = a.x + a.y + a.z + a.w + b.x + b.y + b.z + b.w + c.x + c.y + c.z + c.w + d.x + d.y + d.z + d.w;
      srs[tid] = rsqrtf(t * (1.f / 1024.f) + EPS);
    }
    f32x4 acc[4][4]; acc_zero(acc);
    gemm_mainloop(acc, (const bf16_t*)(p.ws + WS_ZS), 1024, W + 512, 1536, 1024, m0, n0, smem);
#pragma unroll
    for (int i = 0; i < 4; ++i)
#pragma unroll
      for (int r = 0; r < 4; ++r) {
        float rs = srs[wm * 64 + i * 16 + 4 * g + r];
#pragma unroll
        for (int j = 0; j < 4; ++j) acc[i][j][r] *= rs;
      }
    gemm_mainloop(acc, (const bf16_t*)(p.ws + WS_QA), 512, W, 1536, 512, m0, n0, smem);
    resid_epilogue(p, acc, 0, m0, n0, smem);
  }
}
DI void phase_mla_out(const Params& p, unsigned char* smem) {
  for (int tile = blockIdx.x; tile < 128 * 8; tile += gridDim.x) {
    int mt, nt; xcd_tile(tile, 8, mt, nt); const int m0 = mt * 128, n0 = nt * 128;
    f32x4 acc[4][4]; acc_zero(acc);
    gemm_mainloop(acc, (const bf16_t*)(p.ws + WS_AOM), 1024, (const bf16_t*)(p.ws + W_MOUT), 1024, 1024, m0, n0, smem);
    resid_epilogue(p, acc, 1, m0, n0, smem);
  }
}

DI void phase_mla_in(const Params& p, unsigned char* smem) {
  const int tid = threadIdx.x, lane = tid & 63, w = tid >> 6, wm = w >> 1, wn = w & 1, lc = lane & 15, g = lane >> 4;
  bf16_t* GM = (bf16_t*)(p.ws + WS_GM);
  constexpr int NT = MIN_N / 128;
  for (int tile = blockIdx.x; tile < 128 * NT; tile += gridDim.x) {
    int mt, nt; xcd_tile(tile, NT, mt, nt); const int m0 = mt * 128, n0 = nt * 128;
    f32x4 acc[4][4]; acc_zero(acc);
    gemm_mainloop(acc, (const bf16_t*)(p.ws + WS_H), 1024, (const bf16_t*)(p.ws + W_MIN), 1024, 1024, m0, n0, smem);
    const int rb = m0 + wm * 64, cb = n0 + wn * 64;
    const float* wb = stage_wave_tile(acc, smem);
    const int c4 = (lane & 15) * 4, col = cb + c4;
    if (n0 < 256) {
      bf16_t* CQB = (bf16_t*)(p.ws + WS_CQN); float* rsq = (float*)(p.ws + WS_ROWSQ_Q);
#pragma unroll 4
      for (int it = 0; it < 16; ++it) {
        const int rl = it * 4 + (lane >> 4); const size_t row = (size_t)(rb + rl);
        const float4 v = *(const float4*)(wb + rl * 68 + c4);
        *(uint2*)(CQB + row * 256 + col) = pk4(v);
        float ss = v.x * v.x + v.y * v.y + v.z * v.z + v.w * v.w;
        ss += __shfl_xor(ss, 8); ss += __shfl_xor(ss, 4); ss += __shfl_xor(ss, 2); ss += __shfl_xor(ss, 1);
        if ((lane & 15) == 0) __hip_atomic_fetch_add(rsq + row, ss, __ATOMIC_RELAXED, __HIP_MEMORY_SCOPE_AGENT);
      }
    } else if (n0 < 384) {
      float* ex = (float*)(smem + 69632);
#pragma unroll 4
      for (int it = 0; it < 16; ++it) {
        const int rl = it * 4 + (lane >> 4);
        const float4 v = *(const float4*)(wb + rl * 68 + c4);
        float ss = v.x * v.x + v.y * v.y + v.z * v.z + v.w * v.w;
        ss += __shfl_xor(ss, 8); ss += __shfl_xor(ss, 4); ss += __shfl_xor(ss, 2); ss += __shfl_xor(ss, 1);
        if ((lane & 15) == 0) ex[(wm * 2 + wn) * 64 + rl] = ss;
      }
      __syncthreads();
      bf16_t* CKVN = (bf16_t*)(p.ws + WS_CKVN);
      const float4 nw = *(const float4*)(p.in[I_KVNW] + col - 256);
#pragma unroll 4
      for (int it = 0; it < 16; ++it) {
        const int rl = it * 4 + (lane >> 4); const size_t row = (size_t)(rb + rl);
        const float rs = rsqrtf((ex[(wm * 2 + 0) * 64 + rl] + ex[(wm * 2 + 1) * 64 + rl]) * (1.f / 128.f) + EPS);
        const float4 v = *(const float4*)(wb + rl * 68 + c4);
        const float4 o = make_float4(v.x * rs * nw.x, v.y * rs * nw.y, v.z * rs * nw.z, v.w * rs * nw.w);
        *(uint2*)(CKVN + row * 128 + col - 256) = pk4(o);
        if (m0 < NCTX) *(float4*)(p.out + O_CKV + row * 128 + col - 256) = o;
      }
    } else if (n0 < 1408) {
#pragma unroll 4
      for (int it = 0; it < 16; ++it) {
        const int rl = it * 4 + (lane >> 4); const size_t row = (size_t)(rb + rl);
        *(uint2*)(GM + row * 1024 + col - 384) = pk4(silu4(*(const float4*)(wb + rl * 68 + c4)));
      }
    } else if (wn == 0) {
      bf16_t* KPEB = (bf16_t*)(p.ws + WS_KPEB);
      const bool lat = m0 >= NCTX;
#pragma unroll 4
      for (int it = 0; it < 16; ++it) {
        const int rl = it * 4 + (lane >> 4); const size_t row = (size_t)(rb + rl);
        const float4 v = *(const float4*)(wb + rl * 68 + c4);
        const float4 pr = make_float4(__shfl_xor(v.x, 2), __shfl_xor(v.y, 2), __shfl_xor(v.z, 2), __shfl_xor(v.w, 2));
        float4 o = v;
        if (lat) {
          const int l = (int)(row - NCTX) & 4095;
          const float pos = (c4 & 16) ? (float)(l & 63) : (float)(l >> 6);
          const float vv[4] = {v.x, v.y, v.z, v.w}, pp[4] = {pr.x, pr.y, pr.z, pr.w}; float oo[4];
#pragma unroll
          for (int e = 0; e < 4; ++e) {
            const float th = pos * ex2(-(float)((c4 + e) & 7) * (13.287712379549449f / 8.f)), c = __cosf(th), sn = __sinf(th);
            oo[e] = (c4 & 8) ? vv[e] * c + pp[e] * sn : vv[e] * c - pp[e] * sn;
          }
          o = make_float4(oo[0], oo[1], oo[2], oo[3]);
        }
        if (c4 < 32) {
          *(uint2*)(KPEB + row * 32 + c4) = pk4(o);
          if (!lat) *(float4*)(p.out + O_KPE + row * 32 + c4) = v;
        }
      }
    }
  }
}

DI void mla_cache_convert(const Params& p) {
  bf16_t* CKVN = (bf16_t*)(p.ws + WS_CKVN) + (size_t)NTOK * 128; bf16_t* KPEB = (bf16_t*)(p.ws + WS_KPEB) + (size_t)NTOK * 32;
  for (int i = blockIdx.x * 256 + threadIdx.x; i < (65536 + 16384) / 4; i += gridDim.x * 256) {
    if (i < 16384) { float4 v = ((const float4*)p.in[I_CCKV])[i]; *(uint2*)(CKVN + i * 4) = make_uint2(pack2(v.x, v.y), pack2(v.z, v.w)); }
    else { int k = i - 16384; float4 v = ((const float4*)p.in[I_CKPE])[k]; *(uint2*)(KPEB + k * 4) = make_uint2(pack2(v.x, v.y), pack2(v.z, v.w)); }
  }
}
DI void phase_mla_prep(const Params& p) {
  const int tid = threadIdx.x, lane = tid & 63, w = tid >> 6;
  const float* CQ = (const float*)(p.ws + WS_CQ); const float* CKV = (const float*)(p.ws + WS_CKV); const float* KPE = (const float*)(p.ws + WS_KPE);
  bf16_t* CQN = (bf16_t*)(p.ws + WS_CQN); bf16_t* CKVN = (bf16_t*)(p.ws + WS_CKVN); bf16_t* KPEB = (bf16_t*)(p.ws + WS_KPEB);
  for (int item = blockIdx.x; item < NTOK / 4; item += gridDim.x) {
    const size_t row = (size_t)item * 4 + w;
    {
      float4 v = *(const float4*)(CQ + row * 256 + lane * 4);
      float ss = wave_sum(v.x * v.x + v.y * v.y + v.z * v.z + v.w * v.w);
      float rs = rsqrtf(ss * (1.f / 256.f) + EPS);
      float4 nw = *(const float4*)(p.in[I_QNW] + lane * 4);
      *(uint2*)(CQN + row * 256 + lane * 4) = make_uint2(pack2(v.x * rs * nw.x, v.y * rs * nw.y), pack2(v.z * rs * nw.z, v.w * rs * nw.w));
    }
    {
      float2 v = *(const float2*)(CKV + row * 128 + lane * 2);
      float ss = wave_sum(v.x * v.x + v.y * v.y);
      float rs = rsqrtf(ss * (1.f / 128.f) + EPS);
      float2 nw = *(const float2*)(p.in[I_KVNW] + lane * 2);
      float a = v.x * rs * nw.x, b = v.y * rs * nw.y;
      *(unsigned*)(CKVN + row * 128 + lane * 2) = pack2(a, b);
      if (row < NCTX) *(float2*)(p.out + O_CKV + row * 128 + lane * 2) = make_float2(a, b);
    }
    {
      float v = lane < 32 ? KPE[row * 32 + lane] : 0.f;
      float pr = __shfl_xor(v, 8);
      float o = v;
      if (row >= NCTX) {
        int l = (int)(row - NCTX) & 4095;
        float pos = (lane & 16) ? (float)(l & 63) : (float)(l >> 6);
        float th = pos * ex2(-(float)(lane & 7) * (13.287712379549449f / 8.f));
        float c = __cosf(th), s = __sinf(th);
        o = (lane & 8) ? v * c + pr * s : v * c - pr * s;
      } else if (lane < 32) p.out[O_KPE + row * 32 + lane] = v;
      if (lane < 32) KPEB[row * 32 + lane] = f2bf(o);
    }
  }
}

DI void phase_mla_up(const Params& p, unsigned char* smem) {
  const int tid = threadIdx.x, lane = tid & 63, w = tid >> 6, wm = w >> 1, wn = w & 1, lc = lane & 15, g = lane >> 4;
  bf16_t* QM = (bf16_t*)(p.ws + WS_QM); bf16_t* KN = (bf16_t*)(p.ws + WS_KNOPE); bf16_t* VTM = (bf16_t*)(p.ws + WS_VTM);
  constexpr int NQ = 128 * 12, NKV = 132 * 16;
  for (int tile = blockIdx.x; tile < NQ + NKV; tile += gridDim.x) {
    f32x4 acc[4][4]; acc_zero(acc);
    if (tile < NQ) {
      int mt, nt; xcd_tile(tile, 12, mt, nt); const int m0 = mt * 128, n0 = nt * 128;
      gemm_mainloop(acc, (const bf16_t*)(p.ws + WS_CQN), 256, (const bf16_t*)(p.ws + W_UQ), 256, 256, m0, n0, smem);
      const int rb = m0 + wm * 64, cb = n0 + wn * 64; const bool lat = m0 >= NCTX;
      const float inv = ex2(-(float)(lc & 7) * (13.287712379549449f / 8.f));
      if (lat) {
#pragma unroll
        for (int j = 0; j < 4; ++j) {
          const int col0 = cb + j * 16, d0 = col0 % 96;
          if (d0 >= 64) {
#pragma unroll
            for (int i = 0; i < 4; ++i)
#pragma unroll
              for (int r = 0; r < 4; ++r) {
                const int row = rb + i * 16 + 4 * g + r;
                float v = acc[i][j][r];
                float pr = __shfl_xor(v, 8);
                int l = (row - NCTX) & 4095;
                float pos = d0 >= 80 ? (float)(l & 63) : (float)(l >> 6);
                float th = pos * inv, c = __cosf(th), sn = __sinf(th);
                acc[i][j][r] = (lc & 8) ? v * c + pr * sn : v * c - pr * sn;
              }
          }
        }
      }
      {
        const float* wb = stage_wave_tile(acc, smem);
        const int c4 = (lane & 15) * 4; const float qs = 0.10206207261596575f * LOG2E;
#pragma unroll 4
        for (int it = 0; it < 16; ++it) {
          const int rl = it * 4 + (lane >> 4); const size_t row = (size_t)(rb + rl);
          const float4 v = *(const float4*)(wb + rl * 68 + c4);
          const float qr = qs * rsqrtf(((const float*)(p.ws + WS_ROWSQ_Q))[row] * (1.f / 256.f) + EPS);
          *(uint2*)(QM + row * 1536 + cb + c4) = pk4(make_float4(v.x * qr, v.y * qr, v.z * qr, v.w * qr));
        }
      }
    } else {
      const int t2 = tile - NQ; int mt, head; if (t2 < 128 * 16) xcd_tile(t2, 16, mt, head); else { mt = t2 >> 4; head = t2 & 15; } const int m0 = mt * 128, n0 = head * 128;
      gemm_mainloop(acc, (const bf16_t*)(p.ws + WS_CKVN), 128, (const bf16_t*)(p.ws + W_UKV), 128, 128, m0, n0, smem);
      const int rb = m0 + wm * 64;
      if (wn == 0) {
        const float* wb = stage_wave_tile(acc, smem);
        const int c4 = (lane & 15) * 4;
#pragma unroll 4
        for (int it = 0; it < 16; ++it) {
          const int rl = it * 4 + (lane >> 4);
          *(uint2*)(KN + (size_t)(rb + rl) * 1024 + head * 64 + c4) = pk4(*(const float4*)(wb + rl * 68 + c4));
        }
      } else {
#pragma unroll
        for (int i = 0; i < 4; ++i)
#pragma unroll
          for (int j = 0; j < 4; ++j) {
            int row = rb + i * 16 + 4 * g, d = j * 16 + lc;
            *(uint2*)(VTM + ((size_t)(row >> 6) * 16 + head) * 4096 + d * 64 + (row & 63)) = make_uint2(pack2(acc[i][j][0], acc[i][j][1]), pack2(acc[i][j][2], acc[i][j][3]));
          }
      }
    }
  }
}

DI void phase_mla_attn(const Params& p, unsigned char* smem) {
  for (int item = blockIdx.x; item < 1024; item += gridDim.x) {
    AttnArgs a;
    const bool latent = item < 512;
    const int it = latent ? item : item - 512;
    int qb, head, b;
    if (latent) { const int x = it & 7, j = it >> 3, pair = x * 4 + (j >> 4); qb = j & 15; head = pair & 15; b = pair >> 4; }
    else { qb = 0; head = it & 15; b = it >> 4; }
    const int seqrow = latent ? NCTX + b * 4096 : b * 256;
    a.q = (const bf16_t*)(p.ws + WS_QM) + head * 96; a.ldq = 1536;
    a.k = (const bf16_t*)(p.ws + WS_KNOPE) + head * 64; a.ldk = 1024; a.kpe = (const bf16_t*)(p.ws + WS_KPEB);
    a.vt = (const bf16_t*)(p.ws + WS_VTM); a.vt_heads = 16; a.vhead = head;
    a.gate = (const bf16_t*)(p.ws + WS_GM) + head * 64; a.ldg = 1024;
    a.out = (bf16_t*)(p.ws + WS_AOM) + head * 64; a.ldo = 1024;
    a.qrow0 = seqrow + qb * 256; a.qpos0 = qb * 256;
    a.seg0_row = seqrow; a.seg0_n = latent ? 4096 : 256; a.seg0_pos = 0; a.band = 0;
    a.seg1_row = NTOK + b * 256; a.seg1_n = latent ? 256 : 0;
    a.sink2 = 0.f; a.has_sink = 0; a.scale2 = 1.f;
    attn_item2<96, true>(a, smem);
  }
}

DI void phase_final_norm(const Params& p) {
  const int tid = threadIdx.x;
  const bf16_t* X2B = (const bf16_t*)(p.ws + WS_X2B); const float* rowsq = (const float*)(p.ws + WS_ROWSQ);
  const int c8 = (tid & 127) * 8;
  const float4 w0 = *(const float4*)(p.in[I_FNW] + c8), w1 = *(const float4*)(p.in[I_FNW] + c8 + 4);
  for (int item = blockIdx.x; item < NTOK / 2; item += gridDim.x) {
    const size_t row = (size_t)item * 2 + (tid >> 7);
    const float rs = rsqrtf(rowsq[row] * (1.f / 1024.f) + EPS);
    const uint4 u = *(const uint4*)(X2B + row * 1024 + c8);
    float* o = p.out + O_Y + row * 1024 + c8;
    *(float4*)o = make_float4(bflo(u.x) * rs * w0.x, bfhi(u.x) * rs * w0.y, bflo(u.y) * rs * w0.z, bfhi(u.y) * rs * w0.w);
    *(float4*)(o + 4) = make_float4(bflo(u.z) * rs * w1.x, bfhi(u.z) * rs * w1.y, bflo(u.w) * rs * w1.z, bfhi(u.w) * rs * w1.w);
  }
}

#define XB_TMO      128
#define XB_XCNT(j)  (256  + 64 * (j))
#define XB_XSUB(j)  (1280 + 64 * (j))
#define XB_XGEN(j)  (2304 + 64 * (j))
#define XB_TOP      3328
#define XB_TOPGEN   3392
#define XCD_BAR_WORDS 3456
#define XB_SPIN_CAP (1u << 18)
#define LAS __attribute__((address_space(3)))

__device__ __forceinline__ unsigned xb_ld(unsigned* p)              { return __hip_atomic_load(p, __ATOMIC_RELAXED, __HIP_MEMORY_SCOPE_AGENT); }
__device__ __forceinline__ unsigned xb_add(unsigned* p, unsigned v) { return __hip_atomic_fetch_add(p, v, __ATOMIC_RELAXED, __HIP_MEMORY_SCOPE_AGENT); }
__device__ __forceinline__ unsigned xb_xcc_id() { return (unsigned)__builtin_amdgcn_s_getreg((3 << 11) | 20) & 0xFu; }
#define XB_SPIN(cond, bar) do { unsigned _sp = 0; while (cond) { __builtin_amdgcn_s_sleep(1); \
    if ((++_sp & 255u) == 0u) { if (xb_ld(&(bar)[XB_TMO])) break; if (_sp > XB_SPIN_CAP) { atomicAdd(&(bar)[XB_TMO], 1u); break; } } } } while (0)

struct XcdBarrier {
    unsigned* bar; unsigned x;
    volatile LAS unsigned* st;
};

__device__ __forceinline__ XcdBarrier xcd_barrier_post(unsigned* bar, volatile LAS unsigned* st) {
    XcdBarrier b; b.bar = bar; b.x = xb_xcc_id(); b.st = st;
    if (threadIdx.x == 0) (void)xb_add(&bar[XB_XCNT(b.x)], 1u);
    return b;
}
__device__ __forceinline__ void xcd_barrier_complete(unsigned* bar, unsigned x, unsigned& nloc, unsigned& nx) {
    const unsigned G = gridDim.x * gridDim.y * gridDim.z;
    unsigned sum, cnt, mine, sp = 0u;
    for (;;) {
        sum = 0u; cnt = 0u; mine = 0u;
#pragma unroll
        for (unsigned j = 0; j < 16; ++j) { const unsigned c = xb_ld(&bar[XB_XCNT(j)]); sum += c; cnt += (c > 0u) ? 1u : 0u; mine = (j == x) ? c : mine; }
        if (sum == G) break;
        __builtin_amdgcn_s_sleep(1);
        if ((++sp & 255u) == 0u) { if (xb_ld(&bar[XB_TMO])) break; if (sp > XB_SPIN_CAP) { atomicAdd(&bar[XB_TMO], 1u); break; } }
    }
    nloc = mine > 0u ? mine : 1u; nx = cnt > 0u ? cnt : 1u;
}

__device__ __forceinline__ void xcd_barrier(const XcdBarrier& b) {
    asm volatile("s_waitcnt vmcnt(0)" ::: "memory");
    __syncthreads();
    if (threadIdx.x == 0) {
        unsigned* bar = b.bar;
        __builtin_amdgcn_s_waitcnt(0);
        unsigned nloc = b.st[0], nx = b.st[1];
        if (nloc == 0u) { xcd_barrier_complete(bar, b.x, nloc, nx); b.st[0] = nloc; b.st[1] = nx; }
        const unsigned old = xb_add(&bar[XB_XSUB(b.x)], 1u);
        const unsigned gen = old / nloc;
        if (old + 1u == (gen + 1u) * nloc) {
            __builtin_amdgcn_fence(__ATOMIC_RELEASE, "agent");
            asm volatile("s_waitcnt vmcnt(0)" ::: "memory");
            const unsigned og = xb_add(&bar[XB_TOP], 1u);
            const unsigned tg = og / nx;
            if (og + 1u == (tg + 1u) * nx) xb_add(&bar[XB_TOPGEN], 1u);
            else XB_SPIN(xb_ld(&bar[XB_TOPGEN]) == tg, bar);
            __builtin_amdgcn_fence(__ATOMIC_ACQUIRE, "agent");
            xb_add(&bar[XB_XGEN(b.x)], 1u);
            asm volatile("s_waitcnt vmcnt(0)" ::: "memory");
        } else {
            XB_SPIN(xb_ld(&bar[XB_XGEN(b.x)]) == gen, bar);
            __builtin_amdgcn_fence(__ATOMIC_ACQUIRE, "agent");
            asm volatile("s_waitcnt vmcnt(0)" ::: "memory");
        }
    }
    __syncthreads();
}


constexpr int N_PHASES = 15;
__global__ void __launch_bounds__(256, 2) mega(Params p) {
  __shared__ __attribute__((aligned(16))) unsigned char smem[75 * 1024];
  volatile LAS unsigned* xst = (volatile LAS unsigned*)(smem + 75 * 1024 - 16);
  if (threadIdx.x == 0) { xst[0] = 0u; xst[1] = 0u; }
  __syncthreads();
  XcdBarrier xb = xcd_barrier_post((unsigned*)(p.ws + WS_BAR), xst);
  if (p.ph_hi > 1000) cg::this_grid().sync();
#ifndef PROBE_D
#define PROBE_D 0
#endif
#ifndef REPEAT_MASK
#define REPEAT_MASK 0
#endif
#define PHASE(n, ...) if (p.ph_lo <= n && n < p.ph_hi) { __VA_ARGS__; if ((REPEAT_MASK >> n) & 1) { __VA_ARGS__; } if (n + 1 < p.ph_hi) xcd_barrier(xb); }
  PHASE(1, phase0(p, smem); for (int t = blockIdx.x; t < N_WT; t += gridDim.x) wt_item(p, t, smem + 24576); phase_modnorm(p, 0, smem))
  PHASE(2, phase_ab_in(p, smem))
  PHASE(3, phase_conv(p, smem); for (int it = 384 + blockIdx.x; it < 768; it += gridDim.x) p0_mod_item(p, it, smem))
  PHASE(4, phase_ssd_states(p, smem))
#if PROBE_D == 1
  if (p.ph_lo <= 5 && 5 < p.ph_hi) phase_scan_attn_a(p, smem, p.ph_hi > 100);
#endif
  PHASE(5, phase_scan_attn_a(p, smem))
#if PROBE_D == 2
  if (p.ph_lo <= 6 && 6 < p.ph_hi) phase_ssd_out(p, smem, p.ph_hi > 100);
#endif
  PHASE(6, phase_ssd_out(p, smem))
  PHASE(7, phase_ab_out(p, smem))
  PHASE(8, phase_modnorm(p, 1, smem); mla_cache_convert(p))
  PHASE(9, phase_mla_in(p, smem))
  PHASE(11, phase_mla_up(p, smem))
  PHASE(12, phase_mla_attn(p, smem))
  PHASE(13, phase_mla_out(p, smem))
  PHASE(14, phase_final_norm(p))
}

extern "C" void kernel_launch(void* const* d_in, const int* in_sizes, int n_in, void* d_out, int out_size, void* d_ws, size_t ws_size, hipStream_t stream) {
  static int grid = 0;
  if (grid == 0) {
    int dev = 0, cus = 0, per_cu = 0;
    hipGetDevice(&dev);
    hipDeviceGetAttribute(&cus, hipDeviceAttributeMultiprocessorCount, dev);
    hipOccupancyMaxActiveBlocksPerMultiprocessor(&per_cu, (const void*)mega, 256, 0);
    if (per_cu < 1) per_cu = 1;
    if (per_cu > 2) per_cu = 2;
    grid = cus * per_cu;
  }
  Params p{};
  for (int i = 0; i < 29; ++i) p.in[i] = (const float*)d_in[i];
  p.out = (float*)d_out; p.ws = (unsigned char*)d_ws;
  hipMemsetAsync((unsigned char*)d_ws + WS_BAR, 0, WS_ZERO_BYTES, stream);
#if MULTI_LAUNCH
  for (int ph = 0; ph < N_PHASES; ++ph) {
    p.ph_lo = ph; p.ph_hi = ph + 1;
    hipLaunchKernelGGL(mega, dim3(grid), dim3(256), 0, stream, p);
  }
#else
  p.ph_lo = 0; p.ph_hi = N_PHASES;
  void* args[] = {&p};
  hipError_t e = hipLaunchCooperativeKernel((const void*)mega, dim3(grid), dim3(256), args, 0, stream);
  if (e != hipSuccess) fprintf(stderr, "cooperative launch failed: %s (grid %d)\n", hipGetErrorString(e), grid);
#endif
}
```

```cpp
#include <hip/hip_runtime.h>
#include <hip/hip_cooperative_groups.h>
#include <cstdio>
namespace cg = cooperative_groups;

#ifndef MULTI_LAUNCH
#define MULTI_LAUNCH 0
#endif

typedef unsigned short bf16_t;
using bf16x8 = __attribute__((ext_vector_type(8))) short;
using f32x4  = __attribute__((ext_vector_type(4))) float;
typedef __bf16 bf2v __attribute__((ext_vector_type(2)));
typedef float  fl2v __attribute__((ext_vector_type(2)));
#define DI __device__ __forceinline__
#define MFMA16(a, b, c) __builtin_amdgcn_mfma_f32_16x16x32_bf16((a), (b), (c), 0, 0, 0)

constexpr int NTOK = 16384;
constexpr int NCTX = 8192;
constexpr int NROWK = 16896;
constexpr int ABIN_N = 3712;
constexpr int MIN_N = 1536;
constexpr float EPS = 1e-6f;
constexpr float LOG2E = 1.4426950408889634f;

constexpr size_t O_Y = 0;
constexpr size_t O_CAK = 16777216;
constexpr size_t O_CAV = 17825792;
constexpr size_t O_SF = 18874368;
constexpr size_t O_SB = 20971520;
constexpr size_t O_CKV = 23068672;
constexpr size_t O_KPE = 24117248;

constexpr size_t KB = 1024, MB = 1024 * 1024;
constexpr size_t W_ABIN = 0;
constexpr size_t W_ABOUT = W_ABIN + (size_t)ABIN_N * 1024 * 2;
constexpr size_t W_MIN = W_ABOUT + 1024 * 1536 * 2;
constexpr size_t W_UQ = W_MIN + 1536 * 1024 * 2;
constexpr size_t W_UKV = W_UQ + 1536 * 256 * 2;
constexpr size_t W_MOUT = W_UKV + 2048 * 128 * 2;
constexpr size_t W_END = W_MOUT + 1024 * 1024 * 2;
constexpr size_t WS_ROWSQ = 17 * MB + 768 * KB + 96 * KB;
constexpr size_t WS_ROWSQ_Q = WS_ROWSQ + 64 * KB;
constexpr size_t WS_ZERO_BYTES = 96 * KB + 128 * KB;
constexpr size_t WS_X2B = 50 * MB;
constexpr size_t WS_GCNT = 17 * MB + 768 * KB + 15 * KB;
constexpr size_t WS_MODP = 17 * MB + 768 * KB + 16 * KB;
constexpr size_t WS_CDEC = 17 * MB + 512 * KB;
constexpr size_t WS_BAR = 17 * MB + 768 * KB;
constexpr size_t WS_H = 18 * MB;
constexpr size_t WS_XT = 18 * MB;
constexpr size_t WS_XBCR = 50 * MB;
constexpr size_t WS_HIN = 50 * MB;
constexpr size_t WS_QA = 90 * MB;
constexpr size_t WS_KA = 106 * MB;
constexpr size_t WS_VTA = WS_KA + 4352 * KB;
constexpr size_t WS_GA = WS_VTA + 4352 * KB;
constexpr size_t WS_ZS = WS_GA + 16 * MB;
constexpr size_t WS_DTP = WS_ZS + 32 * MB;
constexpr size_t WS_BT = WS_DTP + 2 * MB;
constexpr size_t WS_BCM = WS_BT + 4 * MB;
constexpr size_t WS_SSQ = WS_BCM + 8 * MB;
constexpr size_t WS_STATES = WS_SSQ + 1 * MB;
constexpr size_t WS_L0_END = WS_STATES + 64 * MB;
constexpr size_t WS_AOM = 18 * MB;
constexpr size_t WS_GM = 50 * MB;
constexpr size_t WS_CQN = 82 * MB;
constexpr size_t WS_CKVN = 90 * MB;
constexpr size_t WS_KPEB = WS_CKVN + 4352 * KB;
constexpr size_t WS_QM = WS_KPEB + 1280 * KB;
constexpr size_t WS_KNOPE = WS_QM + 48 * MB;
constexpr size_t WS_VTM = WS_KNOPE + 33 * MB;
constexpr size_t WS_CQ = WS_VTM;
constexpr size_t WS_CKV = WS_CQ + 16 * MB;
constexpr size_t WS_KPE = WS_CKV + 8 * MB;
constexpr size_t WS_X1B = WS_VTM + 33 * MB;
constexpr size_t WS_L1_END = WS_X1B + 32 * MB;
static_assert(W_END <= 17 * MB, "weights");
static_assert(WS_L0_END <= 256 * MB && WS_L1_END <= 256 * MB && WS_X1B >= WS_STATES && WS_X1B >= WS_SSQ + 1 * MB, "workspace");

struct Params {
  const float* in[29];
  float* out;
  unsigned char* ws;
  int ph_lo, ph_hi;
};
enum { I_XP = 0, I_XS, I_CAK, I_CAV, I_SF, I_SB, I_CCKV, I_CKPE, I_C, I_CCTX, I_ADAW, I_ADAB, I_NORMW, I_ABWIN, I_SINK, I_CONVW, I_CONVB,
       I_DTB, I_ALOG, I_DSKIP, I_GNW, I_ABWOUT, I_MWIN, I_QNW, I_KVNW, I_WUQ, I_WUKV, I_MWOUT, I_FNW };

DI unsigned pack2(float a, float b) { fl2v v = {a, b}; bf2v r = __builtin_convertvector(v, bf2v); return __builtin_bit_cast(unsigned, r); }
DI bf16_t f2bf(float a) { return (bf16_t)(pack2(a, 0.f) & 0xffffu); }
DI float bf2f(bf16_t b) { return __uint_as_float(((unsigned)b) << 16); }
DI float bflo(unsigned u) { return __uint_as_float(u << 16); }
DI float bfhi(unsigned u) { return __uint_as_float(u & 0xffff0000u); }
DI float silu_f(float x) { return x * __builtin_amdgcn_rcpf(1.f + __builtin_amdgcn_exp2f(-x * 1.4426950408889634f)); }
DI float softplus_f(float x) { return x > 20.f ? x : log1pf(__expf(x)); }
DI float ex2(float x) { return __builtin_amdgcn_exp2f(x); }
DI bf16x8 mk8(unsigned a, unsigned b, unsigned c, unsigned d) { uint4 u = make_uint4(a, b, c, d); return __builtin_bit_cast(bf16x8, u); }
DI int cond_of(int row) { return row < NCTX ? 0 : 1 + ((row - NCTX) >> 12); }
DI float wave_sum(float v) {
#pragma unroll
  for (int o = 32; o > 0; o >>= 1) v += __shfl_xor(v, o);
  return v;
}
DI float mod_val(const Params& p, int layer, int cond, int which, int c) {
  return ((const float*)(p.ws + WS_MODP))[(layer * 3 + cond) * 3072 + which * 1024 + c];
}
DI void chunk_rows(int gc, int& row0, int& s0, int& s1) {
  if (gc < 64) { int seq = gc >> 1; s0 = seq * 256; s1 = s0 + 256; row0 = s0 + (gc & 1) * 128; }
  else { int g2 = gc - 64; int seq = g2 >> 5; s0 = NCTX + seq * 4096; s1 = s0 + 4096; row0 = s0 + (g2 & 31) * 128; }
}

DI void p0_mod_item(const Params& p, int item, unsigned char* smem) {
  const int tid = threadIdx.x;
  const int kc = item & 31, cgp = (item >> 5) % 12, layer = item / 384;
  float* sl = (float*)smem;
  __syncthreads();
  if (tid < 96) {
    int j = tid >> 5, k = kc * 32 + (tid & 31);
    const float* cv = j == 0 ? p.in[I_CCTX] : p.in[I_C] + (j - 1) * 1024;
    sl[tid] = silu_f(cv[k]);
  }
  __syncthreads();
  const int col = cgp * 256 + tid;
  const float* W = p.in[I_ADAW] + (size_t)layer * 1024 * 3072 + (size_t)(kc * 32) * 3072 + col;
  float wv[32];
#pragma unroll
  for (int kk = 0; kk < 32; ++kk) wv[kk] = W[(size_t)kk * 3072];
  float a0 = 0.f, a1 = 0.f, a2 = 0.f;
#pragma unroll
  for (int kk = 0; kk < 32; ++kk) { a0 += sl[kk] * wv[kk]; a1 += sl[32 + kk] * wv[kk]; a2 += sl[64 + kk] * wv[kk]; }
  if (kc == 0) { float bb = p.in[I_ADAB][layer * 3072 + col]; a0 += bb; a1 += bb; a2 += bb; }
  float* mp = (float*)(p.ws + WS_MODP) + (size_t)layer * 3 * 3072 + col;
  atomicAdd(mp, a0); atomicAdd(mp + 3072, a1); atomicAdd(mp + 6144, a2);
  if (layer == 0) {
    asm volatile("s_waitcnt vmcnt(0)" ::: "memory");
    __syncthreads();
    if (tid == 0) __hip_atomic_fetch_add((unsigned*)(p.ws + WS_GCNT), 1u, __ATOMIC_RELAXED, __HIP_MEMORY_SCOPE_AGENT);
  }
}
DI void p0_wt_tile(const float* src, int ldsrc, bf16_t* dst, int K, int k0, int n0, int nvalid, int mode, const float* rowscale, int rs_off, unsigned char* smem) {
  const int tid = threadIdx.x;
  float* tile = (float*)smem;
  const int c4 = (tid & 15) * 4, r0 = tid >> 4;
  const int n = n0 + c4;
  int sc;
  if (mode == 0) sc = n < nvalid ? n : -1;
  else sc = n < 384 ? n : (n < 1408 ? n + 32 : (n < 1440 ? n - 1024 : -1));
  __syncthreads();
  float4 vv[4];
#pragma unroll
  for (int i = 0; i < 4; ++i) { const int k = k0 + r0 + 16 * i; vv[i] = sc >= 0 ? *(const float4*)(src + (size_t)k * ldsrc + sc) : make_float4(0.f, 0.f, 0.f, 0.f); }
#pragma unroll
  for (int i = 0; i < 4; ++i) {
    const int k = k0 + r0 + 16 * i; float4 v = vv[i];
    if (rowscale && k >= rs_off) { const float f = rowscale[k - rs_off]; v.x *= f; v.y *= f; v.z *= f; v.w *= f; }
    float* tp = tile + (r0 + 16 * i) * 65 + c4;
    tp[0] = v.x; tp[1] = v.y; tp[2] = v.z; tp[3] = v.w;
  }
  __syncthreads();
  const int nn = tid >> 2, kk0 = (tid & 3) * 16;
  unsigned u[8];
#pragma unroll
  for (int e = 0; e < 8; ++e) u[e] = pack2(tile[(kk0 + 2 * e) * 65 + nn], tile[(kk0 + 2 * e + 1) * 65 + nn]);
  uint4* d = (uint4*)(dst + (size_t)(n0 + nn) * K + k0 + kk0);
  d[0] = make_uint4(u[0], u[1], u[2], u[3]); d[1] = make_uint4(u[4], u[5], u[6], u[7]);
}
constexpr int T_ABIN = 16 * 58, T_ABOUT = 24 * 16, T_MIN = 16 * 24, T_UQ = 4 * 24, T_UKV = 2 * 32, T_MOUT = 16 * 16;
constexpr int N_WT = T_ABIN + T_ABOUT + T_MIN + T_UQ + T_UKV + T_MOUT;
DI void wt_item(const Params& p, int t, unsigned char* smem) {
  if (t < T_ABIN) { int nt = t % 58, kt = t / 58; p0_wt_tile(p.in[I_ABWIN], 3616, (bf16_t*)(p.ws + W_ABIN), 1024, kt * 64, nt * 64, 3616, 0, nullptr, 0, smem); return; }
  t -= T_ABIN;
  if (t < T_ABOUT) { int nt = t % 16, kt = t / 16; p0_wt_tile(p.in[I_ABWOUT], 1024, (bf16_t*)(p.ws + W_ABOUT), 1536, kt * 64, nt * 64, 1024, 0, p.in[I_GNW], 512, smem); return; }
  t -= T_ABOUT;
  if (t < T_MIN) { int nt = t % 24, kt = t / 24; p0_wt_tile(p.in[I_MWIN], 1440, (bf16_t*)(p.ws + W_MIN), 1024, kt * 64, nt * 64, 1440, 1, nullptr, 0, smem); return; }
  t -= T_MIN;
  if (t < T_UQ) { int nt = t % 24, kt = t / 24; p0_wt_tile(p.in[I_WUQ], 1536, (bf16_t*)(p.ws + W_UQ), 256, kt * 64, nt * 64, 1536, 0, p.in[I_QNW], 0, smem); return; }
  t -= T_UQ;
  if (t < T_UKV) { int nt = t % 32, kt = t / 32; p0_wt_tile(p.in[I_WUKV], 2048, (bf16_t*)(p.ws + W_UKV), 128, kt * 64, nt * 64, 2048, 0, nullptr, 0, smem); return; }
  t -= T_UKV;
  { int nt = t % 16, kt = t / 16; p0_wt_tile(p.in[I_MWOUT], 1024, (bf16_t*)(p.ws + W_MOUT), 1024, kt * 64, nt * 64, 1024, 0, nullptr, 0, smem); }
}
DI void phase0(const Params& p, unsigned char* smem) {
  constexpr int N_MOD = 384;
  constexpr int N_CACHE = 64;
  constexpr int N_ALL = N_MOD + N_CACHE;
  for (int item = blockIdx.x; item < N_ALL; item += gridDim.x) {
    if (item < N_MOD) { p0_mod_item(p, item, smem); continue; }
    int t = item - N_MOD;
    const int tid = threadIdx.x;
    if (t < 32) {
      int e0 = t * 2048 + tid * 8;
      const float4* s = (const float4*)(p.in[I_CAK] + e0);
      float4 a = s[0], b = s[1];
      *(uint4*)((bf16_t*)(p.ws + WS_KA) + (size_t)NTOK * 128 + e0) = make_uint4(pack2(a.x, a.y), pack2(a.z, a.w), pack2(b.x, b.y), pack2(b.z, b.w));
    } else {
      int e0 = (t - 32) * 2048 + tid * 8;
      bf16_t* vt = (bf16_t*)(p.ws + WS_VTA);
#pragma unroll
      for (int e = 0; e < 8; ++e) {
        int idx = e0 + e;
        int d = idx & 63, kvh = (idx >> 6) & 1, rj = idx >> 7;
        int row = NTOK + rj;
        vt[((size_t)(row >> 6) * 2 + kvh) * 4096 + d * 64 + (row & 63)] = f2bf(p.in[I_CAV][idx]);
      }
    }
  }
}

DI void phase_modnorm(const Params& p, int layer, unsigned char* smem) {
  const int tid = threadIdx.x, lane = tid & 63, w = tid >> 6;
  float* em = (float*)smem;
  float* ea = em + 3072;
  if (layer == 0 && tid == 0) {
    unsigned spins = 0;
    while (__hip_atomic_load((unsigned*)(p.ws + WS_GCNT), __ATOMIC_RELAXED, __HIP_MEMORY_SCOPE_AGENT) < 384u && ++spins < (1u << 22)) __builtin_amdgcn_s_sleep(2);
  }
  __syncthreads();
  for (int i = tid; i < 3072; i += 256) {
    int cond = i >> 10, c = i & 1023;
    float* mpa = (float*)(p.ws + WS_MODP) + (layer * 3 + cond) * 3072;
    float sh = __hip_atomic_load(mpa + c, __ATOMIC_RELAXED, __HIP_MEMORY_SCOPE_AGENT), sc = __hip_atomic_load(mpa + 1024 + c, __ATOMIC_RELAXED, __HIP_MEMORY_SCOPE_AGENT);
    em[i] = p.in[I_NORMW][layer * 1024 + c] * (1.f + sc); ea[i] = sh;
  }
  __syncthreads();
  bf16_t* H = (bf16_t*)(p.ws + WS_H);
  for (int item = blockIdx.x; item < NTOK / 4; item += gridDim.x) {
    int row = item * 4 + w;
    float4 v[4]; float ss = 0.f;
    if (layer == 0) {
      const float* xr = row < NCTX ? p.in[I_XP] + (size_t)row * 1024 : p.in[I_XS] + (size_t)(row - NCTX) * 1024;
#pragma unroll
      for (int i = 0; i < 4; ++i) v[i] = ((const float4*)xr)[lane + 64 * i];
    } else {
      const uint2* xr = (const uint2*)((const bf16_t*)(p.ws + WS_X1B) + (size_t)row * 1024);
#pragma unroll
      for (int i = 0; i < 4; ++i) { uint2 u = xr[lane + 64 * i]; v[i] = make_float4(bflo(u.x), bfhi(u.x), bflo(u.y), bfhi(u.y)); }
    }
#pragma unroll
    for (int i = 0; i < 4; ++i) ss += v[i].x * v[i].x + v[i].y * v[i].y + v[i].z * v[i].z + v[i].w * v[i].w;
    ss = wave_sum(ss);
    float rstd = rsqrtf(ss * (1.f / 1024.f) + EPS);
    int cond = cond_of(row);
#pragma unroll
    for (int i = 0; i < 4; ++i) {
      int col = (lane + 64 * i) * 4;
      float4 m = *(const float4*)(em + cond * 1024 + col), a = *(const float4*)(ea + cond * 1024 + col);
      uint2 o = make_uint2(pack2(v[i].x * rstd * m.x + a.x, v[i].y * rstd * m.y + a.y), pack2(v[i].z * rstd * m.z + a.z, v[i].w * rstd * m.w + a.w));
      *(uint2*)(H + (size_t)row * 1024 + col) = o;
    }
  }
}

template <bool NARROW = false>
DI void gemm_mainloop(f32x4 (&acc)[4][4], const bf16_t* __restrict__ A, int lda, const bf16_t* __restrict__ B, int ldb, int K, int m0, int n0, unsigned char* smem) {
  const int tid = threadIdx.x, lane = tid & 63, w = tid >> 6, wm = w >> 1, wn = w & 1, lc = lane & 15, g = lane >> 4;
  const int rr = w * 8 + (lane >> 3);
  const int q = (lane & 7) ^ (((w & 1) * 4 + (lane >> 4)) & 7);
  const bf16_t* ga = A + (size_t)(m0 + rr) * lda + q * 8;
  const bf16_t* gb = B + (size_t)(n0 + rr) * ldb + q * 8;
  const int sw = (lc >> 1) & 7;
  const int nk = K >> 6;
#define GSTAGE(s, kt) do { _Pragma("unroll") for (int i = 0; i < 4; ++i) { \
    __builtin_amdgcn_global_load_lds((const unsigned*)(ga + (size_t)(i * 32) * lda + (kt) * 64), (unsigned*)(smem + (s) * 32768 + w * 1024 + i * 4096), 16, 0, 0); \
    if (!NARROW || i == 0) __builtin_amdgcn_global_load_lds((const unsigned*)(gb + (size_t)(i * 32) * ldb + (kt) * 64), (unsigned*)(smem + (s) * 32768 + 16384 + w * 1024 + i * 4096), 16, 0, 0); } } while (0)
  __syncthreads();
  GSTAGE(0, 0);
  asm volatile("s_waitcnt vmcnt(0)" ::: "memory");
  __syncthreads();
  for (int kt = 0; kt < nk; ++kt) {
    const int cur = kt & 1;
    if (kt + 1 < nk) GSTAGE(cur ^ 1, kt + 1);
    const unsigned char* sa = smem + cur * 32768 + (wm * 64 + lc) * 128;
    const unsigned char* sb = smem + cur * 32768 + 16384 + (wn * 64 + lc) * 128;
#pragma unroll
    for (int ks = 0; ks < 2; ++ks) {
      const int co = ((ks * 4 + g) ^ sw) * 16;
      bf16x8 af[4], bfr[4];
      if (NARROW) {
        if (wn == 0) {
#pragma unroll
          for (int i = 0; i < 4; ++i) af[i] = *(const bf16x8*)(sa + i * 2048 + co);
#pragma unroll
          for (int j = 0; j < 2; ++j) bfr[j] = *(const bf16x8*)(sb + j * 2048 + co);
#pragma unroll
          for (int i = 0; i < 4; ++i)
#pragma unroll
            for (int j = 0; j < 2; ++j) acc[i][j] = MFMA16(af[i], bfr[j], acc[i][j]);
        }
      } else {
#pragma unroll
        for (int i = 0; i < 4; ++i) af[i] = *(const bf16x8*)(sa + i * 2048 + co);
#pragma unroll
        for (int j = 0; j < 4; ++j) bfr[j] = *(const bf16x8*)(sb + j * 2048 + co);
#pragma unroll
        for (int i = 0; i < 4; ++i)
#pragma unroll
          for (int j = 0; j < 4; ++j) acc[i][j] = MFMA16(af[i], bfr[j], acc[i][j]);
      }
    }
    asm volatile("s_waitcnt vmcnt(0)" ::: "memory");
    __syncthreads();
  }
#undef GSTAGE
}
DI void acc_zero(f32x4 (&acc)[4][4]) {
#pragma unroll
  for (int i = 0; i < 4; ++i)
#pragma unroll
    for (int j = 0; j < 4; ++j) acc[i][j] = f32x4{0.f, 0.f, 0.f, 0.f};
}
DI void rope64(f32x4 (&acc)[4][4], int rowbase  , int lc, int g) {
  const float inv = ex2(-(float)lc * (13.287712379549449f / 16.f));
#pragma unroll
  for (int i = 0; i < 4; ++i)
#pragma unroll
    for (int r = 0; r < 4; ++r) {
      int l = (rowbase + i * 16 + 4 * g + r - NCTX) & 4095;
      float tr = (float)(l >> 6) * inv, tc = (float)(l & 63) * inv;
      float cr = __cosf(tr), sr = __sinf(tr), cc = __cosf(tc), sc = __sinf(tc);
      float a = acc[i][0][r], b = acc[i][1][r];
      acc[i][0][r] = a * cr - b * sr; acc[i][1][r] = b * cr + a * sr;
      a = acc[i][2][r]; b = acc[i][3][r];
      acc[i][2][r] = a * cc - b * sc; acc[i][3][r] = b * cc + a * sc;
    }
}

DI float* stage_wave_tile(const f32x4 (&acc)[4][4], unsigned char* smem) {
  const int lane = threadIdx.x & 63, w = threadIdx.x >> 6, lc = lane & 15, g = lane >> 4;
  float* wb = (float*)smem + w * (64 * 68);
#pragma unroll
  for (int i = 0; i < 4; ++i)
#pragma unroll
    for (int j = 0; j < 4; ++j)
#pragma unroll
      for (int r = 0; r < 4; ++r) wb[(i * 16 + 4 * g + r) * 68 + j * 16 + lc] = acc[i][j][r];
  __builtin_amdgcn_wave_barrier();
  return wb;
}
DI uint2 pk4(float4 v) { return make_uint2(pack2(v.x, v.y), pack2(v.z, v.w)); }
DI float4 silu4(float4 v) { return make_float4(silu_f(v.x), silu_f(v.y), silu_f(v.z), silu_f(v.w)); }
DI void xcd_tile(int v, int NT, int& mt, int& nt) { const int x = v & 7, j = v >> 3; mt = (j / NT) * 8 + x; nt = j % NT; }

DI void phase_ab_in(const Params& p, unsigned char* smem) {
  const int tid = threadIdx.x, lane = tid & 63, w = tid >> 6, wm = w >> 1, wn = w & 1, lc = lane & 15, g = lane >> 4;
  const bf16_t* H = (const bf16_t*)(p.ws + WS_H);
  const bf16_t* W = (const bf16_t*)(p.ws + W_ABIN);
  bf16_t* QA = (bf16_t*)(p.ws + WS_QA); bf16_t* KA = (bf16_t*)(p.ws + WS_KA); bf16_t* VTA = (bf16_t*)(p.ws + WS_VTA);
  bf16_t* GA = (bf16_t*)(p.ws + WS_GA); bf16_t* ZS = (bf16_t*)(p.ws + WS_ZS); bf16_t* XB = (bf16_t*)(p.ws + WS_XBCR);
  float* DTP = (float*)(p.ws + WS_DTP);
  constexpr int NT = ABIN_N / 128;
  for (int tile = blockIdx.x; tile < 128 * NT; tile += gridDim.x) {
    int mt, nt; if (tile < 128 * (NT - 1)) xcd_tile(tile, NT - 1, mt, nt); else { mt = tile - 128 * (NT - 1); nt = NT - 1; }
    const int m0 = mt * 128, n0 = nt * 128;
    f32x4 acc[4][4]; acc_zero(acc);
    if (n0 >= 3584) gemm_mainloop<true>(acc, H, 1024, W, 1024, 1024, m0, n0, smem); else gemm_mainloop<false>(acc, H, 1024, W, 1024, 1024, m0, n0, smem);
    const int rb = m0 + wm * 64, cb = n0 + wn * 64;
    const bool lat = m0 >= NCTX;
    if (n0 < 640 && lat) rope64(acc, rb, lc, g);
    if (n0 >= 640 && n0 < 768) {
#pragma unroll
      for (int i = 0; i < 4; ++i)
#pragma unroll
        for (int j = 0; j < 4; ++j) {
          int row = rb + i * 16 + 4 * g, d = j * 16 + lc;
          *(uint2*)(VTA + ((size_t)(row >> 6) * 2 + wn) * 4096 + d * 64 + (row & 63)) = make_uint2(pack2(acc[i][j][0], acc[i][j][1]), pack2(acc[i][j][2], acc[i][j][3]));
        }
    }
    if (n0 < 3584) {
      const float* wb = stage_wave_tile(acc, smem);
      const int c4 = (lane & 15) * 4, col = cb + c4;
#pragma unroll 4
      for (int it = 0; it < 16; ++it) {
        const int rl = it * 4 + (lane >> 4); const size_t row = (size_t)(rb + rl);
        float4 v = *(const float4*)(wb + rl * 68 + c4);
        if (n0 < 512) { const float qs = 0.125f * LOG2E; *(uint2*)(QA + row * 512 + col) = pk4(make_float4(v.x * qs, v.y * qs, v.z * qs, v.w * qs)); }
        else if (n0 < 640) { *(uint2*)(KA + row * 128 + col - 512) = pk4(v); if (!lat) *(float4*)(p.out + O_CAK + row * 128 + col - 512) = v; }
        else if (n0 < 768) { if (!lat) *(float4*)(p.out + O_CAV + row * 128 + col - 640) = v; }
        else if (n0 < 1280) *(uint2*)(GA + row * 512 + col - 768) = pk4(silu4(v));
        else if (n0 < 2304) *(uint2*)(ZS + row * 1024 + col - 1280) = pk4(silu4(v));
        else *(uint2*)(XB + row * 1280 + col - 2304) = pk4(v);
      }
    } else if (wn == 0) {
#pragma unroll
      for (int i = 0; i < 4; ++i)
#pragma unroll
        for (int j = 0; j < 2; ++j)
#pragma unroll
          for (int r = 0; r < 4; ++r) {
            int row = rb + i * 16 + 4 * g + r, col = j * 16 + lc;
            DTP[(size_t)row * 32 + col] = softplus_f(acc[i][j][r] + p.in[I_DTB][col]);
          }
    }
  }
}

DI void phase_conv(const Params& p, unsigned char* smem) {
  const int tid = threadIdx.x;
  bf16_t* raw = (bf16_t*)smem;
  bf16_t* outl = raw + 132 * 64;
  const bf16_t* XB = (const bf16_t*)(p.ws + WS_XBCR);
  bf16_t* XT = (bf16_t*)(p.ws + WS_XT); bf16_t* BT = (bf16_t*)(p.ws + WS_BT); bf16_t* BCM = (bf16_t*)(p.ws + WS_BCM);
  for (int item = blockIdx.x; item < 128 * 20; item += gridDim.x) {
    const int gc = item / 20, cgp = item % 20;
    int row0, s0, s1; chunk_rows(gc, row0, s0, s1);
    __syncthreads();
    for (int c = tid; c < 132 * 8; c += 256) {
      int t = c >> 3, c8 = c & 7, row = row0 - 2 + t;
      uint4 v = make_uint4(0, 0, 0, 0);
      if (row >= s0 && row < s1) v = *(const uint4*)(XB + (size_t)row * 1280 + cgp * 64 + c8 * 8);
      *(uint4*)(raw + t * 64 + c8 * 8) = v;
    }
    __syncthreads();
    {
      const int c = tid & 63, tg = tid >> 6, ch = cgp * 64 + c;
      float wv[5];
#pragma unroll
      for (int j = 0; j < 5; ++j) wv[j] = p.in[I_CONVW][j * 1280 + ch];
      const float bias = p.in[I_CONVB][ch];
      float x0 = bf2f(raw[(tg * 32 + 0) * 64 + c]), x1 = bf2f(raw[(tg * 32 + 1) * 64 + c]), x2 = bf2f(raw[(tg * 32 + 2) * 64 + c]), x3 = bf2f(raw[(tg * 32 + 3) * 64 + c]);
#pragma unroll 8
      for (int t = 0; t < 32; ++t) {
        int tt = tg * 32 + t;
        float x4 = bf2f(raw[(tt + 4) * 64 + c]);
        float o = bias + wv[0] * x0 + wv[1] * x1 + wv[2] * x2 + wv[3] * x3 + wv[4] * x4;
        outl[tt * 66 + c] = f2bf(silu_f(o));
        x0 = x1; x1 = x2; x2 = x3; x3 = x4;
      }
    }
    __syncthreads();
    if (cgp >= 16) {
      for (int c = tid; c < 1024; c += 256) {
        int tt = c >> 3, c8 = c & 7;
        const unsigned* s = (const unsigned*)(outl + tt * 66 + c8 * 8);
        *(uint4*)(BCM + (size_t)(row0 + tt) * 256 + (cgp - 16) * 64 + c8 * 8) = make_uint4(s[0], s[1], s[2], s[3]);
      }
    }
    if (cgp < 18) {
      for (int c = tid; c < 1024; c += 256) {
        int ch = c >> 4, t8 = c & 15;
        unsigned u[4];
#pragma unroll
        for (int e = 0; e < 4; ++e) u[e] = (unsigned)outl[(t8 * 8 + 2 * e) * 66 + ch] | ((unsigned)outl[(t8 * 8 + 2 * e + 1) * 66 + ch] << 16);
        bf16_t* dst = cgp < 16 ? XT + ((size_t)gc * 1024 + cgp * 64 + ch) * 128 + t8 * 8 : BT + ((size_t)gc * 128 + (cgp - 16) * 64 + ch) * 128 + t8 * 8;
        *(uint4*)dst = make_uint4(u[0], u[1], u[2], u[3]);
      }
    }
  }
}

DI float chunk_cums(const Params& p, int row0, int head, int dir, int lane, float* dtv, float* cumv, float* facv) {
  const float* DTP = (const float*)(p.ws + WS_DTP);
  const float a = -__expf(p.in[I_ALOG][dir * 16 + head]);
  float d0 = DTP[(size_t)(row0 + 2 * lane) * 32 + dir * 16 + head], d1 = DTP[(size_t)(row0 + 2 * lane + 1) * 32 + dir * 16 + head];
  float v0 = d0 * a, v1 = d1 * a, s = v0 + v1, sc = s;
#pragma unroll
  for (int o = 1; o < 64; o <<= 1) { float t = __shfl_up(sc, o); if (lane >= o) sc += t; }
  float total = __shfl(sc, 63);
  float e = sc - s, c0 = e + v0, c1 = e + s;
  if (facv) {
    dtv[dir * 128 + 2 * lane] = d0; dtv[dir * 128 + 2 * lane + 1] = d1;
    if (dir == 0) {
      cumv[2 * lane] = c0; cumv[2 * lane + 1] = c1;
      facv[2 * lane] = d0 * __expf(total - c0); facv[2 * lane + 1] = d1 * __expf(total - c1);
    } else {
      cumv[128 + 2 * lane] = total - c0 + v0; cumv[128 + 2 * lane + 1] = total - c1 + v1;
      facv[128 + 2 * lane] = d0 * __expf(c0 - v0); facv[128 + 2 * lane + 1] = d1 * __expf(c1 - v1);
    }
  } else {
    const float q0 = dir == 0 ? c0 : total - c0 + v0, q1 = dir == 0 ? c1 : total - c1 + v1;
    cumv[dir * 128 + 2 * lane] = q0 * LOG2E; cumv[dir * 128 + 2 * lane + 1] = q1 * LOG2E;
    dtv[dir * 128 + 2 * lane] = q0 * LOG2E - __log2f(d0); dtv[dir * 128 + 2 * lane + 1] = q1 * LOG2E - __log2f(d1);
  }
  return total;
}

DI void phase_ssd_states(const Params& p, unsigned char* smem) {
  const int tid = threadIdx.x, lane = tid & 63, w = tid >> 6, lc = lane & 15, g = lane >> 4;
  bf16_t* xf = (bf16_t*)smem;
  bf16_t* xb = xf + 64 * 136;
  bf16_t* bt = xb + 64 * 136;
  float* dtv = (float*)(bt + 64 * 136);
  float* cumv = dtv + 256;
  float* facv = cumv + 256;
  const bf16_t* XT = (const bf16_t*)(p.ws + WS_XT); const bf16_t* BT = (const bf16_t*)(p.ws + WS_BT);
  float* ST = (float*)(p.ws + WS_STATES); float* CD = (float*)(p.ws + WS_CDEC);
  for (int item = blockIdx.x; item < 2048; item += gridDim.x) {
    const int gc = ((item >> 7) << 3) + (item & 7), head = (item >> 3) & 15, grp = head >> 3;
    int row0, s0, s1; chunk_rows(gc, row0, s0, s1);
    __syncthreads();
    if (w < 2) {
      float total = chunk_cums(p, row0, head, w, lane, dtv, cumv, facv);
      if (lane == 0) CD[(gc * 2 + w) * 16 + head] = __expf(total);
    }
    __syncthreads();
#pragma unroll
    for (int i = 0; i < 4; ++i) {
      int id = tid + 256 * i, r = id >> 4, c16 = id & 15;
      uint4 xv = *(const uint4*)(XT + ((size_t)gc * 1024 + head * 64 + r) * 128 + c16 * 8);
      uint4 bv = *(const uint4*)(BT + ((size_t)gc * 128 + grp * 64 + r) * 128 + c16 * 8);
      *(uint4*)(bt + r * 136 + c16 * 8) = bv;
      const float* ff = facv + c16 * 8; const float* fb = facv + 128 + c16 * 8;
      unsigned xs[4] = {xv.x, xv.y, xv.z, xv.w}, of[4], ob[4];
#pragma unroll
      for (int e = 0; e < 4; ++e) {
        float lo = bflo(xs[e]), hi = bfhi(xs[e]);
        of[e] = pack2(lo * ff[2 * e], hi * ff[2 * e + 1]); ob[e] = pack2(lo * fb[2 * e], hi * fb[2 * e + 1]);
      }
      *(uint4*)(xf + r * 136 + c16 * 8) = make_uint4(of[0], of[1], of[2], of[3]);
      *(uint4*)(xb + r * 136 + c16 * 8) = make_uint4(ob[0], ob[1], ob[2], ob[3]);
    }
    __syncthreads();
    f32x4 af[4], ab[4];
#pragma unroll
    for (int j = 0; j < 4; ++j) { af[j] = f32x4{0, 0, 0, 0}; ab[j] = f32x4{0, 0, 0, 0}; }
#pragma unroll
    for (int ks = 0; ks < 4; ++ks) {
      bf16x8 a_f = *(const bf16x8*)(xf + (w * 16 + lc) * 136 + ks * 32 + g * 8);
      bf16x8 a_b = *(const bf16x8*)(xb + (w * 16 + lc) * 136 + ks * 32 + g * 8);
#pragma unroll
      for (int j = 0; j < 4; ++j) {
        bf16x8 b = *(const bf16x8*)(bt + (j * 16 + lc) * 136 + ks * 32 + g * 8);
        af[j] = MFMA16(a_f, b, af[j]); ab[j] = MFMA16(a_b, b, ab[j]);
      }
    }
    bf16_t* o0 = (bf16_t*)ST + ((size_t)(gc * 2 + 0) * 16 + head) * 4096; bf16_t* o1 = (bf16_t*)ST + ((size_t)(gc * 2 + 1) * 16 + head) * 4096;
    const bool odd = lc & 1;
#pragma unroll
    for (int j = 0; j < 4; ++j) {
      const int n2 = j * 16 + (lc & ~1), pb = w * 16 + 4 * g + (odd ? 2 : 0);
      {
        const float y0 = __shfl_xor(odd ? af[j][0] : af[j][2], 1), y1 = __shfl_xor(odd ? af[j][1] : af[j][3], 1);
        const unsigned u0 = odd ? pack2(y0, af[j][2]) : pack2(af[j][0], y0), u1 = odd ? pack2(y1, af[j][3]) : pack2(af[j][1], y1);
        *(unsigned*)(o0 + (pb + 0) * 64 + n2) = u0; *(unsigned*)(o0 + (pb + 1) * 64 + n2) = u1;
      }
      {
        const float y0 = __shfl_xor(odd ? ab[j][0] : ab[j][2], 1), y1 = __shfl_xor(odd ? ab[j][1] : ab[j][3], 1);
        const unsigned u0 = odd ? pack2(y0, ab[j][2]) : pack2(ab[j][0], y0), u1 = odd ? pack2(y1, ab[j][3]) : pack2(ab[j][1], y1);
        *(unsigned*)(o1 + (pb + 0) * 64 + n2) = u0; *(unsigned*)(o1 + (pb + 1) * 64 + n2) = u1;
      }
    }
  }
}

struct AttnArgs {
  const bf16_t* q; int ldq;
  const bf16_t* k; int ldk;
  const bf16_t* kpe;
  const bf16_t* vt; int vt_heads, vhead;
  const bf16_t* gate; int ldg;
  bf16_t* out; int ldo;
  int qrow0, qpos0;
  int seg0_row, seg0_n, seg0_pos, band;
  int seg1_row, seg1_n;
  float sink2; int has_sink; float scale2;
};
using f32x16 = __attribute__((ext_vector_type(16))) float;
#define MFMA32(a, b, c) __builtin_amdgcn_mfma_f32_32x32x16_bf16((a), (b), (c), 0, 0, 0)
template <int DK, bool MLA>
DI void attn_item(const AttnArgs& a, unsigned char* smem, bool dost = true) {
  constexpr int KS = DK / 16, KSTR = DK + 8, KCH = DK / 8, VSTR = 68;
  const int tid = threadIdx.x, lane = tid & 63, w = tid >> 6, r32 = lane & 31, h = lane >> 5;
  bf16_t* sK = (bf16_t*)smem;
  bf16_t* sV = sK + 64 * KSTR;
  bf16x8 qf[KS];
#pragma unroll
  for (int ks = 0; ks < KS; ++ks) qf[ks] = *(const bf16x8*)(a.q + (size_t)(a.qrow0 + w * 32 + r32) * a.ldq + ks * 16 + h * 8);
  f32x16 O[2], L;
#pragma unroll
  for (int i = 0; i < 16; ++i) { O[0][i] = 0.f; O[1][i] = 0.f; L[i] = a.has_sink ? 1.f : 0.f; }
  float mrow = a.has_sink ? a.sink2 : -1e30f;
  const bf16x8 ones = mk8(0x3F803F80u, 0x3F803F80u, 0x3F803F80u, 0x3F803F80u);
  const int ntiles = (a.seg0_n + a.seg1_n) >> 6;
  const int qpos = a.qpos0 + w * 32 + r32;
  uint4 pk0, pk1, pk2, pv0, pv1;
#define KR(i) ((tid + 256 * (i)) / KCH)
#define KQ(i) ((tid + 256 * (i)) % KCH)
#define KSRC(i, krow) ((!MLA || KQ(i) < 8) ? a.k + (size_t)((krow) + KR(i)) * a.ldk + KQ(i) * 8 : a.kpe + (size_t)((krow) + KR(i)) * 32 + (KQ(i) - 8) * 8)
  const int vr = tid >> 3, vq = tid & 7;
#define ATT_LOAD(t_) do { const int kk0_ = (t_) * 64; const int krow_ = kk0_ < a.seg0_n ? a.seg0_row + kk0_ : a.seg1_row + kk0_ - a.seg0_n; \
    pk0 = *(const uint4*)KSRC(0, krow_); pk1 = *(const uint4*)KSRC(1, krow_); if (MLA) pk2 = *(const uint4*)KSRC(2, krow_); \
    const bf16_t* vsrc_ = a.vt + ((size_t)(krow_ >> 6) * a.vt_heads + a.vhead) * 4096; \
    pv0 = *(const uint4*)(vsrc_ + vr * 64 + vq * 8); pv1 = *(const uint4*)(vsrc_ + (vr + 32) * 64 + vq * 8); } while (0)
  ATT_LOAD(0);
  for (int t = 0; t < ntiles; ++t) {
    const int kk0 = t * 64; const bool loc = kk0 < a.seg0_n;
    __syncthreads();
    *(uint4*)(sK + KR(0) * KSTR + KQ(0) * 8) = pk0; *(uint4*)(sK + KR(1) * KSTR + KQ(1) * 8) = pk1; if (MLA) *(uint4*)(sK + KR(2) * KSTR + KQ(2) * 8) = pk2;
    *(uint2*)(sV + vr * VSTR + vq * 8) = make_uint2(pv0.x, pv0.y); *(uint2*)(sV + vr * VSTR + vq * 8 + 4) = make_uint2(pv0.z, pv0.w);
    *(uint2*)(sV + (vr + 32) * VSTR + vq * 8) = make_uint2(pv1.x, pv1.y); *(uint2*)(sV + (vr + 32) * VSTR + vq * 8 + 4) = make_uint2(pv1.z, pv1.w);
    __syncthreads();
    if (t + 1 < ntiles) ATT_LOAD(t + 1);
    f32x16 S[2];
#pragma unroll
    for (int i = 0; i < 16; ++i) { S[0][i] = 0.f; S[1][i] = 0.f; }
#pragma unroll
    for (int ks = 0; ks < KS; ++ks)
#pragma unroll
      for (int kt = 0; kt < 2; ++kt) {
        bf16x8 kf = *(const bf16x8*)(sK + (kt * 32 + r32) * KSTR + ks * 16 + h * 8);
        S[kt] = MFMA32(kf, qf[ks], S[kt]);
      }
    const bool msk = a.band && loc;
    float m = -1e30f;
#pragma unroll
    for (int kt = 0; kt < 2; ++kt)
#pragma unroll
      for (int ri = 0; ri < 16; ++ri) {
        float v = S[kt][ri];
        if (msk) { int dlt = a.seg0_pos + kk0 + kt * 32 + (ri & 3) + 8 * (ri >> 2) + 4 * h - qpos; if (dlt > 128 || dlt < -128) v = -1e30f; S[kt][ri] = v; }
        m = fmaxf(m, v);
      }
    m = fmaxf(m, __shfl_xor(m, 32));
    if (__builtin_amdgcn_ballot_w64(m > mrow + 8.f) != 0ull) {
      const float mnew = fmaxf(mrow, m), alpha = ex2(mrow - mnew);
      mrow = mnew;
#pragma unroll
      for (int i = 0; i < 16; ++i) { O[0][i] *= alpha; O[1][i] *= alpha; L[i] *= alpha; }
    }
#pragma unroll
    for (int kt = 0; kt < 2; ++kt)
#pragma unroll
      for (int s2 = 0; s2 < 2; ++s2) {
        const bf16x8 pf = mk8(pack2(ex2(S[kt][8 * s2 + 0] - mrow), ex2(S[kt][8 * s2 + 1] - mrow)), pack2(ex2(S[kt][8 * s2 + 2] - mrow), ex2(S[kt][8 * s2 + 3] - mrow)),
                              pack2(ex2(S[kt][8 * s2 + 4] - mrow), ex2(S[kt][8 * s2 + 5] - mrow)), pack2(ex2(S[kt][8 * s2 + 6] - mrow), ex2(S[kt][8 * s2 + 7] - mrow)));
        L = MFMA32(ones, pf, L);
#pragma unroll
        for (int dt = 0; dt < 2; ++dt) {
          const bf16_t* vp = sV + (dt * 32 + r32) * VSTR + kt * 32 + 16 * s2 + 4 * h;
          const uint2 lo = *(const uint2*)vp, hi = *(const uint2*)(vp + 8);
          O[dt] = MFMA32(mk8(lo.x, lo.y, hi.x, hi.y), pf, O[dt]);
        }
      }
  }
#undef KR
#undef KQ
#undef KSRC
#undef ATT_LOAD
  {
    const float inv = 1.f / L[0];
    const size_t row = (size_t)(a.qrow0 + w * 32 + r32);
#pragma unroll
    for (int dt = 0; dt < 2; ++dt)
#pragma unroll
      for (int gq = 0; gq < 4; ++gq) {
        const int d0 = dt * 32 + 8 * gq + 4 * h;
        const uint2 gt = *(const uint2*)(a.gate + row * a.ldg + d0);
        const float o0 = O[dt][4 * gq + 0] * inv * bflo(gt.x), o1 = O[dt][4 * gq + 1] * inv * bfhi(gt.x), o2 = O[dt][4 * gq + 2] * inv * bflo(gt.y), o3 = O[dt][4 * gq + 3] * inv * bfhi(gt.y);
        if (dost) *(uint2*)(a.out + row * a.ldo + d0) = make_uint2(pack2(o0, o1), pack2(o2, o3));
      }
  }
}

template <int DK, bool MLA>
DI void attn_item2(const AttnArgs& a, unsigned char* smem) {
  constexpr int KS = DK / 16, KSTR = DK + 8, KCH = DK / 8, VSTR = 68;
  const int tid = threadIdx.x, lane = tid & 63, w = tid >> 6, r32 = lane & 31, h = lane >> 5;
  bf16_t* sK = (bf16_t*)smem;
  bf16_t* sV = sK + 64 * KSTR;
  bf16_t* sQ = sV + 64 * VSTR;
  __syncthreads();
  for (int c = tid; c < 256 * KCH; c += 256) { const int r = c / KCH, cc = c % KCH; *(uint4*)(sQ + r * KSTR + cc * 8) = *(const uint4*)(a.q + (size_t)(a.qrow0 + r) * a.ldq + cc * 8); }
  const bf16_t* sQw = sQ + (w * 64 + r32) * KSTR + h * 8;
  f32x16 O[2][2];
#pragma unroll
  for (int i = 0; i < 16; ++i) { O[0][0][i] = 0.f; O[0][1][i] = 0.f; O[1][0][i] = 0.f; O[1][1][i] = 0.f; }
  float mrow[2], lsum[2];
  mrow[0] = mrow[1] = a.has_sink ? a.sink2 : -1e30f;
  lsum[0] = lsum[1] = (a.has_sink && h == 0) ? 1.f : 0.f;
  const int ntiles = (a.seg0_n + a.seg1_n) >> 6;
  uint4 pk0, pk1, pk2, pv0, pv1;
#define KR(i) ((tid + 256 * (i)) / KCH)
#define KQ(i) ((tid + 256 * (i)) % KCH)
#define KSRC(i, krow) ((!MLA || KQ(i) < 8) ? a.k + (size_t)((krow) + KR(i)) * a.ldk + KQ(i) * 8 : a.kpe + (size_t)((krow) + KR(i)) * 32 + (KQ(i) - 8) * 8)
  const int vr = tid >> 3, vq = tid & 7;
#define ATT_LOAD(t_) do { const int kk0_ = (t_) * 64; const int krow_ = kk0_ < a.seg0_n ? a.seg0_row + kk0_ : a.seg1_row + kk0_ - a.seg0_n; \
    pk0 = *(const uint4*)KSRC(0, krow_); pk1 = *(const uint4*)KSRC(1, krow_); if (MLA) pk2 = *(const uint4*)KSRC(2, krow_); \
    const bf16_t* vsrc_ = a.vt + ((size_t)(krow_ >> 6) * a.vt_heads + a.vhead) * 4096; \
    pv0 = *(const uint4*)(vsrc_ + vr * 64 + vq * 8); pv1 = *(const uint4*)(vsrc_ + (vr + 32) * 64 + vq * 8); } while (0)
  ATT_LOAD(0);
  for (int t = 0; t < ntiles; ++t) {
    __syncthreads();
    *(uint4*)(sK + KR(0) * KSTR + KQ(0) * 8) = pk0; *(uint4*)(sK + KR(1) * KSTR + KQ(1) * 8) = pk1; if (MLA) *(uint4*)(sK + KR(2) * KSTR + KQ(2) * 8) = pk2;
    *(uint2*)(sV + vr * VSTR + vq * 8) = make_uint2(pv0.x, pv0.y); *(uint2*)(sV + vr * VSTR + vq * 8 + 4) = make_uint2(pv0.z, pv0.w);
    *(uint2*)(sV + (vr + 32) * VSTR + vq * 8) = make_uint2(pv1.x, pv1.y); *(uint2*)(sV + (vr + 32) * VSTR + vq * 8 + 4) = make_uint2(pv1.z, pv1.w);
    __syncthreads();
    if (t + 1 < ntiles) ATT_LOAD(t + 1);
    f32x16 S[2][2];
#pragma unroll
    for (int i = 0; i < 16; ++i) { S[0][0][i] = 0.f; S[0][1][i] = 0.f; S[1][0][i] = 0.f; S[1][1][i] = 0.f; }
#pragma unroll
    for (int ks = 0; ks < KS; ++ks)
#pragma unroll
      for (int kt = 0; kt < 2; ++kt) {
        bf16x8 kf = *(const bf16x8*)(sK + (kt * 32 + r32) * KSTR + ks * 16 + h * 8);
        const bf16x8 q0 = *(const bf16x8*)(sQw + ks * 16), q1 = *(const bf16x8*)(sQw + 32 * KSTR + ks * 16);
        S[0][kt] = MFMA32(kf, q0, S[0][kt]); S[1][kt] = MFMA32(kf, q1, S[1][kt]);
      }
    float mx[2];
#pragma unroll
    for (int gq = 0; gq < 2; ++gq) {
      float m = -1e30f;
#pragma unroll
      for (int kt = 0; kt < 2; ++kt)
#pragma unroll
        for (int ri = 0; ri < 16; ++ri) m = fmaxf(m, S[gq][kt][ri]);
      mx[gq] = fmaxf(m, __shfl_xor(m, 32));
    }
    if (__builtin_amdgcn_ballot_w64((mx[0] > mrow[0] + 8.f) || (mx[1] > mrow[1] + 8.f)) != 0ull) {
#pragma unroll
      for (int gq = 0; gq < 2; ++gq) {
        const float mnew = fmaxf(mrow[gq], mx[gq]), alpha = ex2(mrow[gq] - mnew);
        mrow[gq] = mnew; lsum[gq] *= alpha;
#pragma unroll
        for (int i = 0; i < 16; ++i) { O[gq][0][i] *= alpha; O[gq][1][i] *= alpha; }
      }
    }
#pragma unroll
    for (int kt = 0; kt < 2; ++kt)
#pragma unroll
      for (int s2 = 0; s2 < 2; ++s2) {
        bf16x8 pf[2];
#pragma unroll
        for (int gq = 0; gq < 2; ++gq) {
          float e[8];
#pragma unroll
          for (int j = 0; j < 8; ++j) e[j] = ex2(S[gq][kt][8 * s2 + j] - mrow[gq]);
          lsum[gq] += ((e[0] + e[1]) + (e[2] + e[3])) + ((e[4] + e[5]) + (e[6] + e[7]));
          pf[gq] = mk8(pack2(e[0], e[1]), pack2(e[2], e[3]), pack2(e[4], e[5]), pack2(e[6], e[7]));
        }
#pragma unroll
        for (int dt = 0; dt < 2; ++dt) {
          const bf16_t* vp = sV + (dt * 32 + r32) * VSTR + kt * 32 + 16 * s2 + 4 * h;
          const uint2 lo = *(const uint2*)vp, hi = *(const uint2*)(vp + 8);
          const bf16x8 vf = mk8(lo.x, lo.y, hi.x, hi.y);
          O[0][dt] = MFMA32(vf, pf[0], O[0][dt]); O[1][dt] = MFMA32(vf, pf[1], O[1][dt]);
        }
      }
  }
#undef KR
#undef KQ
#undef KSRC
#undef ATT_LOAD
#pragma unroll
  for (int gq = 0; gq < 2; ++gq) {
    const float l = lsum[gq] + __shfl_xor(lsum[gq], 32);
    const float inv = 1.f / l;
    const size_t row = (size_t)(a.qrow0 + w * 64 + gq * 32 + r32);
#pragma unroll
    for (int dt = 0; dt < 2; ++dt)
#pragma unroll
      for (int g4 = 0; g4 < 4; ++g4) {
        const int d0 = dt * 32 + 8 * g4 + 4 * h;
        const uint2 gt = *(const uint2*)(a.gate + row * a.ldg + d0);
        const float o0 = O[gq][dt][4 * g4 + 0] * inv * bflo(gt.x), o1 = O[gq][dt][4 * g4 + 1] * inv * bfhi(gt.x), o2 = O[gq][dt][4 * g4 + 2] * inv * bflo(gt.y), o3 = O[gq][dt][4 * g4 + 3] * inv * bfhi(gt.y);
        *(uint2*)(a.out + row * a.ldo + d0) = make_uint2(pack2(o0, o1), pack2(o2, o3));
      }
  }
}

DI void scan_item(const Params& p, int it, bool latent, bool dost = true) {
  const int tid = threadIdx.x;
  const int quarter = it & 3, head = (it >> 2) & 15, dir = (it >> 6) & 1, b = it >> 7;
  const int e = quarter * 1024 + tid * 4;
  const float* ST = (const float*)(p.ws + WS_STATES); const float* CD = (const float*)(p.ws + WS_CDEC);
  bf16_t* HIN = (bf16_t*)(p.ws + WS_HIN);
  float4 h = make_float4(0.f, 0.f, 0.f, 0.f);
  const int nc = latent ? 32 : 2, gc0 = latent ? 64 + b * 32 : b * 2;
  if (latent) h = *(const float4*)((dir == 0 ? p.in[I_SF] : p.in[I_SB]) + ((size_t)b * 16 + head) * 4096 + e);
  if (latent) {
    for (int s0 = 0; s0 < 32; s0 += 8) {
      float4 st[8]; float dec[8];
#pragma unroll
      for (int u = 0; u < 8; ++u) {
        const int c = dir == 0 ? s0 + u : 31 - s0 - u;
        const size_t base = ((size_t)((gc0 + c) * 2 + dir) * 16 + head);
        dec[u] = CD[base]; { const uint2 q2 = *(const uint2*)((const bf16_t*)ST + base * 4096 + e); st[u] = make_float4(bflo(q2.x), bfhi(q2.x), bflo(q2.y), bfhi(q2.y)); }
      }
#pragma unroll
      for (int u = 0; u < 8; ++u) {
        const int c = dir == 0 ? s0 + u : 31 - s0 - u;
        const size_t base = ((size_t)((gc0 + c) * 2 + dir) * 16 + head);
        if (dost) *(uint2*)(HIN + base * 4096 + e) = make_uint2(pack2(h.x, h.y), pack2(h.z, h.w));
        h.x = h.x * dec[u] + st[u].x; h.y = h.y * dec[u] + st[u].y; h.z = h.z * dec[u] + st[u].z; h.w = h.w * dec[u] + st[u].w;
      }
    }
  }
}
DI void scan_ctx_item(const Params& p, int it, bool dost = true) {
  const int tid = threadIdx.x;
  const int head = it & 15, dir = (it >> 4) & 1, b = it >> 5;
  const float* ST = (const float*)(p.ws + WS_STATES); const float* CD = (const float*)(p.ws + WS_CDEC);
  bf16_t* HIN = (bf16_t*)(p.ws + WS_HIN);
  const int c0 = dir == 0 ? 0 : 1, c1 = 1 - c0;
  const size_t b0 = ((size_t)((b * 2 + c0) * 2 + dir) * 16 + head), b1 = ((size_t)((b * 2 + c1) * 2 + dir) * 16 + head);
  const float dec1 = CD[b1];
  float4 s0[4], s1[4];
#pragma unroll
  for (int qq = 0; qq < 4; ++qq) { const int e = qq * 1024 + tid * 4; const uint2 q0 = *(const uint2*)((const bf16_t*)ST + b0 * 4096 + e), q1 = *(const uint2*)((const bf16_t*)ST + b1 * 4096 + e);
    s0[qq] = make_float4(bflo(q0.x), bfhi(q0.x), bflo(q0.y), bfhi(q0.y)); s1[qq] = make_float4(bflo(q1.x), bfhi(q1.x), bflo(q1.y), bfhi(q1.y)); }
#pragma unroll
  for (int qq = 0; qq < 4; ++qq) {
    const int e = qq * 1024 + tid * 4;
    if (dost) {
      *(uint2*)(HIN + b0 * 4096 + e) = make_uint2(0u, 0u);
      *(uint2*)(HIN + b1 * 4096 + e) = make_uint2(pack2(s0[qq].x, s0[qq].y), pack2(s0[qq].z, s0[qq].w));
    }
    *(float4*)(p.out + (dir == 0 ? O_SF : O_SB) + ((size_t)b * 16 + head) * 4096 + e) =
        make_float4(s0[qq].x * dec1 + s1[qq].x, s0[qq].y * dec1 + s1[qq].y, s0[qq].z * dec1 + s1[qq].z, s0[qq].w * dec1 + s1[qq].w);
  }
}
DI void attn_a_item(const Params& p, int it, bool latent, unsigned char* smem, bool dost = true) {
  AttnArgs a;
  const int qb = latent ? (it & 31) : (it & 1), head = latent ? ((it >> 5) & 7) : ((it >> 1) & 7), b = latent ? (it >> 8) : (it >> 4);
  const int kvh = head >> 2;
  const int seqrow = latent ? NCTX + b * 4096 : b * 256;
  a.q = (const bf16_t*)(p.ws + WS_QA) + head * 64; a.ldq = 512;
  a.k = (const bf16_t*)(p.ws + WS_KA) + kvh * 64; a.ldk = 128; a.kpe = nullptr;
  a.vt = (const bf16_t*)(p.ws + WS_VTA); a.vt_heads = 2; a.vhead = kvh;
  a.gate = (const bf16_t*)(p.ws + WS_GA) + head * 64; a.ldg = 512;
  a.out = (bf16_t*)(p.ws + WS_QA) + head * 64; a.ldo = 512;
  a.qrow0 = seqrow + qb * 128; a.qpos0 = qb * 128;
  if (latent) {
    int klo = qb * 128 - 128; if (klo < 0) klo = 0; int khi = qb * 128 + 256; if (khi > 4096) khi = 4096;
    a.seg0_row = seqrow + klo; a.seg0_n = khi - klo; a.seg0_pos = klo; a.band = 1;
    a.seg1_row = NTOK + b * 256; a.seg1_n = 256;
  } else {
    a.seg0_row = seqrow; a.seg0_n = 256; a.seg0_pos = 0; a.band = 0; a.seg1_row = 0; a.seg1_n = 0;
  }
  a.sink2 = p.in[I_SINK][head] * LOG2E; a.has_sink = 1; a.scale2 = 0.125f * LOG2E;
  attn_item<64, false>(a, smem, dost);
}
DI void phase_scan_attn_a(const Params& p, unsigned char* smem, bool dost = true) {
  for (int item = blockIdx.x; item < 2304; item += gridDim.x) {
    if (item < 512) attn_a_item(p, item, true, smem, dost);
    else if (item < 768) scan_item(p, item - 512, true, dost);
    else if (item < 1280) attn_a_item(p, item - 768, false, smem, dost);
    else scan_ctx_item(p, item - 1280, dost);
  }
}

DI void phase_ssd_out(const Params& p, unsigned char* smem, bool dost = true) {
  const int tid = threadIdx.x, lane = tid & 63, w = tid >> 6, lc = lane & 15, g = lane >> 4;
  bf16_t* sB = (bf16_t*)smem;
  bf16_t* sC = sB + 128 * 72;
  bf16_t* sX = sC + 128 * 72;
  bf16_t* sHf = sX + 64 * 136;
  bf16_t* sHb = sHf + 64 * 72;
  float* dtv = (float*)(sHb + 64 * 72);
  float* cumv = dtv + 256;
  const bf16_t* XT = (const bf16_t*)(p.ws + WS_XT); const bf16_t* BCM = (const bf16_t*)(p.ws + WS_BCM); const bf16_t* HIN = (const bf16_t*)(p.ws + WS_HIN);
  bf16_t* ZS = (bf16_t*)(p.ws + WS_ZS); float* SSQ = (float*)(p.ws + WS_SSQ);
  for (int item = blockIdx.x; item < 2048; item += gridDim.x) {
    const int gc = ((item >> 7) << 3) + (item & 7), head = (item >> 3) & 15, grp = head >> 3;
    int row0, s0, s1; chunk_rows(gc, row0, s0, s1);
    __syncthreads();
    if (w < 2) chunk_cums(p, row0, head, w, lane, dtv, cumv, nullptr);
#pragma unroll
    for (int i = 0; i < 4; ++i) {
      int id = tid + 256 * i;
      { int r = id >> 3, c8 = id & 7;
        *(uint4*)(sB + r * 72 + c8 * 8) = *(const uint4*)(BCM + (size_t)(row0 + r) * 256 + grp * 64 + c8 * 8);
        *(uint4*)(sC + r * 72 + c8 * 8) = *(const uint4*)(BCM + (size_t)(row0 + r) * 256 + 128 + grp * 64 + c8 * 8); }
      { int r = id >> 4, c16 = id & 15; *(uint4*)(sX + r * 136 + c16 * 8) = *(const uint4*)(XT + ((size_t)gc * 1024 + head * 64 + r) * 128 + c16 * 8); }
    }
#pragma unroll
    for (int i = 0; i < 2; ++i) {
      int id = tid + 256 * i, r = id >> 3, c8 = id & 7;
      *(uint4*)(sHf + r * 72 + c8 * 8) = *(const uint4*)(HIN + ((size_t)(gc * 2 + 0) * 16 + head) * 4096 + r * 64 + c8 * 8);
      *(uint4*)(sHb + r * 72 + c8 * 8) = *(const uint4*)(HIN + ((size_t)(gc * 2 + 1) * 16 + head) * 4096 + r * 64 + c8 * 8);
    }
    __syncthreads();
    bf16x8 cf[2][2];
#pragma unroll
    for (int lt = 0; lt < 2; ++lt)
#pragma unroll
      for (int ks = 0; ks < 2; ++ks) cf[lt][ks] = *(const bf16x8*)(sC + (w * 32 + lt * 16 + lc) * 72 + ks * 32 + g * 8);
    float cfl[2], crl[2];
#pragma unroll
    for (int lt = 0; lt < 2; ++lt) { cfl[lt] = cumv[w * 32 + lt * 16 + lc]; crl[lt] = cumv[128 + w * 32 + lt * 16 + lc]; }
    f32x4 Y[4][2], T[4][2];
#pragma unroll
    for (int pt = 0; pt < 4; ++pt) { T[pt][0] = f32x4{0, 0, 0, 0}; T[pt][1] = f32x4{0, 0, 0, 0}; }
#pragma unroll
    for (int ks = 0; ks < 2; ++ks)
#pragma unroll
      for (int pt = 0; pt < 4; ++pt) {
        bf16x8 hf = *(const bf16x8*)(sHf + (pt * 16 + lc) * 72 + ks * 32 + g * 8);
        T[pt][0] = MFMA16(hf, cf[0][ks], T[pt][0]); T[pt][1] = MFMA16(hf, cf[1][ks], T[pt][1]);
      }
    {
      float e0 = ex2(cfl[0]), e1 = ex2(cfl[1]);
#pragma unroll
      for (int pt = 0; pt < 4; ++pt) { Y[pt][0] = T[pt][0] * e0; Y[pt][1] = T[pt][1] * e1; }
    }
#pragma unroll
    for (int pt = 0; pt < 4; ++pt) { T[pt][0] = f32x4{0, 0, 0, 0}; T[pt][1] = f32x4{0, 0, 0, 0}; }
#pragma unroll
    for (int ks = 0; ks < 2; ++ks)
#pragma unroll
      for (int pt = 0; pt < 4; ++pt) {
        bf16x8 hb = *(const bf16x8*)(sHb + (pt * 16 + lc) * 72 + ks * 32 + g * 8);
        T[pt][0] = MFMA16(hb, cf[0][ks], T[pt][0]); T[pt][1] = MFMA16(hb, cf[1][ks], T[pt][1]);
      }
    {
      float e0 = ex2(crl[0]), e1 = ex2(crl[1]);
#pragma unroll
      for (int pt = 0; pt < 4; ++pt) { Y[pt][0] += T[pt][0] * e0; Y[pt][1] += T[pt][1] * e1; }
    }
    const float dskip = p.in[I_DSKIP][head];
#pragma unroll
    for (int sb = 0; sb < 2; ++sb) {
      f32x4 S[4][2];
#pragma unroll
      for (int st = 0; st < 4; ++st) { S[st][0] = f32x4{0, 0, 0, 0}; S[st][1] = f32x4{0, 0, 0, 0}; }
#pragma unroll
      for (int ks = 0; ks < 2; ++ks)
#pragma unroll
        for (int st = 0; st < 4; ++st) {
          bf16x8 bf = *(const bf16x8*)(sB + (sb * 64 + st * 16 + lc) * 72 + ks * 32 + g * 8);
          S[st][0] = MFMA16(bf, cf[0][ks], S[st][0]); S[st][1] = MFMA16(bf, cf[1][ks], S[st][1]);
        }
#pragma unroll
      for (int st = 0; st < 4; ++st) {
        const int sbase = sb * 64 + st * 16 + 4 * g;
        const f32x4 rfs = *(const f32x4*)(dtv + sbase), rbs = *(const f32x4*)(dtv + 128 + sbase);
#pragma unroll
        for (int lt = 0; lt < 2; ++lt) {
          int l = w * 32 + lt * 16 + lc;
          asm volatile("" : "+v"(l));
#pragma unroll
          for (int r = 0; r < 4; ++r) {
            const int s = sbase + r;
            const float af = s <= l ? cfl[lt] - rfs[r] : -1e30f, ab = s >= l ? crl[lt] - rbs[r] : -1e30f;
            S[st][lt][r] = S[st][lt][r] * (ex2(af) + ex2(ab)) + (s == l ? dskip : 0.f);
          }
        }
      }
      bf16x8 pf[2][2];
#pragma unroll
      for (int lt = 0; lt < 2; ++lt)
#pragma unroll
        for (int k2 = 0; k2 < 2; ++k2)
          pf[lt][k2] = mk8(pack2(S[2 * k2][lt][0], S[2 * k2][lt][1]), pack2(S[2 * k2][lt][2], S[2 * k2][lt][3]),
                           pack2(S[2 * k2 + 1][lt][0], S[2 * k2 + 1][lt][1]), pack2(S[2 * k2 + 1][lt][2], S[2 * k2 + 1][lt][3]));
#pragma unroll
      for (int pt = 0; pt < 4; ++pt)
#pragma unroll
        for (int k2 = 0; k2 < 2; ++k2) {
          uint2 lo = *(const uint2*)(sX + (pt * 16 + lc) * 136 + sb * 64 + k2 * 32 + 4 * g);
          uint2 hi = *(const uint2*)(sX + (pt * 16 + lc) * 136 + sb * 64 + k2 * 32 + 16 + 4 * g);
          bf16x8 xf = mk8(lo.x, lo.y, hi.x, hi.y);
          Y[pt][0] = MFMA16(xf, pf[0][k2], Y[pt][0]); Y[pt][1] = MFMA16(xf, pf[1][k2], Y[pt][1]);
        }
    }
#pragma unroll
    for (int lt = 0; lt < 2; ++lt) {
      const size_t row = (size_t)(row0 + w * 32 + lt * 16 + lc);
      float ss = 0.f;
#pragma unroll
      for (int pt = 0; pt < 4; ++pt) {
        bf16_t* zp = ZS + row * 1024 + head * 64 + pt * 16 + 4 * g;
        uint2 z = *(const uint2*)zp;
        float o0 = Y[pt][lt][0] * bflo(z.x), o1 = Y[pt][lt][1] * bfhi(z.x), o2 = Y[pt][lt][2] * bflo(z.y), o3 = Y[pt][lt][3] * bfhi(z.y);
        ss += o0 * o0 + o1 * o1 + o2 * o2 + o3 * o3;
        if (dost) *(uint2*)zp = make_uint2(pack2(o0, o1), pack2(o2, o3));
      }
      ss += __shfl_xor(ss, 16); ss += __shfl_xor(ss, 32);
      if (g == 0 && dost) SSQ[row * 16 + head] = ss;
    }
  }
}

DI void resid_epilogue(const Params& p, f32x4 (&acc)[4][4], int layer, int m0, int n0, unsigned char* smem) {
  const int tid = threadIdx.x, lane = tid & 63, w = tid >> 6, wm = w >> 1, wn = w & 1;
  const int cond = cond_of(m0);
  const float* wb = stage_wave_tile(acc, smem);
  const int c4 = (lane & 15) * 4, colb = n0 + wn * 64 + c4;
  const float4 gt = *(const float4*)((const float*)(p.ws + WS_MODP) + (layer * 3 + cond) * 3072 + 2048 + colb);
  bf16_t* X1B = (bf16_t*)(p.ws + WS_X1B);
#pragma unroll 4
  for (int it = 0; it < 16; ++it) {
    const int rl = it * 4 + (lane >> 4), row = m0 + wm * 64 + rl;
    const float4 av = *(const float4*)(wb + rl * 68 + c4);
    if (layer == 0) {
      const float* xr = row < NCTX ? p.in[I_XP] + (size_t)row * 1024 : p.in[I_XS] + (size_t)(row - NCTX) * 1024;
      const float4 xv = *(const float4*)(xr + colb);
      *(uint2*)(X1B + (size_t)row * 1024 + colb) = pk4(make_float4(xv.x + gt.x * av.x, xv.y + gt.y * av.y, xv.z + gt.z * av.z, xv.w + gt.w * av.w));
    } else {
      const uint2 xb = *(const uint2*)(X1B + (size_t)row * 1024 + colb);
      const float4 v = make_float4(bflo(xb.x) + gt.x * av.x, bfhi(xb.x) + gt.y * av.y, bflo(xb.y) + gt.z * av.z, bfhi(xb.y) + gt.w * av.w);
      *(uint2*)((bf16_t*)(p.ws + WS_X2B) + (size_t)row * 1024 + colb) = pk4(v);
      float ss = v.x * v.x + v.y * v.y + v.z * v.z + v.w * v.w;
      ss += __shfl_xor(ss, 8); ss += __shfl_xor(ss, 4); ss += __shfl_xor(ss, 2); ss += __shfl_xor(ss, 1);
      if ((lane & 15) == 0) __hip_atomic_fetch_add((float*)(p.ws + WS_ROWSQ) + row, ss, __ATOMIC_RELAXED, __HIP_MEMORY_SCOPE_AGENT);
    }
  }
}
DI void phase_ab_out(const Params& p, unsigned char* smem) {
  const int tid = threadIdx.x, lane = tid & 63, w = tid >> 6, wm = w >> 1, g = lane >> 4;
  float* srs = (float*)(smem + 65536);
  const float* SSQ = (const float*)(p.ws + WS_SSQ);
  const bf16_t* W = (const bf16_t*)(p.ws + W_ABOUT);
  for (int tile = blockIdx.x; tile < 128 * 8; tile += gridDim.x) {
    int mt, nt; xcd_tile(tile, 8, mt, nt); const int m0 = mt * 128, n0 = nt * 128;
    __syncthreads();
    if (tid < 128) {
      const float4* s = (const float4*)(SSQ + (size_t)(m0 + tid) * 16);
      float4 a = s[0], b = s[1], c = s[2], d = s[3];
      float t = a.x + a.y + a.z + a.w + b.x + b.y + b.z + b.w + c.x + c.y + c.z + c.w + d.x + d.y + d.z + d.w;
      srs[tid] = rsqrtf(t * (1.f / 1024.f) + EPS);
    }
    f32x4 acc[4][4]; acc_zero(acc);
    gemm_mainloop(acc, (const bf16_t*)(p.ws + WS_ZS), 1024, W + 512, 1536, 1024, m0, n0, smem);
#pragma unroll
    for (int i = 0; i < 4; ++i)
#pragma unroll
      for (int r = 0; r < 4; ++r) {
        float rs = srs[wm * 64 + i * 16 + 4 * g + r];
#pragma unroll
        for (int j = 0; j < 4; ++j) acc[i][j][r] *= rs;
      }
    gemm_mainloop(acc, (const bf16_t*)(p.ws + WS_QA), 512, W, 1536, 512, m0, n0, smem);
    resid_epilogue(p, acc, 0, m0, n0, smem);
  }
}
DI void phase_mla_out(const Params& p, unsigned char* smem) {
  for (int tile = blockIdx.x; tile < 128 * 8; tile += gridDim.x) {
    int mt, nt; xcd_tile(tile, 8, mt, nt); const int m0 = mt * 128, n0 = nt * 128;
    f32x4 acc[4][4]; acc_zero(acc);
    gemm_mainloop(acc, (const bf16_t*)(p.ws + WS_AOM), 1024, (const bf16_t*)(p.ws + W_MOUT), 1024, 1024, m0, n0, smem);
    resid_epilogue(p, acc, 1, m0, n0, smem);
  }
}

DI void phase_mla_in(const Params& p, unsigned char* smem) {
  const int tid = threadIdx.x, lane = tid & 63, w = tid >> 6, wm = w >> 1, wn = w & 1, lc = lane & 15, g = lane >> 4;
  bf16_t* GM = (bf16_t*)(p.ws + WS_GM);
  constexpr int NT = MIN_N / 128;
  for (int tile = blockIdx.x; tile < 128 * NT; tile += gridDim.x) {
    int mt, nt; xcd_tile(tile, NT, mt, nt); const int m0 = mt * 128, n0 = nt * 128;
    f32x4 acc[4][4]; acc_zero(acc);
    gemm_mainloop(acc, (const bf16_t*)(p.ws + WS_H), 1024, (const bf16_t*)(p.ws + W_MIN), 1024, 1024, m0, n0, smem);
    const int rb = m0 + wm * 64, cb = n0 + wn * 64;
    const float* wb = stage_wave_tile(acc, smem);
    const int c4 = (lane & 15) * 4, col = cb + c4;
    if (n0 < 256) {
      bf16_t* CQB = (bf16_t*)(p.ws + WS_CQN); float* rsq = (float*)(p.ws + WS_ROWSQ_Q);
#pragma unroll 4
      for (int it = 0; it < 16; ++it) {
        const int rl = it * 4 + (lane >> 4); const size_t row = (size_t)(rb + rl);
        const float4 v = *(const float4*)(wb + rl * 68 + c4);
        *(uint2*)(CQB + row * 256 + col) = pk4(v);
        float ss = v.x * v.x + v.y * v.y + v.z * v.z + v.w * v.w;
        ss += __shfl_xor(ss, 8); ss += __shfl_xor(ss, 4); ss += __shfl_xor(ss, 2); ss += __shfl_xor(ss, 1);
        if ((lane & 15) == 0) __hip_atomic_fetch_add(rsq + row, ss, __ATOMIC_RELAXED, __HIP_MEMORY_SCOPE_AGENT);
      }
    } else if (n0 < 384) {
      float* ex = (float*)(smem + 69632);
#pragma unroll 4
      for (int it = 0; it < 16; ++it) {
        const int rl = it * 4 + (lane >> 4);
        const float4 v = *(const float4*)(wb + rl * 68 + c4);
        float ss = v.x * v.x + v.y * v.y + v.z * v.z + v.w * v.w;
        ss += __shfl_xor(ss, 8); ss += __shfl_xor(ss, 4); ss += __shfl_xor(ss, 2); ss += __shfl_xor(ss, 1);
        if ((lane & 15) == 0) ex[(wm * 2 + wn) * 64 + rl] = ss;
      }
      __syncthreads();
      bf16_t* CKVN = (bf16_t*)(p.ws + WS_CKVN);
      const float4 nw = *(const float4*)(p.in[I_KVNW] + col - 256);
#pragma unroll 4
      for (int it = 0; it < 16; ++it) {
        const int rl = it * 4 + (lane >> 4); const size_t row = (size_t)(rb + rl);
        const float rs = rsqrtf((ex[(wm * 2 + 0) * 64 + rl] + ex[(wm * 2 + 1) * 64 + rl]) * (1.f / 128.f) + EPS);
        const float4 v = *(const float4*)(wb + rl * 68 + c4);
        const float4 o = make_float4(v.x * rs * nw.x, v.y * rs * nw.y, v.z * rs * nw.z, v.w * rs * nw.w);
        *(uint2*)(CKVN + row * 128 + col - 256) = pk4(o);
        if (m0 < NCTX) *(float4*)(p.out + O_CKV + row * 128 + col - 256) = o;
      }
    } else if (n0 < 1408) {
#pragma unroll 4
      for (int it = 0; it < 16; ++it) {
        const int rl = it * 4 + (lane >> 4); const size_t row = (size_t)(rb + rl);
        *(uint2*)(GM + row * 1024 + col - 384) = pk4(silu4(*(const float4*)(wb + rl * 68 + c4)));
      }
    } else if (wn == 0) {
      bf16_t* KPEB = (bf16_t*)(p.ws + WS_KPEB);
      const bool lat = m0 >= NCTX;
#pragma unroll 4
      for (int it = 0; it < 16; ++it) {
        const int rl = it * 4 + (lane >> 4); const size_t row = (size_t)(rb + rl);
        const float4 v = *(const float4*)(wb + rl * 68 + c4);
        const float4 pr = make_float4(__shfl_xor(v.x, 2), __shfl_xor(v.y, 2), __shfl_xor(v.z, 2), __shfl_xor(v.w, 2));
        float4 o = v;
        if (lat) {
          const int l = (int)(row - NCTX) & 4095;
          const float pos = (c4 & 16) ? (float)(l & 63) : (float)(l >> 6);
          const float vv[4] = {v.x, v.y, v.z, v.w}, pp[4] = {pr.x, pr.y, pr.z, pr.w}; float oo[4];
#pragma unroll
          for (int e = 0; e < 4; ++e) {
            const float th = pos * ex2(-(float)((c4 + e) & 7) * (13.287712379549449f / 8.f)), c = __cosf(th), sn = __sinf(th);
            oo[e] = (c4 & 8) ? vv[e] * c + pp[e] * sn : vv[e] * c - pp[e] * sn;
          }
          o = make_float4(oo[0], oo[1], oo[2], oo[3]);
        }
        if (c4 < 32) {
          *(uint2*)(KPEB + row * 32 + c4) = pk4(o);
          if (!lat) *(float4*)(p.out + O_KPE + row * 32 + c4) = v;
        }
      }
    }
  }
}

DI void mla_cache_convert(const Params& p) {
  bf16_t* CKVN = (bf16_t*)(p.ws + WS_CKVN) + (size_t)NTOK * 128; bf16_t* KPEB = (bf16_t*)(p.ws + WS_KPEB) + (size_t)NTOK * 32;
  for (int i = blockIdx.x * 256 + threadIdx.x; i < (65536 + 16384) / 4; i += gridDim.x * 256) {
    if (i < 16384) { float4 v = ((const float4*)p.in[I_CCKV])[i]; *(uint2*)(CKVN + i * 4) = make_uint2(pack2(v.x, v.y), pack2(v.z, v.w)); }
    else { int k = i - 16384; float4 v = ((const float4*)p.in[I_CKPE])[k]; *(uint2*)(KPEB + k * 4) = make_uint2(pack2(v.x, v.y), pack2(v.z, v.w)); }
  }
}
DI void phase_mla_prep(const Params& p) {
  const int tid = threadIdx.x, lane = tid & 63, w = tid >> 6;
  const float* CQ = (const float*)(p.ws + WS_CQ); const float* CKV = (const float*)(p.ws + WS_CKV); const float* KPE = (const float*)(p.ws + WS_KPE);
  bf16_t* CQN = (bf16_t*)(p.ws + WS_CQN); bf16_t* CKVN = (bf16_t*)(p.ws + WS_CKVN); bf16_t* KPEB = (bf16_t*)(p.ws + WS_KPEB);
  for (int item = blockIdx.x; item < NTOK / 4; item += gridDim.x) {
    const size_t row = (size_t)item * 4 + w;
    {
      float4 v = *(const float4*)(CQ + row * 256 + lane * 4);
      float ss = wave_sum(v.x * v.x + v.y * v.y + v.z * v.z + v.w * v.w);
      float rs = rsqrtf(ss * (1.f / 256.f) + EPS);
      float4 nw = *(const float4*)(p.in[I_QNW] + lane * 4);
      *(uint2*)(CQN + row * 256 + lane * 4) = make_uint2(pack2(v.x * rs * nw.x, v.y * rs * nw.y), pack2(v.z * rs * nw.z, v.w * rs * nw.w));
    }
    {
      float2 v = *(const float2*)(CKV + row * 128 + lane * 2);
      float ss = wave_sum(v.x * v.x + v.y * v.y);
      float rs = rsqrtf(ss * (1.f / 128.f) + EPS);
      float2 nw = *(const float2*)(p.in[I_KVNW] + lane * 2);
      float a = v.x * rs * nw.x, b = v.y * rs * nw.y;
      *(unsigned*)(CKVN + row * 128 + lane * 2) = pack2(a, b);
      if (row < NCTX) *(float2*)(p.out + O_CKV + row * 128 + lane * 2) = make_float2(a, b);
    }
    {
      float v = lane < 32 ? KPE[row * 32 + lane] : 0.f;
      float pr = __shfl_xor(v, 8);
      float o = v;
      if (row >= NCTX) {
        int l = (int)(row - NCTX) & 4095;
        float pos = (lane & 16) ? (float)(l & 63) : (float)(l >> 6);
        float th = pos * ex2(-(float)(lane & 7) * (13.287712379549449f / 8.f));
        float c = __cosf(th), s = __sinf(th);
        o = (lane & 8) ? v * c + pr * s : v * c - pr * s;
      } else if (lane < 32) p.out[O_KPE + row * 32 + lane] = v;
      if (lane < 32) KPEB[row * 32 + lane] = f2bf(o);
    }
  }
}

DI void phase_mla_up(const Params& p, unsigned char* smem) {
  const int tid = threadIdx.x, lane = tid & 63, w = tid >> 6, wm = w >> 1, wn = w & 1, lc = lane & 15, g = lane >> 4;
  bf16_t* QM = (bf16_t*)(p.ws + WS_QM); bf16_t* KN = (bf16_t*)(p.ws + WS_KNOPE); bf16_t* VTM = (bf16_t*)(p.ws + WS_VTM);
  constexpr int NQ = 128 * 12, NKV = 132 * 16;
  for (int tile = blockIdx.x; tile < NQ + NKV; tile += gridDim.x) {
    f32x4 acc[4][4]; acc_zero(acc);
    if (tile < NQ) {
      int mt, nt; xcd_tile(tile, 12, mt, nt); const int m0 = mt * 128, n0 = nt * 128;
      gemm_mainloop(acc, (const bf16_t*)(p.ws + WS_CQN), 256, (const bf16_t*)(p.ws + W_UQ), 256, 256, m0, n0, smem);
      const int rb = m0 + wm * 64, cb = n0 + wn * 64; const bool lat = m0 >= NCTX;
      const float inv = ex2(-(float)(lc & 7) * (13.287712379549449f / 8.f));
      if (lat) {
#pragma unroll
        for (int j = 0; j < 4; ++j) {
          const int col0 = cb + j * 16, d0 = col0 % 96;
          if (d0 >= 64) {
#pragma unroll
            for (int i = 0; i < 4; ++i)
#pragma unroll
              for (int r = 0; r < 4; ++r) {
                const int row = rb + i * 16 + 4 * g + r;
                float v = acc[i][j][r];
                float pr = __shfl_xor(v, 8);
                int l = (row - NCTX) & 4095;
                float pos = d0 >= 80 ? (float)(l & 63) : (float)(l >> 6);
                float th = pos * inv, c = __cosf(th), sn = __sinf(th);
                acc[i][j][r] = (lc & 8) ? v * c + pr * sn : v * c - pr * sn;
              }
          }
        }
      }
      {
        const float* wb = stage_wave_tile(acc, smem);
        const int c4 = (lane & 15) * 4; const float qs = 0.10206207261596575f * LOG2E;
#pragma unroll 4
        for (int it = 0; it < 16; ++it) {
          const int rl = it * 4 + (lane >> 4); const size_t row = (size_t)(rb + rl);
          const float4 v = *(const float4*)(wb + rl * 68 + c4);
          const float qr = qs * rsqrtf(((const float*)(p.ws + WS_ROWSQ_Q))[row] * (1.f / 256.f) + EPS);
          *(uint2*)(QM + row * 1536 + cb + c4) = pk4(make_float4(v.x * qr, v.y * qr, v.z * qr, v.w * qr));
        }
      }
    } else {
      const int t2 = tile - NQ; int mt, head; if (t2 < 128 * 16) xcd_tile(t2, 16, mt, head); else { mt = t2 >> 4; head = t2 & 15; } const int m0 = mt * 128, n0 = head * 128;
      gemm_mainloop(acc, (const bf16_t*)(p.ws + WS_CKVN), 128, (const bf16_t*)(p.ws + W_UKV), 128, 128, m0, n0, smem);
      const int rb = m0 + wm * 64;
      if (wn == 0) {
        const float* wb = stage_wave_tile(acc, smem);
        const int c4 = (lane & 15) * 4;
#pragma unroll 4
        for (int it = 0; it < 16; ++it) {
          const int rl = it * 4 + (lane >> 4);
          *(uint2*)(KN + (size_t)(rb + rl) * 1024 + head * 64 + c4) = pk4(*(const float4*)(wb + rl * 68 + c4));
        }
      } else {
#pragma unroll
        for (int i = 0; i < 4; ++i)
#pragma unroll
          for (int j = 0; j < 4; ++j) {
            int row = rb + i * 16 + 4 * g, d = j * 16 + lc;
            *(uint2*)(VTM + ((size_t)(row >> 6) * 16 + head) * 4096 + d * 64 + (row & 63)) = make_uint2(pack2(acc[i][j][0], acc[i][j][1]), pack2(acc[i][j][2], acc[i][j][3]));
          }
      }
    }
  }
}

DI void phase_mla_attn(const Params& p, unsigned char* smem) {
  for (int item = blockIdx.x; item < 1024; item += gridDim.x) {
    AttnArgs a;
    const bool latent = item < 512;
    const int it = latent ? item : item - 512;
    int qb, head, b;
    if (latent) { const int x = it & 7, j = it >> 3, pair = x * 4 + (j >> 4); qb = j & 15; head = pair & 15; b = pair >> 4; }
    else { qb = 0; head = it & 15; b = it >> 4; }
    const int seqrow = latent ? NCTX + b * 4096 : b * 256;
    a.q = (const bf16_t*)(p.ws + WS_QM) + head * 96; a.ldq = 1536;
    a.k = (const bf16_t*)(p.ws + WS_KNOPE) + head * 64; a.ldk = 1024; a.kpe = (const bf16_t*)(p.ws + WS_KPEB);
    a.vt = (const bf16_t*)(p.ws + WS_VTM); a.vt_heads = 16; a.vhead = head;
    a.gate = (const bf16_t*)(p.ws + WS_GM) + head * 64; a.ldg = 1024;
    a.out = (bf16_t*)(p.ws + WS_AOM) + head * 64; a.ldo = 1024;
    a.qrow0 = seqrow + qb * 256; a.qpos0 = qb * 256;
    a.seg0_row = seqrow; a.seg0_n = latent ? 4096 : 256; a.seg0_pos = 0; a.band = 0;
    a.seg1_row = NTOK + b * 256; a.seg1_n = latent ? 256 : 0;
    a.sink2 = 0.f; a.has_sink = 0; a.scale2 = 1.f;
    attn_item2<96, true>(a, smem);
  }
}

DI void phase_final_norm(const Params& p) {
  const int tid = threadIdx.x;
  const bf16_t* X2B = (const bf16_t*)(p.ws + WS_X2B); const float* rowsq = (const float*)(p.ws + WS_ROWSQ);
  const int c8 = (tid & 127) * 8;
  const float4 w0 = *(const float4*)(p.in[I_FNW] + c8), w1 = *(const float4*)(p.in[I_FNW] + c8 + 4);
  for (int item = blockIdx.x; item < NTOK / 2; item += gridDim.x) {
    const size_t row = (size_t)item * 2 + (tid >> 7);
    const float rs = rsqrtf(rowsq[row] * (1.f / 1024.f) + EPS);
    const uint4 u = *(const uint4*)(X2B + row * 1024 + c8);
    float* o = p.out + O_Y + row * 1024 + c8;
    *(float4*)o = make_float4(bflo(u.x) * rs * w0.x, bfhi(u.x) * rs * w0.y, bflo(u.y) * rs * w0.z, bfhi(u.y) * rs * w0.w);
    *(float4*)(o + 4) = make_float4(bflo(u.z) * rs * w1.x, bfhi(u.z) * rs * w1.y, bflo(u.w) * rs * w1.z, bfhi(u.w) * rs * w1.w);
  }
}

#define XB_TMO      128
#define XB_XCNT(j)  (256  + 64 * (j))
#define XB_XSUB(j)  (1280 + 64 * (j))
#define XB_XGEN(j)  (2304 + 64 * (j))
#define XB_TOP      3328
#define XB_TOPGEN   3392
#define XCD_BAR_WORDS 3456
#define XB_SPIN_CAP (1u << 18)
#define LAS __attribute__((address_space(3)))

__device__ __forceinline__ unsigned xb_ld(unsigned* p)              { return __hip_atomic_load(p, __ATOMIC_RELAXED, __HIP_MEMORY_SCOPE_AGENT); }
__device__ __forceinline__ unsigned xb_add(unsigned* p, unsigned v) { return __hip_atomic_fetch_add(p, v, __ATOMIC_RELAXED, __HIP_MEMORY_SCOPE_AGENT); }
__device__ __forceinline__ unsigned xb_xcc_id() { return (unsigned)__builtin_amdgcn_s_getreg((3 << 11) | 20) & 0xFu; }
#define XB_SPIN(cond, bar) do { unsigned _sp = 0; while (cond) { __builtin_amdgcn_s_sleep(1); \
    if ((++_sp & 255u) == 0u) { if (xb_ld(&(bar)[XB_TMO])) break; if (_sp > XB_SPIN_CAP) { atomicAdd(&(bar)[XB_TMO], 1u); break; } } } } while (0)

struct XcdBarrier {
    unsigned* bar; unsigned x;
    volatile LAS unsigned* st;
};

__device__ __forceinline__ XcdBarrier xcd_barrier_post(unsigned* bar, volatile LAS unsigned* st) {
    XcdBarrier b; b.bar = bar; b.x = xb_xcc_id(); b.st = st;
    if (threadIdx.x == 0) (void)xb_add(&bar[XB_XCNT(b.x)], 1u);
    return b;
}
__device__ __forceinline__ void xcd_barrier_complete(unsigned* bar, unsigned x, unsigned& nloc, unsigned& nx) {
    const unsigned G = gridDim.x * gridDim.y * gridDim.z;
    unsigned sum, cnt, mine, sp = 0u;
    for (;;) {
        sum = 0u; cnt = 0u; mine = 0u;
#pragma unroll
        for (unsigned j = 0; j < 16; ++j) { const unsigned c = xb_ld(&bar[XB_XCNT(j)]); sum += c; cnt += (c > 0u) ? 1u : 0u; mine = (j == x) ? c : mine; }
        if (sum == G) break;
        __builtin_amdgcn_s_sleep(1);
        if ((++sp & 255u) == 0u) { if (xb_ld(&bar[XB_TMO])) break; if (sp > XB_SPIN_CAP) { atomicAdd(&bar[XB_TMO], 1u); break; } }
    }
    nloc = mine > 0u ? mine : 1u; nx = cnt > 0u ? cnt : 1u;
}

__device__ __forceinline__ void xcd_barrier(const XcdBarrier& b) {
    asm volatile("s_waitcnt vmcnt(0)" ::: "memory");
    __syncthreads();
    if (threadIdx.x == 0) {
        unsigned* bar = b.bar;
        __builtin_amdgcn_s_waitcnt(0);
        unsigned nloc = b.st[0], nx = b.st[1];
        if (nloc == 0u) { xcd_barrier_complete(bar, b.x, nloc, nx); b.st[0] = nloc; b.st[1] = nx; }
        const unsigned old = xb_add(&bar[XB_XSUB(b.x)], 1u);
        const unsigned gen = old / nloc;
        if (old + 1u == (gen + 1u) * nloc) {
            __builtin_amdgcn_fence(__ATOMIC_RELEASE, "agent");
            asm volatile("s_waitcnt vmcnt(0)" ::: "memory");
            const unsigned og = xb_add(&bar[XB_TOP], 1u);
            const unsigned tg = og / nx;
            if (og + 1u == (tg + 1u) * nx) xb_add(&bar[XB_TOPGEN], 1u);
            else XB_SPIN(xb_ld(&bar[XB_TOPGEN]) == tg, bar);
            __builtin_amdgcn_fence(__ATOMIC_ACQUIRE, "agent");
            xb_add(&bar[XB_XGEN(b.x)], 1u);
            asm volatile("s_waitcnt vmcnt(0)" ::: "memory");
        } else {
            XB_SPIN(xb_ld(&bar[XB_XGEN(b.x)]) == gen, bar);
            __builtin_amdgcn_fence(__ATOMIC_ACQUIRE, "agent");
            asm volatile("s_waitcnt vmcnt(0)" ::: "memory");
        }
    }
    __syncthreads();
}


constexpr int N_PHASES = 15;
__global__ void __launch_bounds__(256, 2) mega(Params p) {
  __shared__ __attribute__((aligned(16))) unsigned char smem[75 * 1024];
  volatile LAS unsigned* xst = (volatile LAS unsigned*)(smem + 75 * 1024 - 16);
  if (threadIdx.x == 0) { xst[0] = 0u; xst[1] = 0u; }
  __syncthreads();
  XcdBarrier xb = xcd_barrier_post((unsigned*)(p.ws + WS_BAR), xst);
  if (p.ph_hi > 1000) cg::this_grid().sync();
#ifndef PROBE_D
#define PROBE_D 0
#endif
#ifndef REPEAT_MASK
#define REPEAT_MASK 0
#endif
#define PHASE(n, ...) if (p.ph_lo <= n && n < p.ph_hi) { __VA_ARGS__; if ((REPEAT_MASK >> n) & 1) { __VA_ARGS__; } if (n + 1 < p.ph_hi) xcd_barrier(xb); }
  PHASE(1, phase0(p, smem); for (int t = blockIdx.x; t < N_WT; t += gridDim.x) wt_item(p, t, smem + 24576); phase_modnorm(p, 0, smem))
  PHASE(2, phase_ab_in(p, smem))
  PHASE(3, phase_conv(p, smem); for (int it = 384 + blockIdx.x; it < 768; it += gridDim.x) p0_mod_item(p, it, smem))
  PHASE(4, phase_ssd_states(p, smem))
#if PROBE_D == 1
  if (p.ph_lo <= 5 && 5 < p.ph_hi) phase_scan_attn_a(p, smem, p.ph_hi > 100);
#endif
  PHASE(5, phase_scan_attn_a(p, smem))
#if PROBE_D == 2
  if (p.ph_lo <= 6 && 6 < p.ph_hi) phase_ssd_out(p, smem, p.ph_hi > 100);
#endif
  PHASE(6, phase_ssd_out(p, smem))
  PHASE(7, phase_ab_out(p, smem))
  PHASE(8, phase_modnorm(p, 1, smem); mla_cache_convert(p))
  PHASE(9, phase_mla_in(p, smem))
  PHASE(11, phase_mla_up(p, smem))
  PHASE(12, phase_mla_attn(p, smem))
  PHASE(13, phase_mla_out(p, smem))
  PHASE(14, phase_final_norm(p))
}

extern "C" void kernel_launch(void* const* d_in, const int* in_sizes, int n_in, void* d_out, int out_size, void* d_ws, size_t ws_size, hipStream_t stream) {
  static int grid = 0;
  if (grid == 0) {
    int dev = 0, cus = 0, per_cu = 0;
    hipGetDevice(&dev);
    hipDeviceGetAttribute(&cus, hipDeviceAttributeMultiprocessorCount, dev);
    hipOccupancyMaxActiveBlocksPerMultiprocessor(&per_cu, (const void*)mega, 256, 0);
    if (per_cu < 1) per_cu = 1;
    if (per_cu > 2) per_cu = 2;
    grid = cus * per_cu;
  }
  Params p{};
  for (int i = 0; i < 29; ++i) p.in[i] = (const float*)d_in[i];
  p.out = (float*)d_out; p.ws = (unsigned char*)d_ws;
  hipMemsetAsync((unsigned char*)d_ws + WS_BAR, 0, WS_ZERO_BYTES, stream);
#if MULTI_LAUNCH
  for (int ph = 0; ph < N_PHASES; ++ph) {
    p.ph_lo = ph; p.ph_hi = ph + 1;
    hipLaunchKernelGGL(mega, dim3(grid), dim3(256), 0, stream, p);
  }
#else
  p.ph_lo = 0; p.ph_hi = N_PHASES;
  void* args[] = {&p};
  hipError_t e = hipLaunchCooperativeKernel((const void*)mega, dim3(grid), dim3(256), args, 0, stream);
  if (e != hipSuccess) fprintf(stderr, "cooperative launch failed: %s (grid %d)\n", hipGetErrorString(e), grid);
#endif
}
```

```cpp
#include <hip/hip_runtime.h>
#include <hip/hip_cooperative_groups.h>
#include <cstdio>
namespace cg = cooperative_groups;

#ifndef MULTI_LAUNCH
#define MULTI_LAUNCH 0
#endif

typedef unsigned short bf16_t;
using bf16x8 = __attribute__((ext_vector_type(8))) short;
using f32x4  = __attribute__((ext_vector_type(4))) float;
typedef __bf16 bf2v __attribute__((ext_vector_type(2)));
typedef float  fl2v __attribute__((ext_vector_type(2)));
#define DI __device__ __forceinline__
#define MFMA16(a, b, c) __builtin_amdgcn_mfma_f32_16x16x32_bf16((a), (b), (c), 0, 0, 0)

constexpr int NTOK = 16384;
constexpr int NCTX = 8192;
constexpr int NROWK = 16896;
constexpr int ABIN_N = 3712;
constexpr int MIN_N = 1536;
constexpr float EPS = 1e-6f;
constexpr float LOG2E = 1.4426950408889634f;

constexpr size_t O_Y = 0;
constexpr size_t O_CAK = 16777216;
constexpr size_t O_CAV = 17825792;
constexpr size_t O_SF = 18874368;
constexpr size_t O_SB = 20971520;
constexpr size_t O_CKV = 23068672;
constexpr size_t O_KPE = 24117248;

constexpr size_t KB = 1024, MB = 1024 * 1024;
constexpr size_t W_ABIN = 0;
constexpr size_t W_ABOUT = W_ABIN + (size_t)ABIN_N * 1024 * 2;
constexpr size_t W_MIN = W_ABOUT + 1024 * 1536 * 2;
constexpr size_t W_UQ = W_MIN + 1536 * 1024 * 2;
constexpr size_t W_UKV = W_UQ + 1536 * 256 * 2;
constexpr size_t W_MOUT = W_UKV + 2048 * 128 * 2;
constexpr size_t W_END = W_MOUT + 1024 * 1024 * 2;
constexpr size_t WS_ROWSQ = 17 * MB + 768 * KB + 96 * KB;
constexpr size_t WS_ROWSQ_Q = WS_ROWSQ + 64 * KB;
constexpr size_t WS_ZERO_BYTES = 96 * KB + 128 * KB;
constexpr size_t WS_X2B = 50 * MB;
constexpr size_t WS_GCNT = 17 * MB + 768 * KB + 15 * KB;
constexpr size_t WS_MODP = 17 * MB + 768 * KB + 16 * KB;
constexpr size_t WS_CDEC = 17 * MB + 512 * KB;
constexpr size_t WS_BAR = 17 * MB + 768 * KB;
constexpr size_t WS_H = 18 * MB;
constexpr size_t WS_XT = 18 * MB;
constexpr size_t WS_XBCR = 50 * MB;
constexpr size_t WS_HIN = 50 * MB;
constexpr size_t WS_QA = 90 * MB;
constexpr size_t WS_KA = 106 * MB;
constexpr size_t WS_VTA = WS_KA + 4352 * KB;
constexpr size_t WS_GA = WS_VTA + 4352 * KB;
constexpr size_t WS_ZS = WS_GA + 16 * MB;
constexpr size_t WS_DTP = WS_ZS + 32 * MB;
constexpr size_t WS_BT = WS_DTP + 2 * MB;
constexpr size_t WS_BCM = WS_BT + 4 * MB;
constexpr size_t WS_SSQ = WS_BCM + 8 * MB;
constexpr size_t WS_STATES = WS_SSQ + 1 * MB;
constexpr size_t WS_L0_END = WS_STATES + 64 * MB;
constexpr size_t WS_AOM = 18 * MB;
constexpr size_t WS_GM = 50 * MB;
constexpr size_t WS_CQN = 82 * MB;
constexpr size_t WS_CKVN = 90 * MB;
constexpr size_t WS_KPEB = WS_CKVN + 4352 * KB;
constexpr size_t WS_QM = WS_KPEB + 1280 * KB;
constexpr size_t WS_KNOPE = WS_QM + 48 * MB;
constexpr size_t WS_VTM = WS_KNOPE + 33 * MB;
constexpr size_t WS_CQ = WS_VTM;
constexpr size_t WS_CKV = WS_CQ + 16 * MB;
constexpr size_t WS_KPE = WS_CKV + 8 * MB;
constexpr size_t WS_X1B = WS_VTM + 33 * MB;
constexpr size_t WS_L1_END = WS_X1B + 32 * MB;
static_assert(W_END <= 17 * MB, "weights");
static_assert(WS_L0_END <= 256 * MB && WS_L1_END <= 256 * MB && WS_X1B >= WS_STATES && WS_X1B >= WS_SSQ + 1 * MB, "workspace");

struct Params {
  const float* in[29];
  float* out;
  unsigned char* ws;
  int ph_lo, ph_hi;
};
enum { I_XP = 0, I_XS, I_CAK, I_CAV, I_SF, I_SB, I_CCKV, I_CKPE, I_C, I_CCTX, I_ADAW, I_ADAB, I_NORMW, I_ABWIN, I_SINK, I_CONVW, I_CONVB,
       I_DTB, I_ALOG, I_DSKIP, I_GNW, I_ABWOUT, I_MWIN, I_QNW, I_KVNW, I_WUQ, I_WUKV, I_MWOUT, I_FNW };

DI unsigned pack2(float a, float b) { fl2v v = {a, b}; bf2v r = __builtin_convertvector(v, bf2v); return __builtin_bit_cast(unsigned, r); }
DI bf16_t f2bf(float a) { return (bf16_t)(pack2(a, 0.f) & 0xffffu); }
DI float bf2f(bf16_t b) { return __uint_as_float(((unsigned)b) << 16); }
DI float bflo(unsigned u) { return __uint_as_float(u << 16); }
DI float bfhi(unsigned u) { return __uint_as_float(u & 0xffff0000u); }
DI float silu_f(float x) { return x * __builtin_amdgcn_rcpf(1.f + __builtin_amdgcn_exp2f(-x * 1.4426950408889634f)); }
DI float softplus_f(float x) { return x > 20.f ? x : log1pf(__expf(x)); }
DI float ex2(float x) { return __builtin_amdgcn_exp2f(x); }
DI bf16x8 mk8(unsigned a, unsigned b, unsigned c, unsigned d) { uint4 u = make_uint4(a, b, c, d); return __builtin_bit_cast(bf16x8, u); }
DI int cond_of(int row) { return row < NCTX ? 0 : 1 + ((row - NCTX) >> 12); }
DI float wave_sum(float v) {
#pragma unroll
  for (int o = 32; o > 0; o >>= 1) v += __shfl_xor(v, o);
  return v;
}
DI float mod_val(const Params& p, int layer, int cond, int which, int c) {
  return ((const float*)(p.ws + WS_MODP))[(layer * 3 + cond) * 3072 + which * 1024 + c];
}
DI void chunk_rows(int gc, int& row0, int& s0, int& s1) {
  if (gc < 64) { int seq = gc >> 1; s0 = seq * 256; s1 = s0 + 256; row0 = s0 + (gc & 1) * 128; }
  else { int g2 = gc - 64; int seq = g2 >> 5; s0 = NCTX + seq * 4096; s1 = s0 + 4096; row0 = s0 + (g2 & 31) * 128; }
}

DI void p0_mod_item(const Params& p, int item, unsigned char* smem) {
  const int tid = threadIdx.x;
  const int kc = item & 31, cgp = (item >> 5) % 12, layer = item / 384;
  float* sl = (float*)smem;
  __syncthreads();
  if (tid < 96) {
    int j = tid >> 5, k = kc * 32 + (tid & 31);
    const float* cv = j == 0 ? p.in[I_CCTX] : p.in[I_C] + (j - 1) * 1024;
    sl[tid] = silu_f(cv[k]);
  }
  __syncthreads();
  const int col = cgp * 256 + tid;
  const float* W = p.in[I_ADAW] + (size_t)layer * 1024 * 3072 + (size_t)(kc * 32) * 3072 + col;
  float wv[32];
#pragma unroll
  for (int kk = 0; kk < 32; ++kk) wv[kk] = W[(size_t)kk * 3072];
  float a0 = 0.f, a1 = 0.f, a2 = 0.f;
#pragma unroll
  for (int kk = 0; kk < 32; ++kk) { a0 += sl[kk] * wv[kk]; a1 += sl[32 + kk] * wv[kk]; a2 += sl[64 + kk] * wv[kk]; }
  if (kc == 0) { float bb = p.in[I_ADAB][layer * 3072 + col]; a0 += bb; a1 += bb; a2 += bb; }
  float* mp = (float*)(p.ws + WS_MODP) + (size_t)layer * 3 * 3072 + col;
  atomicAdd(mp, a0); atomicAdd(mp + 3072, a1); atomicAdd(mp + 6144, a2);
  if (layer == 0) {
    asm volatile("s_waitcnt vmcnt(0)" ::: "memory");
    __syncthreads();
    if (tid == 0) __hip_atomic_fetch_add((unsigned*)(p.ws + WS_GCNT), 1u, __ATOMIC_RELAXED, __HIP_MEMORY_SCOPE_AGENT);
  }
}
DI void p0_wt_tile(const float* src, int ldsrc, bf16_t* dst, int K, int k0, int n0, int nvalid, int mode, const float* rowscale, int rs_off, unsigned char* smem) {
  const int tid = threadIdx.x;
  float* tile = (float*)smem;
  const int c4 = (tid & 15) * 4, r0 = tid >> 4;
  const int n = n0 + c4;
  int sc;
  if (mode == 0) sc = n < nvalid ? n : -1;
  else sc = n < 384 ? n : (n < 1408 ? n + 32 : (n < 1440 ? n - 1024 : -1));
  __syncthreads();
  float4 vv[4];
#pragma unroll
  for (int i = 0; i < 4; ++i) { const int k = k0 + r0 + 16 * i; vv[i] = sc >= 0 ? *(const float4*)(src + (size_t)k * ldsrc + sc) : make_float4(0.f, 0.f, 0.f, 0.f); }
#pragma unroll
  for (int i = 0; i < 4; ++i) {
    const int k = k0 + r0 + 16 * i; float4 v = vv[i];
    if (rowscale && k >= rs_off) { const float f = rowscale[k - rs_off]; v.x *= f; v.y *= f; v.z *= f; v.w *= f; }
    float* tp = tile + (r0 + 16 * i) * 65 + c4;
    tp[0] = v.x; tp[1] = v.y; tp[2] = v.z; tp[3] = v.w;
  }
  __syncthreads();
  const int nn = tid >> 2, kk0 = (tid & 3) * 16;
  unsigned u[8];
#pragma unroll
  for (int e = 0; e < 8; ++e) u[e] = pack2(tile[(kk0 + 2 * e) * 65 + nn], tile[(kk0 + 2 * e + 1) * 65 + nn]);
  uint4* d = (uint4*)(dst + (size_t)(n0 + nn) * K + k0 + kk0);
  d[0] = make_uint4(u[0], u[1], u[2], u[3]); d[1] = make_uint4(u[4], u[5], u[6], u[7]);
}
constexpr int T_ABIN = 16 * 58, T_ABOUT = 24 * 16, T_MIN = 16 * 24, T_UQ = 4 * 24, T_UKV = 2 * 32, T_MOUT = 16 * 16;
constexpr int N_WT = T_ABIN + T_ABOUT + T_MIN + T_UQ + T_UKV + T_MOUT;
DI void wt_item(const Params& p, int t, unsigned char* smem) {
  if (t < T_ABIN) { int nt = t % 58, kt = t / 58; p0_wt_tile(p.in[I_ABWIN], 3616, (bf16_t*)(p.ws + W_ABIN), 1024, kt * 64, nt * 64, 3616, 0, nullptr, 0, smem); return; }
  t -= T_ABIN;
  if (t < T_ABOUT) { int nt = t % 16, kt = t / 16; p0_wt_tile(p.in[I_ABWOUT], 1024, (bf16_t*)(p.ws + W_ABOUT), 1536, kt * 64, nt * 64, 1024, 0, p.in[I_GNW], 512, smem); return; }
  t -= T_ABOUT;
  if (t < T_MIN) { int nt = t % 24, kt = t / 24; p0_wt_tile(p.in[I_MWIN], 1440, (bf16_t*)(p.ws + W_MIN), 1024, kt * 64, nt * 64, 1440, 1, nullptr, 0, smem); return; }
  t -= T_MIN;
  if (t < T_UQ) { int nt = t % 24, kt = t / 24; p0_wt_tile(p.in[I_WUQ], 1536, (bf16_t*)(p.ws + W_UQ), 256, kt * 64, nt * 64, 1536, 0, p.in[I_QNW], 0, smem); return; }
  t -= T_UQ;
  if (t < T_UKV) { int nt = t % 32, kt = t / 32; p0_wt_tile(p.in[I_WUKV], 2048, (bf16_t*)(p.ws + W_UKV), 128, kt * 64, nt * 64, 2048, 0, nullptr, 0, smem); return; }
  t -= T_UKV;
  { int nt = t % 16, kt = t / 16; p0_wt_tile(p.in[I_MWOUT], 1024, (bf16_t*)(p.ws + W_MOUT), 1024, kt * 64, nt * 64, 1024, 0, nullptr, 0, smem); }
}
DI void phase0(const Params& p, unsigned char* smem) {
  constexpr int N_MOD = 384;
  constexpr int N_CACHE = 64;
  constexpr int N_ALL = N_MOD + N_CACHE;
  for (int item = blockIdx.x; item < N_ALL; item += gridDim.x) {
    if (item < N_MOD) { p0_mod_item(p, item, smem); continue; }
    int t = item - N_MOD;
    const int tid = threadIdx.x;
    if (t < 32) {
      int e0 = t * 2048 + tid * 8;
      const float4* s = (const float4*)(p.in[I_CAK] + e0);
      float4 a = s[0], b = s[1];
      *(uint4*)((bf16_t*)(p.ws + WS_KA) + (size_t)NTOK * 128 + e0) = make_uint4(pack2(a.x, a.y), pack2(a.z, a.w), pack2(b.x, b.y), pack2(b.z, b.w));
    } else {
      int e0 = (t - 32) * 2048 + tid * 8;
      bf16_t* vt = (bf16_t*)(p.ws + WS_VTA);
#pragma unroll
      for (int e = 0; e < 8; ++e) {
        int idx = e0 + e;
        int d = idx & 63, kvh = (idx >> 6) & 1, rj = idx >> 7;
        int row = NTOK + rj;
        vt[((size_t)(row >> 6) * 2 + kvh) * 4096 + d * 64 + (row & 63)] = f2bf(p.in[I_CAV][idx]);
      }
    }
  }
}

DI void phase_modnorm(const Params& p, int layer, unsigned char* smem) {
  const int tid = threadIdx.x, lane = tid & 63, w = tid >> 6;
  float* em = (float*)smem;
  float* ea = em + 3072;
  if (layer == 0 && tid == 0) {
    unsigned spins = 0;
    while (__hip_atomic_load((unsigned*)(p.ws + WS_GCNT), __ATOMIC_RELAXED, __HIP_MEMORY_SCOPE_AGENT) < 384u && ++spins < (1u << 22)) __builtin_amdgcn_s_sleep(2);
  }
  __syncthreads();
  for (int i = tid; i < 3072; i += 256) {
    int cond = i >> 10, c = i & 1023;
    float* mpa = (float*)(p.ws + WS_MODP) + (layer * 3 + cond) * 3072;
    float sh = __hip_atomic_load(mpa + c, __ATOMIC_RELAXED, __HIP_MEMORY_SCOPE_AGENT), sc = __hip_atomic_load(mpa + 1024 + c, __ATOMIC_RELAXED, __HIP_MEMORY_SCOPE_AGENT);
    em[i] = p.in[I_NORMW][layer * 1024 + c] * (1.f + sc); ea[i] = sh;
  }
  __syncthreads();
  bf16_t* H = (bf16_t*)(p.ws + WS_H);
  for (int item = blockIdx.x; item < NTOK / 4; item += gridDim.x) {
    int row = item * 4 + w;
    float4 v[4]; float ss = 0.f;
    if (layer == 0) {
      const float* xr = row < NCTX ? p.in[I_XP] + (size_t)row * 1024 : p.in[I_XS] + (size_t)(row - NCTX) * 1024;
#pragma unroll
      for (int i = 0; i < 4; ++i) v[i] = ((const float4*)xr)[lane + 64 * i];
    } else {
      const uint2* xr = (const uint2*)((const bf16_t*)(p.ws + WS_X1B) + (size_t)row * 1024);
#pragma unroll
      for (int i = 0; i < 4; ++i) { uint2 u = xr[lane + 64 * i]; v[i] = make_float4(bflo(u.x), bfhi(u.x), bflo(u.y), bfhi(u.y)); }
    }
#pragma unroll
    for (int i = 0; i < 4; ++i) ss += v[i].x * v[i].x + v[i].y * v[i].y + v[i].z * v[i].z + v[i].w * v[i].w;
    ss = wave_sum(ss);
    float rstd = rsqrtf(ss * (1.f / 1024.f) + EPS);
    int cond = cond_of(row);
#pragma unroll
    for (int i = 0; i < 4; ++i) {
      int col = (lane + 64 * i) * 4;
      float4 m = *(const float4*)(em + cond * 1024 + col), a = *(const float4*)(ea + cond * 1024 + col);
      uint2 o = make_uint2(pack2(v[i].x * rstd * m.x + a.x, v[i].y * rstd * m.y + a.y), pack2(v[i].z * rstd * m.z + a.z, v[i].w * rstd * m.w + a.w));
      *(uint2*)(H + (size_t)row * 1024 + col) = o;
    }
  }
}

template <bool NARROW = false>
DI void gemm_mainloop(f32x4 (&acc)[4][4], const bf16_t* __restrict__ A, int lda, const bf16_t* __restrict__ B, int ldb, int K, int m0, int n0, unsigned char* smem) {
  const int tid = threadIdx.x, lane = tid & 63, w = tid >> 6, wm = w >> 1, wn = w & 1, lc = lane & 15, g = lane >> 4;
  const int rr = w * 8 + (lane >> 3);
  const int q = (lane & 7) ^ (((w & 1) * 4 + (lane >> 4)) & 7);
  const bf16_t* ga = A + (size_t)(m0 + rr) * lda + q * 8;
  const bf16_t* gb = B + (size_t)(n0 + rr) * ldb + q * 8;
  const int sw = (lc >> 1) & 7;
  const int nk = K >> 6;
#define GSTAGE(s, kt) do { _Pragma("unroll") for (int i = 0; i < 4; ++i) { \
    __builtin_amdgcn_global_load_lds((const unsigned*)(ga + (size_t)(i * 32) * lda + (kt) * 64), (unsigned*)(smem + (s) * 32768 + w * 1024 + i * 4096), 16, 0, 0); \
    if (!NARROW || i == 0) __builtin_amdgcn_global_load_lds((const unsigned*)(gb + (size_t)(i * 32) * ldb + (kt) * 64), (unsigned*)(smem + (s) * 32768 + 16384 + w * 1024 + i * 4096), 16, 0, 0); } } while (0)
  __syncthreads();
  GSTAGE(0, 0);
  asm volatile("s_waitcnt vmcnt(0)" ::: "memory");
  __syncthreads();
  for (int kt = 0; kt < nk; ++kt) {
    const int cur = kt & 1;
    if (kt + 1 < nk) GSTAGE(cur ^ 1, kt + 1);
    const unsigned char* sa = smem + cur * 32768 + (wm * 64 + lc) * 128;
    const unsigned char* sb = smem + cur * 32768 + 16384 + (wn * 64 + lc) * 128;
#pragma unroll
    for (int ks = 0; ks < 2; ++ks) {
      const int co = ((ks * 4 + g) ^ sw) * 16;
      bf16x8 af[4], bfr[4];
      if (NARROW) {
        if (wn == 0) {
#pragma unroll
          for (int i = 0; i < 4; ++i) af[i] = *(const bf16x8*)(sa + i * 2048 + co);
#pragma unroll
          for (int j = 0; j < 2; ++j) bfr[j] = *(const bf16x8*)(sb + j * 2048 + co);
#pragma unroll
          for (int i = 0; i < 4; ++i)
#pragma unroll
            for (int j = 0; j < 2; ++j) acc[i][j] = MFMA16(af[i], bfr[j], acc[i][j]);
        }
      } else {
#pragma unroll
        for (int i = 0; i < 4; ++i) af[i] = *(const bf16x8*)(sa + i * 2048 + co);
#pragma unroll
        for (int j = 0; j < 4; ++j) bfr[j] = *(const bf16x8*)(sb + j * 2048 + co);
#pragma unroll
        for (int i = 0; i < 4; ++i)
#pragma unroll
          for (int j = 0; j < 4; ++j) acc[i][j] = MFMA16(af[i], bfr[j], acc[i][j]);
      }
    }
    asm volatile("s_waitcnt vmcnt(0)" ::: "memory");
    __syncthreads();
  }
#undef GSTAGE
}
DI void acc_zero(f32x4 (&acc)[4][4]) {
#pragma unroll
  for (int i = 0; i < 4; ++i)
#pragma unroll
    for (int j = 0; j < 4; ++j) acc[i][j] = f32x4{0.f, 0.f, 0.f, 0.f};
}
DI void rope64(f32x4 (&acc)[4][4], int rowbase  , int lc, int g) {
  const float inv = ex2(-(float)lc * (13.287712379549449f / 16.f));
#pragma unroll
  for (int i = 0; i < 4; ++i)
#pragma unroll
    for (int r = 0; r < 4; ++r) {
      int l = (rowbase + i * 16 + 4 * g + r - NCTX) & 4095;
      float tr = (float)(l >> 6) * inv, tc = (float)(l & 63) * inv;
      float cr = __cosf(tr), sr = __sinf(tr), cc = __cosf(tc), sc = __sinf(tc);
      float a = acc[i][0][r], b = acc[i][1][r];
      acc[i][0][r] = a * cr - b * sr; acc[i][1][r] = b * cr + a * sr;
      a = acc[i][2][r]; b = acc[i][3][r];
      acc[i][2][r] = a * cc - b * sc; acc[i][3][r] = b * cc + a * sc;
    }
}

DI float* stage_wave_tile(const f32x4 (&acc)[4][4], unsigned char* smem) {
  const int lane = threadIdx.x & 63, w = threadIdx.x >> 6, lc = lane & 15, g = lane >> 4;
  float* wb = (float*)smem + w * (64 * 68);
#pragma unroll
  for (int i = 0; i < 4; ++i)
#pragma unroll
    for (int j = 0; j < 4; ++j)
#pragma unroll
      for (int r = 0; r < 4; ++r) wb[(i * 16 + 4 * g + r) * 68 + j * 16 + lc] = acc[i][j][r];
  __builtin_amdgcn_wave_barrier();
  return wb;
}
DI uint2 pk4(float4 v) { return make_uint2(pack2(v.x, v.y), pack2(v.z, v.w)); }
DI float4 silu4(float4 v) { return make_float4(silu_f(v.x), silu_f(v.y), silu_f(v.z), silu_f(v.w)); }
DI void xcd_tile(int v, int NT, int& mt, int& nt) { const int x = v & 7, j = v >> 3; mt = (j / NT) * 8 + x; nt = j % NT; }

DI void phase_ab_in(const Params& p, unsigned char* smem) {
  const int tid = threadIdx.x, lane = tid & 63, w = tid >> 6, wm = w >> 1, wn = w & 1, lc = lane & 15, g = lane >> 4;
  const bf16_t* H = (const bf16_t*)(p.ws + WS_H);
  const bf16_t* W = (const bf16_t*)(p.ws + W_ABIN);
  bf16_t* QA = (bf16_t*)(p.ws + WS_QA); bf16_t* KA = (bf16_t*)(p.ws + WS_KA); bf16_t* VTA = (bf16_t*)(p.ws + WS_VTA);
  bf16_t* GA = (bf16_t*)(p.ws + WS_GA); bf16_t* ZS = (bf16_t*)(p.ws + WS_ZS); bf16_t* XB = (bf16_t*)(p.ws + WS_XBCR);
  float* DTP = (float*)(p.ws + WS_DTP);
  constexpr int NT = ABIN_N / 128;
  for (int tile = blockIdx.x; tile < 128 * NT; tile += gridDim.x) {
    int mt, nt; if (tile < 128 * (NT - 1)) xcd_tile(tile, NT - 1, mt, nt); else { mt = tile - 128 * (NT - 1); nt = NT - 1; }
    const int m0 = mt * 128, n0 = nt * 128;
    f32x4 acc[4][4]; acc_zero(acc);
    if (n0 >= 3584) gemm_mainloop<true>(acc, H, 1024, W, 1024, 1024, m0, n0, smem); else gemm_mainloop<false>(acc, H, 1024, W, 1024, 1024, m0, n0, smem);
    const int rb = m0 + wm * 64, cb = n0 + wn * 64;
    const bool lat = m0 >= NCTX;
    if (n0 < 640 && lat) rope64(acc, rb, lc, g);
    if (n0 >= 640 && n0 < 768) {
#pragma unroll
      for (int i = 0; i < 4; ++i)
#pragma unroll
        for (int j = 0; j < 4; ++j) {
          int row = rb + i * 16 + 4 * g, d = j * 16 + lc;
          *(uint2*)(VTA + ((size_t)(row >> 6) * 2 + wn) * 4096 + d * 64 + (row & 63)) = make_uint2(pack2(acc[i][j][0], acc[i][j][1]), pack2(acc[i][j][2], acc[i][j][3]));
        }
    }
    if (n0 < 3584) {
      const float* wb = stage_wave_tile(acc, smem);
      const int c4 = (lane & 15) * 4, col = cb + c4;
#pragma unroll 4
      for (int it = 0; it < 16; ++it) {
        const int rl = it * 4 + (lane >> 4); const size_t row = (size_t)(rb + rl);
        float4 v = *(const float4*)(wb + rl * 68 + c4);
        if (n0 < 512) { const float qs = 0.125f * LOG2E; *(uint2*)(QA + row * 512 + col) = pk4(make_float4(v.x * qs, v.y * qs, v.z * qs, v.w * qs)); }
        else if (n0 < 640) { *(uint2*)(KA + row * 128 + col - 512) = pk4(v); if (!lat) *(float4*)(p.out + O_CAK + row * 128 + col - 512) = v; }
        else if (n0 < 768) { if (!lat) *(float4*)(p.out + O_CAV + row * 128 + col - 640) = v; }
        else if (n0 < 1280) *(uint2*)(GA + row * 512 + col - 768) = pk4(silu4(v));
        else if (n0 < 2304) *(uint2*)(ZS + row * 1024 + col - 1280) = pk4(silu4(v));
        else *(uint2*)(XB + row * 1280 + col - 2304) = pk4(v);
      }
    } else if (wn == 0) {
#pragma unroll
      for (int i = 0; i < 4; ++i)
#pragma unroll
        for (int j = 0; j < 2; ++j)
#pragma unroll
          for (int r = 0; r < 4; ++r) {
            int row = rb + i * 16 + 4 * g + r, col = j * 16 + lc;
            DTP[(size_t)row * 32 + col] = softplus_f(acc[i][j][r] + p.in[I_DTB][col]);
          }
    }
  }
}

DI void phase_conv(const Params& p, unsigned char* smem) {
  const int tid = threadIdx.x;
  bf16_t* raw = (bf16_t*)smem;
  bf16_t* outl = raw + 132 * 64;
  const bf16_t* XB = (const bf16_t*)(p.ws + WS_XBCR);
  bf16_t* XT = (bf16_t*)(p.ws + WS_XT); bf16_t* BT = (bf16_t*)(p.ws + WS_BT); bf16_t* BCM = (bf16_t*)(p.ws + WS_BCM);
  for (int item = blockIdx.x; item < 128 * 20; item += gridDim.x) {
    const int gc = ((item >> 3) / 20) * 8 + (item & 7), cgp = (item >> 3) % 20;
    int row0, s0, s1; chunk_rows(gc, row0, s0, s1);
    __syncthreads();
    for (int c = tid; c < 132 * 8; c += 256) {
      int t = c >> 3, c8 = c & 7, row = row0 - 2 + t;
      uint4 v = make_uint4(0, 0, 0, 0);
      if (row >= s0 && row < s1) v = *(const uint4*)(XB + (size_t)row * 1280 + cgp * 64 + c8 * 8);
      *(uint4*)(raw + t * 64 + c8 * 8) = v;
    }
    __syncthreads();
    {
      const int c = tid & 63, tg = tid >> 6, ch = cgp * 64 + c;
      float wv[5];
#pragma unroll
      for (int j = 0; j < 5; ++j) wv[j] = p.in[I_CONVW][j * 1280 + ch];
      const float bias = p.in[I_CONVB][ch];
      float x0 = bf2f(raw[(tg * 32 + 0) * 64 + c]), x1 = bf2f(raw[(tg * 32 + 1) * 64 + c]), x2 = bf2f(raw[(tg * 32 + 2) * 64 + c]), x3 = bf2f(raw[(tg * 32 + 3) * 64 + c]);
#pragma unroll 8
      for (int t = 0; t < 32; ++t) {
        int tt = tg * 32 + t;
        float x4 = bf2f(raw[(tt + 4) * 64 + c]);
        float o = bias + wv[0] * x0 + wv[1] * x1 + wv[2] * x2 + wv[3] * x3 + wv[4] * x4;
        outl[tt * 66 + c] = f2bf(silu_f(o));
        x0 = x1; x1 = x2; x2 = x3; x3 = x4;
      }
    }
    __syncthreads();
    if (cgp >= 16) {
      for (int c = tid; c < 1024; c += 256) {
        int tt = c >> 3, c8 = c & 7;
        const unsigned* s = (const unsigned*)(outl + tt * 66 + c8 * 8);
        *(uint4*)(BCM + (size_t)(row0 + tt) * 256 + (cgp - 16) * 64 + c8 * 8) = make_uint4(s[0], s[1], s[2], s[3]);
      }
    }
    if (cgp < 18) {
      for (int c = tid; c < 1024; c += 256) {
        int ch = c >> 4, t8 = c & 15;
        unsigned u[4];
#pragma unroll
        for (int e = 0; e < 4; ++e) u[e] = (unsigned)outl[(t8 * 8 + 2 * e) * 66 + ch] | ((unsigned)outl[(t8 * 8 + 2 * e + 1) * 66 + ch] << 16);
        bf16_t* dst = cgp < 16 ? XT + ((size_t)gc * 1024 + cgp * 64 + ch) * 128 + t8 * 8 : BT + ((size_t)gc * 128 + (cgp - 16) * 64 + ch) * 128 + t8 * 8;
        *(uint4*)dst = make_uint4(u[0], u[1], u[2], u[3]);
      }
    }
  }
}

DI float chunk_cums(const Params& p, int row0, int head, int dir, int lane, float* dtv, float* cumv, float* facv) {
  const float* DTP = (const float*)(p.ws + WS_DTP);
  const float a = -__expf(p.in[I_ALOG][dir * 16 + head]);
  float d0 = DTP[(size_t)(row0 + 2 * lane) * 32 + dir * 16 + head], d1 = DTP[(size_t)(row0 + 2 * lane + 1) * 32 + dir * 16 + head];
  float v0 = d0 * a, v1 = d1 * a, s = v0 + v1, sc = s;
#pragma unroll
  for (int o = 1; o < 64; o <<= 1) { float t = __shfl_up(sc, o); if (lane >= o) sc += t; }
  float total = __shfl(sc, 63);
  float e = sc - s, c0 = e + v0, c1 = e + s;
  if (facv) {
    dtv[dir * 128 + 2 * lane] = d0; dtv[dir * 128 + 2 * lane + 1] = d1;
    if (dir == 0) {
      cumv[2 * lane] = c0; cumv[2 * lane + 1] = c1;
      facv[2 * lane] = d0 * __expf(total - c0); facv[2 * lane + 1] = d1 * __expf(total - c1);
    } else {
      cumv[128 + 2 * lane] = total - c0 + v0; cumv[128 + 2 * lane + 1] = total - c1 + v1;
      facv[128 + 2 * lane] = d0 * __expf(c0 - v0); facv[128 + 2 * lane + 1] = d1 * __expf(c1 - v1);
    }
  } else {
    const float q0 = dir == 0 ? c0 : total - c0 + v0, q1 = dir == 0 ? c1 : total - c1 + v1;
    cumv[dir * 128 + 2 * lane] = q0 * LOG2E; cumv[dir * 128 + 2 * lane + 1] = q1 * LOG2E;
    dtv[dir * 128 + 2 * lane] = q0 * LOG2E - __log2f(d0); dtv[dir * 128 + 2 * lane + 1] = q1 * LOG2E - __log2f(d1);
  }
  return total;
}

DI void phase_ssd_states(const Params& p, unsigned char* smem) {
  const int tid = threadIdx.x, lane = tid & 63, w = tid >> 6, lc = lane & 15, g = lane >> 4;
  bf16_t* xf = (bf16_t*)smem;
  bf16_t* xb = xf + 64 * 136;
  bf16_t* bt = xb + 64 * 136;
  float* dtv = (float*)(bt + 64 * 136);
  float* cumv = dtv + 256;
  float* facv = cumv + 256;
  const bf16_t* XT = (const bf16_t*)(p.ws + WS_XT); const bf16_t* BT = (const bf16_t*)(p.ws + WS_BT);
  float* ST = (float*)(p.ws + WS_STATES); float* CD = (float*)(p.ws + WS_CDEC);
  for (int item = blockIdx.x; item < 2048; item += gridDim.x) {
    const int gc = ((item >> 7) << 3) + (item & 7), head = (item >> 3) & 15, grp = head >> 3;
    int row0, s0, s1; chunk_rows(gc, row0, s0, s1);
    __syncthreads();
    if (w < 2) {
      float total = chunk_cums(p, row0, head, w, lane, dtv, cumv, facv);
      if (lane == 0) CD[(gc * 2 + w) * 16 + head] = __expf(total);
    }
    __syncthreads();
#pragma unroll
    for (int i = 0; i < 4; ++i) {
      int id = tid + 256 * i, r = id >> 4, c16 = id & 15;
      uint4 xv = *(const uint4*)(XT + ((size_t)gc * 1024 + head * 64 + r) * 128 + c16 * 8);
      uint4 bv = *(const uint4*)(BT + ((size_t)gc * 128 + grp * 64 + r) * 128 + c16 * 8);
      *(uint4*)(bt + r * 136 + c16 * 8) = bv;
      const float* ff = facv + c16 * 8; const float* fb = facv + 128 + c16 * 8;
      unsigned xs[4] = {xv.x, xv.y, xv.z, xv.w}, of[4], ob[4];
#pragma unroll
      for (int e = 0; e < 4; ++e) {
        float lo = bflo(xs[e]), hi = bfhi(xs[e]);
        of[e] = pack2(lo * ff[2 * e], hi * ff[2 * e + 1]); ob[e] = pack2(lo * fb[2 * e], hi * fb[2 * e + 1]);
      }
      *(uint4*)(xf + r * 136 + c16 * 8) = make_uint4(of[0], of[1], of[2], of[3]);
      *(uint4*)(xb + r * 136 + c16 * 8) = make_uint4(ob[0], ob[1], ob[2], ob[3]);
    }
    __syncthreads();
    f32x4 af[4], ab[4];
#pragma unroll
    for (int j = 0; j < 4; ++j) { af[j] = f32x4{0, 0, 0, 0}; ab[j] = f32x4{0, 0, 0, 0}; }
#pragma unroll
    for (int ks = 0; ks < 4; ++ks) {
      bf16x8 a_f = *(const bf16x8*)(xf + (w * 16 + lc) * 136 + ks * 32 + g * 8);
      bf16x8 a_b = *(const bf16x8*)(xb + (w * 16 + lc) * 136 + ks * 32 + g * 8);
#pragma unroll
      for (int j = 0; j < 4; ++j) {
        bf16x8 b = *(const bf16x8*)(bt + (j * 16 + lc) * 136 + ks * 32 + g * 8);
        af[j] = MFMA16(a_f, b, af[j]); ab[j] = MFMA16(a_b, b, ab[j]);
      }
    }
    bf16_t* o0 = (bf16_t*)ST + ((size_t)(gc * 2 + 0) * 16 + head) * 4096; bf16_t* o1 = (bf16_t*)ST + ((size_t)(gc * 2 + 1) * 16 + head) * 4096;
    const bool odd = lc & 1;
#pragma unroll
    for (int j = 0; j < 4; ++j) {
      const int n2 = j * 16 + (lc & ~1), pb = w * 16 + 4 * g + (odd ? 2 : 0);
      {
        const float y0 = __shfl_xor(odd ? af[j][0] : af[j][2], 1), y1 = __shfl_xor(odd ? af[j][1] : af[j][3], 1);
        const unsigned u0 = odd ? pack2(y0, af[j][2]) : pack2(af[j][0], y0), u1 = odd ? pack2(y1, af[j][3]) : pack2(af[j][1], y1);
        *(unsigned*)(o0 + (pb + 0) * 64 + n2) = u0; *(unsigned*)(o0 + (pb + 1) * 64 + n2) = u1;
      }
      {
        const float y0 = __shfl_xor(odd ? ab[j][0] : ab[j][2], 1), y1 = __shfl_xor(odd ? ab[j][1] : ab[j][3], 1);
        const unsigned u0 = odd ? pack2(y0, ab[j][2]) : pack2(ab[j][0], y0), u1 = odd ? pack2(y1, ab[j][3]) : pack2(ab[j][1], y1);
        *(unsigned*)(o1 + (pb + 0) * 64 + n2) = u0; *(unsigned*)(o1 + (pb + 1) * 64 + n2) = u1;
      }
    }
  }
}

struct AttnArgs {
  const bf16_t* q; int ldq;
  const bf16_t* k; int ldk;
  const bf16_t* kpe;
  const bf16_t* vt; int vt_heads, vhead;
  const bf16_t* gate; int ldg;
  bf16_t* out; int ldo;
  int qrow0, qpos0;
  int seg0_row, seg0_n, seg0_pos, band;
  int seg1_row, seg1_n;
  float sink2; int has_sink; float scale2;
};
using f32x16 = __attribute__((ext_vector_type(16))) float;
#define MFMA32(a, b, c) __builtin_amdgcn_mfma_f32_32x32x16_bf16((a), (b), (c), 0, 0, 0)
template <int DK, bool MLA>
DI void attn_item(const AttnArgs& a, unsigned char* smem, bool dost = true) {
  constexpr int KS = DK / 16, KSTR = DK + 8, KCH = DK / 8, VSTR = 68;
  const int tid = threadIdx.x, lane = tid & 63, w = tid >> 6, r32 = lane & 31, h = lane >> 5;
  bf16_t* sK = (bf16_t*)smem;
  bf16_t* sV = sK + 64 * KSTR;
  bf16x8 qf[KS];
#pragma unroll
  for (int ks = 0; ks < KS; ++ks) qf[ks] = *(const bf16x8*)(a.q + (size_t)(a.qrow0 + w * 32 + r32) * a.ldq + ks * 16 + h * 8);
  f32x16 O[2], L;
#pragma unroll
  for (int i = 0; i < 16; ++i) { O[0][i] = 0.f; O[1][i] = 0.f; L[i] = a.has_sink ? 1.f : 0.f; }
  float mrow = a.has_sink ? a.sink2 : -1e30f;
  const bf16x8 ones = mk8(0x3F803F80u, 0x3F803F80u, 0x3F803F80u, 0x3F803F80u);
  const int ntiles = (a.seg0_n + a.seg1_n) >> 6;
  const int qpos = a.qpos0 + w * 32 + r32;
  uint4 pk0, pk1, pk2, pv0, pv1;
#define KR(i) ((tid + 256 * (i)) / KCH)
#define KQ(i) ((tid + 256 * (i)) % KCH)
#define KSRC(i, krow) ((!MLA || KQ(i) < 8) ? a.k + (size_t)((krow) + KR(i)) * a.ldk + KQ(i) * 8 : a.kpe + (size_t)((krow) + KR(i)) * 32 + (KQ(i) - 8) * 8)
  const int vr = tid >> 3, vq = tid & 7;
#define ATT_LOAD(t_) do { const int kk0_ = (t_) * 64; const int krow_ = kk0_ < a.seg0_n ? a.seg0_row + kk0_ : a.seg1_row + kk0_ - a.seg0_n; \
    pk0 = *(const uint4*)KSRC(0, krow_); pk1 = *(const uint4*)KSRC(1, krow_); if (MLA) pk2 = *(const uint4*)KSRC(2, krow_); \
    const bf16_t* vsrc_ = a.vt + ((size_t)(krow_ >> 6) * a.vt_heads + a.vhead) * 4096; \
    pv0 = *(const uint4*)(vsrc_ + vr * 64 + vq * 8); pv1 = *(const uint4*)(vsrc_ + (vr + 32) * 64 + vq * 8); } while (0)
  ATT_LOAD(0);
  for (int t = 0; t < ntiles; ++t) {
    const int kk0 = t * 64; const bool loc = kk0 < a.seg0_n;
    __syncthreads();
    *(uint4*)(sK + KR(0) * KSTR + KQ(0) * 8) = pk0; *(uint4*)(sK + KR(1) * KSTR + KQ(1) * 8) = pk1; if (MLA) *(uint4*)(sK + KR(2) * KSTR + KQ(2) * 8) = pk2;
    *(uint2*)(sV + vr * VSTR + vq * 8) = make_uint2(pv0.x, pv0.y); *(uint2*)(sV + vr * VSTR + vq * 8 + 4) = make_uint2(pv0.z, pv0.w);
    *(uint2*)(sV + (vr + 32) * VSTR + vq * 8) = make_uint2(pv1.x, pv1.y); *(uint2*)(sV + (vr + 32) * VSTR + vq * 8 + 4) = make_uint2(pv1.z, pv1.w);
    __syncthreads();
    if (t + 1 < ntiles) ATT_LOAD(t + 1);
    f32x16 S[2];
#pragma unroll
    for (int i = 0; i < 16; ++i) { S[0][i] = 0.f; S[1][i] = 0.f; }
#pragma unroll
    for (int ks = 0; ks < KS; ++ks)
#pragma unroll
      for (int kt = 0; kt < 2; ++kt) {
        bf16x8 kf = *(const bf16x8*)(sK + (kt * 32 + r32) * KSTR + ks * 16 + h * 8);
        S[kt] = MFMA32(kf, qf[ks], S[kt]);
      }
    const bool msk = a.band && loc;
    float m = -1e30f;
#pragma unroll
    for (int kt = 0; kt < 2; ++kt)
#pragma unroll
      for (int ri = 0; ri < 16; ++ri) {
        float v = S[kt][ri];
        if (msk) { int dlt = a.seg0_pos + kk0 + kt * 32 + (ri & 3) + 8 * (ri >> 2) + 4 * h - qpos; if (dlt > 128 || dlt < -128) v = -1e30f; S[kt][ri] = v; }
        m = fmaxf(m, v);
      }
    m = fmaxf(m, __shfl_xor(m, 32));
    if (__builtin_amdgcn_ballot_w64(m > mrow + 8.f) != 0ull) {
      const float mnew = fmaxf(mrow, m), alpha = ex2(mrow - mnew);
      mrow = mnew;
#pragma unroll
      for (int i = 0; i < 16; ++i) { O[0][i] *= alpha; O[1][i] *= alpha; L[i] *= alpha; }
    }
#pragma unroll
    for (int kt = 0; kt < 2; ++kt)
#pragma unroll
      for (int s2 = 0; s2 < 2; ++s2) {
        const bf16x8 pf = mk8(pack2(ex2(S[kt][8 * s2 + 0] - mrow), ex2(S[kt][8 * s2 + 1] - mrow)), pack2(ex2(S[kt][8 * s2 + 2] - mrow), ex2(S[kt][8 * s2 + 3] - mrow)),
                              pack2(ex2(S[kt][8 * s2 + 4] - mrow), ex2(S[kt][8 * s2 + 5] - mrow)), pack2(ex2(S[kt][8 * s2 + 6] - mrow), ex2(S[kt][8 * s2 + 7] - mrow)));
        L = MFMA32(ones, pf, L);
#pragma unroll
        for (int dt = 0; dt < 2; ++dt) {
          const bf16_t* vp = sV + (dt * 32 + r32) * VSTR + kt * 32 + 16 * s2 + 4 * h;
          const uint2 lo = *(const uint2*)vp, hi = *(const uint2*)(vp + 8);
          O[dt] = MFMA32(mk8(lo.x, lo.y, hi.x, hi.y), pf, O[dt]);
        }
      }
  }
#undef KR
#undef KQ
#undef KSRC
#undef ATT_LOAD
  {
    const float inv = 1.f / L[0];
    const size_t row = (size_t)(a.qrow0 + w * 32 + r32);
#pragma unroll
    for (int dt = 0; dt < 2; ++dt)
#pragma unroll
      for (int gq = 0; gq < 4; ++gq) {
        const int d0 = dt * 32 + 8 * gq + 4 * h;
        const uint2 gt = *(const uint2*)(a.gate + row * a.ldg + d0);
        const float o0 = O[dt][4 * gq + 0] * inv * bflo(gt.x), o1 = O[dt][4 * gq + 1] * inv * bfhi(gt.x), o2 = O[dt][4 * gq + 2] * inv * bflo(gt.y), o3 = O[dt][4 * gq + 3] * inv * bfhi(gt.y);
        if (dost) *(uint2*)(a.out + row * a.ldo + d0) = make_uint2(pack2(o0, o1), pack2(o2, o3));
      }
  }
}

template <int DK, bool MLA>
DI void attn_item2(const AttnArgs& a, unsigned char* smem) {
  constexpr int KS = DK / 16, KSTR = DK + 8, KCH = DK / 8, VSTR = 68;
  const int tid = threadIdx.x, lane = tid & 63, w = tid >> 6, r32 = lane & 31, h = lane >> 5;
  bf16_t* sK = (bf16_t*)smem;
  bf16_t* sV = sK + 64 * KSTR;
  bf16_t* sQ = sV + 64 * VSTR;
  __syncthreads();
  for (int c = tid; c < 256 * KCH; c += 256) { const int r = c / KCH, cc = c % KCH; *(uint4*)(sQ + r * KSTR + cc * 8) = *(const uint4*)(a.q + (size_t)(a.qrow0 + r) * a.ldq + cc * 8); }
  const bf16_t* sQw = sQ + (w * 64 + r32) * KSTR + h * 8;
  f32x16 O[2][2];
#pragma unroll
  for (int i = 0; i < 16; ++i) { O[0][0][i] = 0.f; O[0][1][i] = 0.f; O[1][0][i] = 0.f; O[1][1][i] = 0.f; }
  float mrow[2], lsum[2];
  mrow[0] = mrow[1] = a.has_sink ? a.sink2 : -1e30f;
  lsum[0] = lsum[1] = (a.has_sink && h == 0) ? 1.f : 0.f;
  const int ntiles = (a.seg0_n + a.seg1_n) >> 6;
  uint4 pk0, pk1, pk2, pv0, pv1;
#define KR(i) ((tid + 256 * (i)) / KCH)
#define KQ(i) ((tid + 256 * (i)) % KCH)
#define KSRC(i, krow) ((!MLA || KQ(i) < 8) ? a.k + (size_t)((krow) + KR(i)) * a.ldk + KQ(i) * 8 : a.kpe + (size_t)((krow) + KR(i)) * 32 + (KQ(i) - 8) * 8)
  const int vr = tid >> 3, vq = tid & 7;
#define ATT_LOAD(t_) do { const int kk0_ = (t_) * 64; const int krow_ = kk0_ < a.seg0_n ? a.seg0_row + kk0_ : a.seg1_row + kk0_ - a.seg0_n; \
    pk0 = *(const uint4*)KSRC(0, krow_); pk1 = *(const uint4*)KSRC(1, krow_); if (MLA) pk2 = *(const uint4*)KSRC(2, krow_); \
    const bf16_t* vsrc_ = a.vt + ((size_t)(krow_ >> 6) * a.vt_heads + a.vhead) * 4096; \
    pv0 = *(const uint4*)(vsrc_ + vr * 64 + vq * 8); pv1 = *(const uint4*)(vsrc_ + (vr + 32) * 64 + vq * 8); } while (0)
  ATT_LOAD(0);
  for (int t = 0; t < ntiles; ++t) {
    __syncthreads();
    *(uint4*)(sK + KR(0) * KSTR + KQ(0) * 8) = pk0; *(uint4*)(sK + KR(1) * KSTR + KQ(1) * 8) = pk1; if (MLA) *(uint4*)(sK + KR(2) * KSTR + KQ(2) * 8) = pk2;
    *(uint2*)(sV + vr * VSTR + vq * 8) = make_uint2(pv0.x, pv0.y); *(uint2*)(sV + vr * VSTR + vq * 8 + 4) = make_uint2(pv0.z, pv0.w);
    *(uint2*)(sV + (vr + 32) * VSTR + vq * 8) = make_uint2(pv1.x, pv1.y); *(uint2*)(sV + (vr + 32) * VSTR + vq * 8 + 4) = make_uint2(pv1.z, pv1.w);
    __syncthreads();
    if (t + 1 < ntiles) ATT_LOAD(t + 1);
    f32x16 S[2][2];
#pragma unroll
    for (int i = 0; i < 16; ++i) { S[0][0][i] = 0.f; S[0][1][i] = 0.f; S[1][0][i] = 0.f; S[1][1][i] = 0.f; }
#pragma unroll
    for (int ks = 0; ks < KS; ++ks)
#pragma unroll
      for (int kt = 0; kt < 2; ++kt) {
        bf16x8 kf = *(const bf16x8*)(sK + (kt * 32 + r32) * KSTR + ks * 16 + h * 8);
        const bf16x8 q0 = *(const bf16x8*)(sQw + ks * 16), q1 = *(const bf16x8*)(sQw + 32 * KSTR + ks * 16);
        S[0][kt] = MFMA32(kf, q0, S[0][kt]); S[1][kt] = MFMA32(kf, q1, S[1][kt]);
      }
    float mx[2];
#pragma unroll
    for (int gq = 0; gq < 2; ++gq) {
      float m = -1e30f;
#pragma unroll
      for (int kt = 0; kt < 2; ++kt)
#pragma unroll
        for (int ri = 0; ri < 16; ++ri) m = fmaxf(m, S[gq][kt][ri]);
      mx[gq] = fmaxf(m, __shfl_xor(m, 32));
    }
    if (__builtin_amdgcn_ballot_w64((mx[0] > mrow[0] + 8.f) || (mx[1] > mrow[1] + 8.f)) != 0ull) {
#pragma unroll
      for (int gq = 0; gq < 2; ++gq) {
        const float mnew = fmaxf(mrow[gq], mx[gq]), alpha = ex2(mrow[gq] - mnew);
        mrow[gq] = mnew; lsum[gq] *= alpha;
#pragma unroll
        for (int i = 0; i < 16; ++i) { O[gq][0][i] *= alpha; O[gq][1][i] *= alpha; }
      }
    }
#pragma unroll
    for (int kt = 0; kt < 2; ++kt)
#pragma unroll
      for (int s2 = 0; s2 < 2; ++s2) {
        bf16x8 pf[2];
#pragma unroll
        for (int gq = 0; gq < 2; ++gq) {
          float e[8];
#pragma unroll
          for (int j = 0; j < 8; ++j) e[j] = ex2(S[gq][kt][8 * s2 + j] - mrow[gq]);
          lsum[gq] += ((e[0] + e[1]) + (e[2] + e[3])) + ((e[4] + e[5]) + (e[6] + e[7]));
          pf[gq] = mk8(pack2(e[0], e[1]), pack2(e[2], e[3]), pack2(e[4], e[5]), pack2(e[6], e[7]));
        }
#pragma unroll
        for (int dt = 0; dt < 2; ++dt) {
          const bf16_t* vp = sV + (dt * 32 + r32) * VSTR + kt * 32 + 16 * s2 + 4 * h;
          const uint2 lo = *(const uint2*)vp, hi = *(const uint2*)(vp + 8);
          const bf16x8 vf = mk8(lo.x, lo.y, hi.x, hi.y);
          O[0][dt] = MFMA32(vf, pf[0], O[0][dt]); O[1][dt] = MFMA32(vf, pf[1], O[1][dt]);
        }
      }
  }
#undef KR
#undef KQ
#undef KSRC
#undef ATT_LOAD
#pragma unroll
  for (int gq = 0; gq < 2; ++gq) {
    const float l = lsum[gq] + __shfl_xor(lsum[gq], 32);
    const float inv = 1.f / l;
    const size_t row = (size_t)(a.qrow0 + w * 64 + gq * 32 + r32);
#pragma unroll
    for (int dt = 0; dt < 2; ++dt)
#pragma unroll
      for (int g4 = 0; g4 < 4; ++g4) {
        const int d0 = dt * 32 + 8 * g4 + 4 * h;
        const uint2 gt = *(const uint2*)(a.gate + row * a.ldg + d0);
        const float o0 = O[gq][dt][4 * g4 + 0] * inv * bflo(gt.x), o1 = O[gq][dt][4 * g4 + 1] * inv * bfhi(gt.x), o2 = O[gq][dt][4 * g4 + 2] * inv * bflo(gt.y), o3 = O[gq][dt][4 * g4 + 3] * inv * bfhi(gt.y);
        *(uint2*)(a.out + row * a.ldo + d0) = make_uint2(pack2(o0, o1), pack2(o2, o3));
      }
  }
}

DI void scan_item(const Params& p, int it, bool latent, bool dost = true) {
  const int tid = threadIdx.x;
  const int quarter = it & 3, head = (it >> 2) & 15, dir = (it >> 6) & 1, b = it >> 7;
  const int e = quarter * 1024 + tid * 4;
  const float* ST = (const float*)(p.ws + WS_STATES); const float* CD = (const float*)(p.ws + WS_CDEC);
  bf16_t* HIN = (bf16_t*)(p.ws + WS_HIN);
  float4 h = make_float4(0.f, 0.f, 0.f, 0.f);
  const int nc = latent ? 32 : 2, gc0 = latent ? 64 + b * 32 : b * 2;
  if (latent) h = *(const float4*)((dir == 0 ? p.in[I_SF] : p.in[I_SB]) + ((size_t)b * 16 + head) * 4096 + e);
  if (latent) {
    for (int s0 = 0; s0 < 32; s0 += 8) {
      float4 st[8]; float dec[8];
#pragma unroll
      for (int u = 0; u < 8; ++u) {
        const int c = dir == 0 ? s0 + u : 31 - s0 - u;
        const size_t base = ((size_t)((gc0 + c) * 2 + dir) * 16 + head);
        dec[u] = CD[base]; { const uint2 q2 = *(const uint2*)((const bf16_t*)ST + base * 4096 + e); st[u] = make_float4(bflo(q2.x), bfhi(q2.x), bflo(q2.y), bfhi(q2.y)); }
      }
#pragma unroll
      for (int u = 0; u < 8; ++u) {
        const int c = dir == 0 ? s0 + u : 31 - s0 - u;
        const size_t base = ((size_t)((gc0 + c) * 2 + dir) * 16 + head);
        if (dost) *(uint2*)(HIN + base * 4096 + e) = make_uint2(pack2(h.x, h.y), pack2(h.z, h.w));
        h.x = h.x * dec[u] + st[u].x; h.y = h.y * dec[u] + st[u].y; h.z = h.z * dec[u] + st[u].z; h.w = h.w * dec[u] + st[u].w;
      }
    }
  }
}
DI void scan_ctx_item(const Params& p, int it, bool dost = true) {
  const int tid = threadIdx.x;
  const int head = it & 15, dir = (it >> 4) & 1, b = it >> 5;
  const float* ST = (const float*)(p.ws + WS_STATES); const float* CD = (const float*)(p.ws + WS_CDEC);
  bf16_t* HIN = (bf16_t*)(p.ws + WS_HIN);
  const int c0 = dir == 0 ? 0 : 1, c1 = 1 - c0;
  const size_t b0 = ((size_t)((b * 2 + c0) * 2 + dir) * 16 + head), b1 = ((size_t)((b * 2 + c1) * 2 + dir) * 16 + head);
  const float dec1 = CD[b1];
  float4 s0[4], s1[4];
#pragma unroll
  for (int qq = 0; qq < 4; ++qq) { const int e = qq * 1024 + tid * 4; const uint2 q0 = *(const uint2*)((const bf16_t*)ST + b0 * 4096 + e), q1 = *(const uint2*)((const bf16_t*)ST + b1 * 4096 + e);
    s0[qq] = make_float4(bflo(q0.x), bfhi(q0.x), bflo(q0.y), bfhi(q0.y)); s1[qq] = make_float4(bflo(q1.x), bfhi(q1.x), bflo(q1.y), bfhi(q1.y)); }
#pragma unroll
  for (int qq = 0; qq < 4; ++qq) {
    const int e = qq * 1024 + tid * 4;
    if (dost) {
      *(uint2*)(HIN + b0 * 4096 + e) = make_uint2(0u, 0u);
      *(uint2*)(HIN + b1 * 4096 + e) = make_uint2(pack2(s0[qq].x, s0[qq].y), pack2(s0[qq].z, s0[qq].w));
    }
    *(float4*)(p.out + (dir == 0 ? O_SF : O_SB) + ((size_t)b * 16 + head) * 4096 + e) =
        make_float4(s0[qq].x * dec1 + s1[qq].x, s0[qq].y * dec1 + s1[qq].y, s0[qq].z * dec1 + s1[qq].z, s0[qq].w * dec1 + s1[qq].w);
  }
}
DI void attn_a_item(const Params& p, int it, bool latent, unsigned char* smem, bool dost = true) {
  AttnArgs a;
  int qb, head, b;
  { const int x = it & 7, j = it >> 3;
    if (latent) { qb = (j & 3) * 8 + x; head = (j >> 2) & 7; b = j >> 5; }
    else { const int mt = (j & 7) * 8 + x; head = j >> 3; b = mt >> 1; qb = mt & 1; } }
  const int kvh = head >> 2;
  const int seqrow = latent ? NCTX + b * 4096 : b * 256;
  a.q = (const bf16_t*)(p.ws + WS_QA) + head * 64; a.ldq = 512;
  a.k = (const bf16_t*)(p.ws + WS_KA) + kvh * 64; a.ldk = 128; a.kpe = nullptr;
  a.vt = (const bf16_t*)(p.ws + WS_VTA); a.vt_heads = 2; a.vhead = kvh;
  a.gate = (const bf16_t*)(p.ws + WS_GA) + head * 64; a.ldg = 512;
  a.out = (bf16_t*)(p.ws + WS_QA) + head * 64; a.ldo = 512;
  a.qrow0 = seqrow + qb * 128; a.qpos0 = qb * 128;
  if (latent) {
    int klo = qb * 128 - 128; if (klo < 0) klo = 0; int khi = qb * 128 + 256; if (khi > 4096) khi = 4096;
    a.seg0_row = seqrow + klo; a.seg0_n = khi - klo; a.seg0_pos = klo; a.band = 1;
    a.seg1_row = NTOK + b * 256; a.seg1_n = 256;
  } else {
    a.seg0_row = seqrow; a.seg0_n = 256; a.seg0_pos = 0; a.band = 0; a.seg1_row = 0; a.seg1_n = 0;
  }
  a.sink2 = p.in[I_SINK][head] * LOG2E; a.has_sink = 1; a.scale2 = 0.125f * LOG2E;
  attn_item<64, false>(a, smem, dost);
}
DI void phase_scan_attn_a(const Params& p, unsigned char* smem, bool dost = true) {
  for (int item = blockIdx.x; item < 2304; item += gridDim.x) {
    if (item < 512) attn_a_item(p, item, true, smem, dost);
    else if (item < 768) scan_item(p, item - 512, true, dost);
    else if (item < 1280) attn_a_item(p, item - 768, false, smem, dost);
    else scan_ctx_item(p, item - 1280, dost);
  }
}

DI void phase_ssd_out(const Params& p, unsigned char* smem, bool dost = true) {
  const int tid = threadIdx.x, lane = tid & 63, w = tid >> 6, lc = lane & 15, g = lane >> 4;
  bf16_t* sB = (bf16_t*)smem;
  bf16_t* sC = sB + 128 * 72;
  bf16_t* sX = sC + 128 * 72;
  bf16_t* sHf = sX + 64 * 136;
  bf16_t* sHb = sHf + 64 * 72;
  float* dtv = (float*)(sHb + 64 * 72);
  float* cumv = dtv + 256;
  const bf16_t* XT = (const bf16_t*)(p.ws + WS_XT); const bf16_t* BCM = (const bf16_t*)(p.ws + WS_BCM); const bf16_t* HIN = (const bf16_t*)(p.ws + WS_HIN);
  bf16_t* ZS = (bf16_t*)(p.ws + WS_ZS); float* SSQ = (float*)(p.ws + WS_SSQ);
  for (int item = blockIdx.x; item < 2048; item += gridDim.x) {
    const int gc = ((item >> 7) << 3) + (item & 7), head = (item >> 3) & 15, grp = head >> 3;
    int row0, s0, s1; chunk_rows(gc, row0, s0, s1);
    __syncthreads();
    if (w < 2) chunk_cums(p, row0, head, w, lane, dtv, cumv, nullptr);
#pragma unroll
    for (int i = 0; i < 4; ++i) {
      int id = tid + 256 * i;
      { int r = id >> 3, c8 = id & 7;
        *(uint4*)(sB + r * 72 + c8 * 8) = *(const uint4*)(BCM + (size_t)(row0 + r) * 256 + grp * 64 + c8 * 8);
        *(uint4*)(sC + r * 72 + c8 * 8) = *(const uint4*)(BCM + (size_t)(row0 + r) * 256 + 128 + grp * 64 + c8 * 8); }
      { int r = id >> 4, c16 = id & 15; *(uint4*)(sX + r * 136 + c16 * 8) = *(const uint4*)(XT + ((size_t)gc * 1024 + head * 64 + r) * 128 + c16 * 8); }
    }
#pragma unroll
    for (int i = 0; i < 2; ++i) {
      int id = tid + 256 * i, r = id >> 3, c8 = id & 7;
      *(uint4*)(sHf + r * 72 + c8 * 8) = *(const uint4*)(HIN + ((size_t)(gc * 2 + 0) * 16 + head) * 4096 + r * 64 + c8 * 8);
      *(uint4*)(sHb + r * 72 + c8 * 8) = *(const uint4*)(HIN + ((size_t)(gc * 2 + 1) * 16 + head) * 4096 + r * 64 + c8 * 8);
    }
    __syncthreads();
    bf16x8 cf[2][2];
#pragma unroll
    for (int lt = 0; lt < 2; ++lt)
#pragma unroll
      for (int ks = 0; ks < 2; ++ks) cf[lt][ks] = *(const bf16x8*)(sC + (w * 32 + lt * 16 + lc) * 72 + ks * 32 + g * 8);
    float cfl[2], crl[2];
#pragma unroll
    for (int lt = 0; lt < 2; ++lt) { cfl[lt] = cumv[w * 32 + lt * 16 + lc]; crl[lt] = cumv[128 + w * 32 + lt * 16 + lc]; }
    f32x4 Y[4][2], T[4][2];
#pragma unroll
    for (int pt = 0; pt < 4; ++pt) { T[pt][0] = f32x4{0, 0, 0, 0}; T[pt][1] = f32x4{0, 0, 0, 0}; }
#pragma unroll
    for (int ks = 0; ks < 2; ++ks)
#pragma unroll
      for (int pt = 0; pt < 4; ++pt) {
        bf16x8 hf = *(const bf16x8*)(sHf + (pt * 16 + lc) * 72 + ks * 32 + g * 8);
        T[pt][0] = MFMA16(hf, cf[0][ks], T[pt][0]); T[pt][1] = MFMA16(hf, cf[1][ks], T[pt][1]);
      }
    {
      float e0 = ex2(cfl[0]), e1 = ex2(cfl[1]);
#pragma unroll
      for (int pt = 0; pt < 4; ++pt) { Y[pt][0] = T[pt][0] * e0; Y[pt][1] = T[pt][1] * e1; }
    }
#pragma unroll
    for (int pt = 0; pt < 4; ++pt) { T[pt][0] = f32x4{0, 0, 0, 0}; T[pt][1] = f32x4{0, 0, 0, 0}; }
#pragma unroll
    for (int ks = 0; ks < 2; ++ks)
#pragma unroll
      for (int pt = 0; pt < 4; ++pt) {
        bf16x8 hb = *(const bf16x8*)(sHb + (pt * 16 + lc) * 72 + ks * 32 + g * 8);
        T[pt][0] = MFMA16(hb, cf[0][ks], T[pt][0]); T[pt][1] = MFMA16(hb, cf[1][ks], T[pt][1]);
      }
    {
      float e0 = ex2(crl[0]), e1 = ex2(crl[1]);
#pragma unroll
      for (int pt = 0; pt < 4; ++pt) { Y[pt][0] += T[pt][0] * e0; Y[pt][1] += T[pt][1] * e1; }
    }
    const float dskip = p.in[I_DSKIP][head];
#pragma unroll
    for (int sb = 0; sb < 2; ++sb) {
      f32x4 S[4][2];
#pragma unroll
      for (int st = 0; st < 4; ++st) { S[st][0] = f32x4{0, 0, 0, 0}; S[st][1] = f32x4{0, 0, 0, 0}; }
#pragma unroll
      for (int ks = 0; ks < 2; ++ks)
#pragma unroll
        for (int st = 0; st < 4; ++st) {
          bf16x8 bf = *(const bf16x8*)(sB + (sb * 64 + st * 16 + lc) * 72 + ks * 32 + g * 8);
          S[st][0] = MFMA16(bf, cf[0][ks], S[st][0]); S[st][1] = MFMA16(bf, cf[1][ks], S[st][1]);
        }
#pragma unroll
      for (int st = 0; st < 4; ++st) {
        const int sbase = sb * 64 + st * 16 + 4 * g;
        const f32x4 rfs = *(const f32x4*)(dtv + sbase), rbs = *(const f32x4*)(dtv + 128 + sbase);
#pragma unroll
        for (int lt = 0; lt < 2; ++lt) {
          int l = w * 32 + lt * 16 + lc;
          asm volatile("" : "+v"(l));
#pragma unroll
          for (int r = 0; r < 4; ++r) {
            const int s = sbase + r;
            const float af = s <= l ? cfl[lt] - rfs[r] : -1e30f, ab = s >= l ? crl[lt] - rbs[r] : -1e30f;
            S[st][lt][r] = S[st][lt][r] * (ex2(af) + ex2(ab)) + (s == l ? dskip : 0.f);
          }
        }
      }
      bf16x8 pf[2][2];
#pragma unroll
      for (int lt = 0; lt < 2; ++lt)
#pragma unroll
        for (int k2 = 0; k2 < 2; ++k2)
          pf[lt][k2] = mk8(pack2(S[2 * k2][lt][0], S[2 * k2][lt][1]), pack2(S[2 * k2][lt][2], S[2 * k2][lt][3]),
                           pack2(S[2 * k2 + 1][lt][0], S[2 * k2 + 1][lt][1]), pack2(S[2 * k2 + 1][lt][2], S[2 * k2 + 1][lt][3]));
#pragma unroll
      for (int pt = 0; pt < 4; ++pt)
#pragma unroll
        for (int k2 = 0; k2 < 2; ++k2) {
          uint2 lo = *(const uint2*)(sX + (pt * 16 + lc) * 136 + sb * 64 + k2 * 32 + 4 * g);
          uint2 hi = *(const uint2*)(sX + (pt * 16 + lc) * 136 + sb * 64 + k2 * 32 + 16 + 4 * g);
          bf16x8 xf = mk8(lo.x, lo.y, hi.x, hi.y);
          Y[pt][0] = MFMA16(xf, pf[0][k2], Y[pt][0]); Y[pt][1] = MFMA16(xf, pf[1][k2], Y[pt][1]);
        }
    }
#pragma unroll
    for (int lt = 0; lt < 2; ++lt) {
      const size_t row = (size_t)(row0 + w * 32 + lt * 16 + lc);
      float ss = 0.f;
#pragma unroll
      for (int pt = 0; pt < 4; ++pt) {
        bf16_t* zp = ZS + row * 1024 + head * 64 + pt * 16 + 4 * g;
        uint2 z = *(const uint2*)zp;
        float o0 = Y[pt][lt][0] * bflo(z.x), o1 = Y[pt][lt][1] * bfhi(z.x), o2 = Y[pt][lt][2] * bflo(z.y), o3 = Y[pt][lt][3] * bfhi(z.y);
        ss += o0 * o0 + o1 * o1 + o2 * o2 + o3 * o3;
        if (dost) *(uint2*)zp = make_uint2(pack2(o0, o1), pack2(o2, o3));
      }
      ss += __shfl_xor(ss, 16); ss += __shfl_xor(ss, 32);
      if (g == 0 && dost) SSQ[row * 16 + head] = ss;
    }
  }
}

DI void resid_epilogue(const Params& p, f32x4 (&acc)[4][4], int layer, int m0, int n0, unsigned char* smem) {
  const int tid = threadIdx.x, lane = tid & 63, w = tid >> 6, wm = w >> 1, wn = w & 1;
  const int cond = cond_of(m0);
  const float* wb = stage_wave_tile(acc, smem);
  const int c4 = (lane & 15) * 4, colb = n0 + wn * 64 + c4;
  const float4 gt = *(const float4*)((const float*)(p.ws + WS_MODP) + (layer * 3 + cond) * 3072 + 2048 + colb);
  bf16_t* X1B = (bf16_t*)(p.ws + WS_X1B);
#pragma unroll 4
  for (int it = 0; it < 16; ++it) {
    const int rl = it * 4 + (lane >> 4), row = m0 + wm * 64 + rl;
    const float4 av = *(const float4*)(wb + rl * 68 + c4);
    if (layer == 0) {
      const float* xr = row < NCTX ? p.in[I_XP] + (size_t)row * 1024 : p.in[I_XS] + (size_t)(row - NCTX) * 1024;
      const float4 xv = *(const float4*)(xr + colb);
      *(uint2*)(X1B + (size_t)row * 1024 + colb) = pk4(make_float4(xv.x + gt.x * av.x, xv.y + gt.y * av.y, xv.z + gt.z * av.z, xv.w + gt.w * av.w));
    } else {
      const uint2 xb = *(const uint2*)(X1B + (size_t)row * 1024 + colb);
      const float4 v = make_float4(bflo(xb.x) + gt.x * av.x, bfhi(xb.x) + gt.y * av.y, bflo(xb.y) + gt.z * av.z, bfhi(xb.y) + gt.w * av.w);
      *(uint2*)((bf16_t*)(p.ws + WS_X2B) + (size_t)row * 1024 + colb) = pk4(v);
      float ss = v.x * v.x + v.y * v.y + v.z * v.z + v.w * v.w;
      ss += __shfl_xor(ss, 8); ss += __shfl_xor(ss, 4); ss += __shfl_xor(ss, 2); ss += __shfl_xor(ss, 1);
      if ((lane & 15) == 0) __hip_atomic_fetch_add((float*)(p.ws + WS_ROWSQ) + row, ss, __ATOMIC_RELAXED, __HIP_MEMORY_SCOPE_AGENT);
    }
  }
}
DI void phase_ab_out(const Params& p, unsigned char* smem) {
  const int tid = threadIdx.x, lane = tid & 63, w = tid >> 6, wm = w >> 1, g = lane >> 4;
  float* srs = (float*)(smem + 65536);
  const float* SSQ = (const float*)(p.ws + WS_SSQ);
  const bf16_t* W = (const bf16_t*)(p.ws + W_ABOUT);
  for (int tile = blockIdx.x; tile < 128 * 8; tile += gridDim.x) {
    int mt, nt; xcd_tile(tile, 8, mt, nt); const int m0 = mt * 128, n0 = nt * 128;
    __syncthreads();
    if (tid < 128) {
      const float4* s = (const float4*)(SSQ + (size_t)(m0 + tid) * 16);
      float4 a = s[0], b = s[1], c = s[2], d = s[3];
      float t = a.x + a.y + a.z + a.w + b.x + b.y + b.z + b.w + c.x + c.y + c.z + c.w + d.x + d.y + d.z + d.w;
      srs[tid] = rsqrtf(t * (1.f / 1024.f) + EPS);
    }
    f32x4 acc[4][4]; acc_zero(acc);
    gemm_mainloop(acc, (const bf16_t*)(p.ws + WS_ZS), 1024, W + 512, 1536, 1024, m0, n0, smem);
#pragma unroll
    for (int i = 0; i < 4; ++i)
#pragma unroll
      for (int r = 0; r < 4; ++r) {
        float rs = srs[wm * 64 + i * 16 + 4 * g + r];
#pragma unroll
        for (int j = 0; j < 4; ++j) acc[i][j][r] *= rs;
      }
    gemm_mainloop(acc, (const bf16_t*)(p.ws + WS_QA), 512, W, 1536, 512, m0, n0, smem);
    resid_epilogue(p, acc, 0, m0, n0, smem);
  }
}
DI void phase_mla_out(const Params& p, unsigned char* smem) {
  for (int tile = blockIdx.x; tile < 128 * 8; tile += gridDim.x) {
    int mt, nt; xcd_tile(tile, 8, mt, nt); const int m0 = mt * 128, n0 = nt * 128;
    f32x4 acc[4][4]; acc_zero(acc);
    gemm_mainloop(acc, (const bf16_t*)(p.ws + WS_AOM), 1024, (const bf16_t*)(p.ws + W_MOUT), 1024, 1024, m0, n0, smem);
    resid_epilogue(p, acc, 1, m0, n0, smem);
  }
}

DI void phase_mla_in(const Params& p, unsigned char* smem) {
  const int tid = threadIdx.x, lane = tid & 63, w = tid >> 6, wm = w >> 1, wn = w & 1, lc = lane & 15, g = lane >> 4;
  bf16_t* GM = (bf16_t*)(p.ws + WS_GM);
  constexpr int NT = MIN_N / 128;
  for (int tile = blockIdx.x; tile < 128 * NT; tile += gridDim.x) {
    int mt, nt; xcd_tile(tile, NT, mt, nt); const int m0 = mt * 128, n0 = nt * 128;
    f32x4 acc[4][4]; acc_zero(acc);
    gemm_mainloop(acc, (const bf16_t*)(p.ws + WS_H), 1024, (const bf16_t*)(p.ws + W_MIN), 1024, 1024, m0, n0, smem);
    const int rb = m0 + wm * 64, cb = n0 + wn * 64;
    const float* wb = stage_wave_tile(acc, smem);
    const int c4 = (lane & 15) * 4, col = cb + c4;
    if (n0 < 256) {
      bf16_t* CQB = (bf16_t*)(p.ws + WS_CQN); float* rsq = (float*)(p.ws + WS_ROWSQ_Q);
#pragma unroll 4
      for (int it = 0; it < 16; ++it) {
        const int rl = it * 4 + (lane >> 4); const size_t row = (size_t)(rb + rl);
        const float4 v = *(const float4*)(wb + rl * 68 + c4);
        *(uint2*)(CQB + row * 256 + col) = pk4(v);
        float ss = v.x * v.x + v.y * v.y + v.z * v.z + v.w * v.w;
        ss += __shfl_xor(ss, 8); ss += __shfl_xor(ss, 4); ss += __shfl_xor(ss, 2); ss += __shfl_xor(ss, 1);
        if ((lane & 15) == 0) __hip_atomic_fetch_add(rsq + row, ss, __ATOMIC_RELAXED, __HIP_MEMORY_SCOPE_AGENT);
      }
    } else if (n0 < 384) {
      float* ex = (float*)(smem + 69632);
#pragma unroll 4
      for (int it = 0; it < 16; ++it) {
        const int rl = it * 4 + (lane >> 4);
        const float4 v = *(const float4*)(wb + rl * 68 + c4);
        float ss = v.x * v.x + v.y * v.y + v.z * v.z + v.w * v.w;
        ss += __shfl_xor(ss, 8); ss += __shfl_xor(ss, 4); ss += __shfl_xor(ss, 2); ss += __shfl_xor(ss, 1);
        if ((lane & 15) == 0) ex[(wm * 2 + wn) * 64 + rl] = ss;
      }
      __syncthreads();
      bf16_t* CKVN = (bf16_t*)(p.ws + WS_CKVN);
      const float4 nw = *(const float4*)(p.in[I_KVNW] + col - 256);
#pragma unroll 4
      for (int it = 0; it < 16; ++it) {
        const int rl = it * 4 + (lane >> 4); const size_t row = (size_t)(rb + rl);
        const float rs = rsqrtf((ex[(wm * 2 + 0) * 64 + rl] + ex[(wm * 2 + 1) * 64 + rl]) * (1.f / 128.f) + EPS);
        const float4 v = *(const float4*)(wb + rl * 68 + c4);
        const float4 o = make_float4(v.x * rs * nw.x, v.y * rs * nw.y, v.z * rs * nw.z, v.w * rs * nw.w);
        *(uint2*)(CKVN + row * 128 + col - 256) = pk4(o);
        if (m0 < NCTX) *(float4*)(p.out + O_CKV + row * 128 + col - 256) = o;
      }
    } else if (n0 < 1408) {
#pragma unroll 4
      for (int it = 0; it < 16; ++it) {
        const int rl = it * 4 + (lane >> 4); const size_t row = (size_t)(rb + rl);
        *(uint2*)(GM + row * 1024 + col - 384) = pk4(silu4(*(const float4*)(wb + rl * 68 + c4)));
      }
    } else if (wn == 0) {
      bf16_t* KPEB = (bf16_t*)(p.ws + WS_KPEB);
      const bool lat = m0 >= NCTX;
#pragma unroll 4
      for (int it = 0; it < 16; ++it) {
        const int rl = it * 4 + (lane >> 4); const size_t row = (size_t)(rb + rl);
        const float4 v = *(const float4*)(wb + rl * 68 + c4);
        const float4 pr = make_float4(__shfl_xor(v.x, 2), __shfl_xor(v.y, 2), __shfl_xor(v.z, 2), __shfl_xor(v.w, 2));
        float4 o = v;
        if (lat) {
          const int l = (int)(row - NCTX) & 4095;
          const float pos = (c4 & 16) ? (float)(l & 63) : (float)(l >> 6);
          const float vv[4] = {v.x, v.y, v.z, v.w}, pp[4] = {pr.x, pr.y, pr.z, pr.w}; float oo[4];
#pragma unroll
          for (int e = 0; e < 4; ++e) {
            const float th = pos * ex2(-(float)((c4 + e) & 7) * (13.287712379549449f / 8.f)), c = __cosf(th), sn = __sinf(th);
            oo[e] = (c4 & 8) ? vv[e] * c + pp[e] * sn : vv[e] * c - pp[e] * sn;
          }
          o = make_float4(oo[0], oo[1], oo[2], oo[3]);
        }
        if (c4 < 32) {
          *(uint2*)(KPEB + row * 32 + c4) = pk4(o);
          if (!lat) *(float4*)(p.out + O_KPE + row * 32 + c4) = v;
        }
      }
    }
  }
}

DI void mla_cache_convert(const Params& p) {
  bf16_t* CKVN = (bf16_t*)(p.ws + WS_CKVN) + (size_t)NTOK * 128; bf16_t* KPEB = (bf16_t*)(p.ws + WS_KPEB) + (size_t)NTOK * 32;
  for (int i = blockIdx.x * 256 + threadIdx.x; i < (65536 + 16384) / 4; i += gridDim.x * 256) {
    if (i < 16384) { float4 v = ((const float4*)p.in[I_CCKV])[i]; *(uint2*)(CKVN + i * 4) = make_uint2(pack2(v.x, v.y), pack2(v.z, v.w)); }
    else { int k = i - 16384; float4 v = ((const float4*)p.in[I_CKPE])[k]; *(uint2*)(KPEB + k * 4) = make_uint2(pack2(v.x, v.y), pack2(v.z, v.w)); }
  }
}
DI void phase_mla_prep(const Params& p) {
  const int tid = threadIdx.x, lane = tid & 63, w = tid >> 6;
  const float* CQ = (const float*)(p.ws + WS_CQ); const float* CKV = (const float*)(p.ws + WS_CKV); const float* KPE = (const float*)(p.ws + WS_KPE);
  bf16_t* CQN = (bf16_t*)(p.ws + WS_CQN); bf16_t* CKVN = (bf16_t*)(p.ws + WS_CKVN); bf16_t* KPEB = (bf16_t*)(p.ws + WS_KPEB);
  for (int item = blockIdx.x; item < NTOK / 4; item += gridDim.x) {
    const size_t row = (size_t)item * 4 + w;
    {
      float4 v = *(const float4*)(CQ + row * 256 + lane * 4);
      float ss = wave_sum(v.x * v.x + v.y * v.y + v.z * v.z + v.w * v.w);
      float rs = rsqrtf(ss * (1.f / 256.f) + EPS);
      float4 nw = *(const float4*)(p.in[I_QNW] + lane * 4);
      *(uint2*)(CQN + row * 256 + lane * 4) = make_uint2(pack2(v.x * rs * nw.x, v.y * rs * nw.y), pack2(v.z * rs * nw.z, v.w * rs * nw.w));
    }
    {
      float2 v = *(const float2*)(CKV + row * 128 + lane * 2);
      float ss = wave_sum(v.x * v.x + v.y * v.y);
      float rs = rsqrtf(ss * (1.f / 128.f) + EPS);
      float2 nw = *(const float2*)(p.in[I_KVNW] + lane * 2);
      float a = v.x * rs * nw.x, b = v.y * rs * nw.y;
      *(unsigned*)(CKVN + row * 128 + lane * 2) = pack2(a, b);
      if (row < NCTX) *(float2*)(p.out + O_CKV + row * 128 + lane * 2) = make_float2(a, b);
    }
    {
      float v = lane < 32 ? KPE[row * 32 + lane] : 0.f;
      float pr = __shfl_xor(v, 8);
      float o = v;
      if (row >= NCTX) {
        int l = (int)(row - NCTX) & 4095;
        float pos = (lane & 16) ? (float)(l & 63) : (float)(l >> 6);
        float th = pos * ex2(-(float)(lane & 7) * (13.287712379549449f / 8.f));
        float c = __cosf(th), s = __sinf(th);
        o = (lane & 8) ? v * c + pr * s : v * c - pr * s;
      } else if (lane < 32) p.out[O_KPE + row * 32 + lane] = v;
      if (lane < 32) KPEB[row * 32 + lane] = f2bf(o);
    }
  }
}

DI void phase_mla_up(const Params& p, unsigned char* smem) {
  const int tid = threadIdx.x, lane = tid & 63, w = tid >> 6, wm = w >> 1, wn = w & 1, lc = lane & 15, g = lane >> 4;
  bf16_t* QM = (bf16_t*)(p.ws + WS_QM); bf16_t* KN = (bf16_t*)(p.ws + WS_KNOPE); bf16_t* VTM = (bf16_t*)(p.ws + WS_VTM);
  constexpr int NQ = 128 * 12, NKV = 132 * 16;
  for (int tile = blockIdx.x; tile < NQ + NKV; tile += gridDim.x) {
    f32x4 acc[4][4]; acc_zero(acc);
    if (tile < NQ) {
      int mt, nt; xcd_tile(tile, 12, mt, nt); const int m0 = mt * 128, n0 = nt * 128;
      gemm_mainloop(acc, (const bf16_t*)(p.ws + WS_CQN), 256, (const bf16_t*)(p.ws + W_UQ), 256, 256, m0, n0, smem);
      const int rb = m0 + wm * 64, cb = n0 + wn * 64; const bool lat = m0 >= NCTX;
      const float inv = ex2(-(float)(lc & 7) * (13.287712379549449f / 8.f));
      if (lat) {
#pragma unroll
        for (int j = 0; j < 4; ++j) {
          const int col0 = cb + j * 16, d0 = col0 % 96;
          if (d0 >= 64) {
#pragma unroll
            for (int i = 0; i < 4; ++i)
#pragma unroll
              for (int r = 0; r < 4; ++r) {
                const int row = rb + i * 16 + 4 * g + r;
                float v = acc[i][j][r];
                float pr = __shfl_xor(v, 8);
                int l = (row - NCTX) & 4095;
                float pos = d0 >= 80 ? (float)(l & 63) : (float)(l >> 6);
                float th = pos * inv, c = __cosf(th), sn = __sinf(th);
                acc[i][j][r] = (lc & 8) ? v * c + pr * sn : v * c - pr * sn;
              }
          }
        }
      }
      {
        const float* wb = stage_wave_tile(acc, smem);
        const int c4 = (lane & 15) * 4; const float qs = 0.10206207261596575f * LOG2E;
#pragma unroll 4
        for (int it = 0; it < 16; ++it) {
          const int rl = it * 4 + (lane >> 4); const size_t row = (size_t)(rb + rl);
          const float4 v = *(const float4*)(wb + rl * 68 + c4);
          const float qr = qs * rsqrtf(((const float*)(p.ws + WS_ROWSQ_Q))[row] * (1.f / 256.f) + EPS);
          *(uint2*)(QM + row * 1536 + cb + c4) = pk4(make_float4(v.x * qr, v.y * qr, v.z * qr, v.w * qr));
        }
      }
    } else {
      const int t2 = tile - NQ; int mt, head; if (t2 < 128 * 16) xcd_tile(t2, 16, mt, head); else { mt = t2 >> 4; head = t2 & 15; } const int m0 = mt * 128, n0 = head * 128;
      gemm_mainloop(acc, (const bf16_t*)(p.ws + WS_CKVN), 128, (const bf16_t*)(p.ws + W_UKV), 128, 128, m0, n0, smem);
      const int rb = m0 + wm * 64;
      if (wn == 0) {
        const float* wb = stage_wave_tile(acc, smem);
        const int c4 = (lane & 15) * 4;
#pragma unroll 4
        for (int it = 0; it < 16; ++it) {
          const int rl = it * 4 + (lane >> 4);
          *(uint2*)(KN + (size_t)(rb + rl) * 1024 + head * 64 + c4) = pk4(*(const float4*)(wb + rl * 68 + c4));
        }
      } else {
#pragma unroll
        for (int i = 0; i < 4; ++i)
#pragma unroll
          for (int j = 0; j < 4; ++j) {
            int row = rb + i * 16 + 4 * g, d = j * 16 + lc;
            *(uint2*)(VTM + ((size_t)(row >> 6) * 16 + head) * 4096 + d * 64 + (row & 63)) = make_uint2(pack2(acc[i][j][0], acc[i][j][1]), pack2(acc[i][j][2], acc[i][j][3]));
          }
      }
    }
  }
}

DI void phase_mla_attn(const Params& p, unsigned char* smem) {
  for (int item = blockIdx.x; item < 1024; item += gridDim.x) {
    AttnArgs a;
    const bool latent = item < 512;
    const int it = latent ? item : item - 512;
    int qb, head, b;
    if (latent) { const int x = it & 7, j = it >> 3, pair = x * 4 + (j >> 4); qb = j & 15; head = pair & 15; b = pair >> 4; }
    else { qb = 0; head = it & 15; b = it >> 4; }
    const int seqrow = latent ? NCTX + b * 4096 : b * 256;
    a.q = (const bf16_t*)(p.ws + WS_QM) + head * 96; a.ldq = 1536;
    a.k = (const bf16_t*)(p.ws + WS_KNOPE) + head * 64; a.ldk = 1024; a.kpe = (const bf16_t*)(p.ws + WS_KPEB);
    a.vt = (const bf16_t*)(p.ws + WS_VTM); a.vt_heads = 16; a.vhead = head;
    a.gate = (const bf16_t*)(p.ws + WS_GM) + head * 64; a.ldg = 1024;
    a.out = (bf16_t*)(p.ws + WS_AOM) + head * 64; a.ldo = 1024;
    a.qrow0 = seqrow + qb * 256; a.qpos0 = qb * 256;
    a.seg0_row = seqrow; a.seg0_n = latent ? 4096 : 256; a.seg0_pos = 0; a.band = 0;
    a.seg1_row = NTOK + b * 256; a.seg1_n = latent ? 256 : 0;
    a.sink2 = 0.f; a.has_sink = 0; a.scale2 = 1.f;
    attn_item2<96, true>(a, smem);
  }
}

DI void phase_final_norm(const Params& p) {
  const int tid = threadIdx.x;
  const bf16_t* X2B = (const bf16_t*)(p.ws + WS_X2B); const float* rowsq = (const float*)(p.ws + WS_ROWSQ);
  const int c8 = (tid & 127) * 8;
  const float4 w0 = *(const float4*)(p.in[I_FNW] + c8), w1 = *(const float4*)(p.in[I_FNW] + c8 + 4);
  for (int item = blockIdx.x; item < NTOK / 2; item += gridDim.x) {
    const size_t row = (size_t)item * 2 + (tid >> 7);
    const float rs = rsqrtf(rowsq[row] * (1.f / 1024.f) + EPS);
    const uint4 u = *(const uint4*)(X2B + row * 1024 + c8);
    float* o = p.out + O_Y + row * 1024 + c8;
    *(float4*)o = make_float4(bflo(u.x) * rs * w0.x, bfhi(u.x) * rs * w0.y, bflo(u.y) * rs * w0.z, bfhi(u.y) * rs * w0.w);
    *(float4*)(o + 4) = make_float4(bflo(u.z) * rs * w1.x, bfhi(u.z) * rs * w1.y, bflo(u.w) * rs * w1.z, bfhi(u.w) * rs * w1.w);
  }
}

#define XB_TMO      128
#define XB_XCNT(j)  (256  + 64 * (j))
#define XB_XSUB(j)  (1280 + 64 * (j))
#define XB_XGEN(j)  (2304 + 64 * (j))
#define XB_TOP      3328
#define XB_TOPGEN   3392
#define XCD_BAR_WORDS 3456
#define XB_SPIN_CAP (1u << 18)
#define LAS __attribute__((address_space(3)))

__device__ __forceinline__ unsigned xb_ld(unsigned* p)              { return __hip_atomic_load(p, __ATOMIC_RELAXED, __HIP_MEMORY_SCOPE_AGENT); }
__device__ __forceinline__ unsigned xb_add(unsigned* p, unsigned v) { return __hip_atomic_fetch_add(p, v, __ATOMIC_RELAXED, __HIP_MEMORY_SCOPE_AGENT); }
__device__ __forceinline__ unsigned xb_xcc_id() { return (unsigned)__builtin_amdgcn_s_getreg((3 << 11) | 20) & 0xFu; }
#define XB_SPIN(cond, bar) do { unsigned _sp = 0; while (cond) { __builtin_amdgcn_s_sleep(1); \
    if ((++_sp & 255u) == 0u) { if (xb_ld(&(bar)[XB_TMO])) break; if (_sp > XB_SPIN_CAP) { atomicAdd(&(bar)[XB_TMO], 1u); break; } } } } while (0)

struct XcdBarrier {
    unsigned* bar; unsigned x;
    volatile LAS unsigned* st;
};

__device__ __forceinline__ XcdBarrier xcd_barrier_post(unsigned* bar, volatile LAS unsigned* st) {
    XcdBarrier b; b.bar = bar; b.x = xb_xcc_id(); b.st = st;
    if (threadIdx.x == 0) (void)xb_add(&bar[XB_XCNT(b.x)], 1u);
    return b;
}
__device__ __forceinline__ void xcd_barrier_complete(unsigned* bar, unsigned x, unsigned& nloc, unsigned& nx) {
    const unsigned G = gridDim.x * gridDim.y * gridDim.z;
    unsigned sum, cnt, mine, sp = 0u;
    for (;;) {
        sum = 0u; cnt = 0u; mine = 0u;
#pragma unroll
        for (unsigned j = 0; j < 16; ++j) { const unsigned c = xb_ld(&bar[XB_XCNT(j)]); sum += c; cnt += (c > 0u) ? 1u : 0u; mine = (j == x) ? c : mine; }
        if (sum == G) break;
        __builtin_amdgcn_s_sleep(1);
        if ((++sp & 255u) == 0u) { if (xb_ld(&bar[XB_TMO])) break; if (sp > XB_SPIN_CAP) { atomicAdd(&bar[XB_TMO], 1u); break; } }
    }
    nloc = mine > 0u ? mine : 1u; nx = cnt > 0u ? cnt : 1u;
}

__device__ __forceinline__ void xcd_barrier(const XcdBarrier& b) {
    asm volatile("s_waitcnt vmcnt(0)" ::: "memory");
    __syncthreads();
    if (threadIdx.x == 0) {
        unsigned* bar = b.bar;
        __builtin_amdgcn_s_waitcnt(0);
        unsigned nloc = b.st[0], nx = b.st[1];
        if (nloc == 0u) { xcd_barrier_complete(bar, b.x, nloc, nx); b.st[0] = nloc; b.st[1] = nx; }
        const unsigned old = xb_add(&bar[XB_XSUB(b.x)], 1u);
        const unsigned gen = old / nloc;
        if (old + 1u == (gen + 1u) * nloc) {
            __builtin_amdgcn_fence(__ATOMIC_RELEASE, "agent");
            asm volatile("s_waitcnt vmcnt(0)" ::: "memory");
            const unsigned og = xb_add(&bar[XB_TOP], 1u);
            const unsigned tg = og / nx;
            if (og + 1u == (tg + 1u) * nx) xb_add(&bar[XB_TOPGEN], 1u);
            else XB_SPIN(xb_ld(&bar[XB_TOPGEN]) == tg, bar);
            __builtin_amdgcn_fence(__ATOMIC_ACQUIRE, "agent");
            xb_add(&bar[XB_XGEN(b.x)], 1u);
            asm volatile("s_waitcnt vmcnt(0)" ::: "memory");
        } else {
            XB_SPIN(xb_ld(&bar[XB_XGEN(b.x)]) == gen, bar);
            __builtin_amdgcn_fence(__ATOMIC_ACQUIRE, "agent");
            asm volatile("s_waitcnt vmcnt(0)" ::: "memory");
        }
    }
    __syncthreads();
}


constexpr int N_PHASES = 15;
__global__ void __launch_bounds__(256, 2) mega(Params p) {
  __shared__ __attribute__((aligned(16))) unsigned char smem[75 * 1024];
  volatile LAS unsigned* xst = (volatile LAS unsigned*)(smem + 75 * 1024 - 16);
  if (threadIdx.x == 0) { xst[0] = 0u; xst[1] = 0u; }
  __syncthreads();
  XcdBarrier xb = xcd_barrier_post((unsigned*)(p.ws + WS_BAR), xst);
  if (p.ph_hi > 1000) cg::this_grid().sync();
#ifndef PROBE_D
#define PROBE_D 0
#endif
#ifndef REPEAT_MASK
#define REPEAT_MASK 0
#endif
#define PHASE(n, ...) if (p.ph_lo <= n && n < p.ph_hi) { __VA_ARGS__; if ((REPEAT_MASK >> n) & 1) { __VA_ARGS__; } if (n + 1 < p.ph_hi) xcd_barrier(xb); }
  PHASE(1, phase0(p, smem); for (int t = blockIdx.x; t < N_WT; t += gridDim.x) wt_item(p, t, smem + 24576); phase_modnorm(p, 0, smem))
  PHASE(2, phase_ab_in(p, smem))
  PHASE(3, phase_conv(p, smem); for (int it = 384 + blockIdx.x; it < 768; it += gridDim.x) p0_mod_item(p, it, smem))
  PHASE(4, phase_ssd_states(p, smem))
#if PROBE_D == 1
  if (p.ph_lo <= 5 && 5 < p.ph_hi) phase_scan_attn_a(p, smem, p.ph_hi > 100);
#endif
  PHASE(5, phase_scan_attn_a(p, smem))
#if PROBE_D == 2
  if (p.ph_lo <= 6 && 6 < p.ph_hi) phase_ssd_out(p, smem, p.ph_hi > 100);
#endif
  PHASE(6, phase_ssd_out(p, smem))
  PHASE(7, phase_ab_out(p, smem))
  PHASE(8, phase_modnorm(p, 1, smem); mla_cache_convert(p))
  PHASE(9, phase_mla_in(p, smem))
  PHASE(11, phase_mla_up(p, smem))
  PHASE(12, phase_mla_attn(p, smem))
  PHASE(13, phase_mla_out(p, smem))
  PHASE(14, phase_final_norm(p))
}

extern "C" void kernel_launch(void* const* d_in, const int* in_sizes, int n_in, void* d_out, int out_size, void* d_ws, size_t ws_size, hipStream_t stream) {
  static int grid = 0;
  if (grid == 0) {
    int dev = 0, cus = 0, per_cu = 0;
    hipGetDevice(&dev);
    hipDeviceGetAttribute(&cus, hipDeviceAttributeMultiprocessorCount, dev);
    hipOccupancyMaxActiveBlocksPerMultiprocessor(&per_cu, (const void*)mega, 256, 0);
    if (per_cu < 1) per_cu = 1;
    if (per_cu > 2) per_cu = 2;
    grid = cus * per_cu;
  }
  Params p{};
  for (int i = 0; i < 29; ++i) p.in[i] = (const float*)d_in[i];
  p.out = (float*)d_out; p.ws = (unsigned char*)d_ws;
  hipMemsetAsync((unsigned char*)d_ws + WS_BAR, 0, WS_ZERO_BYTES, stream);
#if MULTI_LAUNCH
  for (int ph = 0; ph < N_PHASES; ++ph) {
    p.ph_lo = ph; p.ph_hi = ph + 1;
    hipLaunchKernelGGL(mega, dim3(grid), dim3(256), 0, stream, p);
  }
#else
  p.ph_lo = 0; p.ph_hi = N_PHASES;
  void* args[] = {&p};
  hipError_t e = hipLaunchCooperativeKernel((const void*)mega, dim3(grid), dim3(256), args, 0, stream);
  if (e != hipSuccess) fprintf(stderr, "cooperative launch failed: %s (grid %d)\n", hipGetErrorString(e), grid);
#endif
}
```
